# Optimizing an MI355X kernel written in HIP

```python
import math
import jax, jax.numpy as jnp
from jax import lax
import numpy as np

D_MODEL = 1024
BATCH = 8
SEQ = 8192
DEPTH = 2
DEC_BATCH = 4
DEC_SEQ = 8192
PAST_LEN = 128

GROUP_WIDTH = 64
D_HYENA = 384
D_CONF = 256
D_RG = 384
D_MIX = D_HYENA + D_CONF + D_RG
RG_HEADS = D_RG // GROUP_WIDTH
HYENA_SHORT_K = 3
HYENA_EMB = 33
HYENA_BANDS = (HYENA_EMB - 1) // 2
HYENA_FILTER_ORDER = 64
HYENA_TARGET = 1e-2
HYENA_FAST_DECAY_PCT = 0.3
HYENA_SLOW_DECAY_PCT = 1.5
CONF_K = 31
RG_CONV_K = 4
RG_C = 8.0
IN_COLS = 3 * D_HYENA + 2 * D_CONF + D_RG + D_MIX
EPS = 1e-6

kernel_name = "hybrid_hyena_conformer_rglru_encoder"


def rmsnorm(x, g):
    xf = x.astype(jnp.float32)
    y = xf * lax.rsqrt(jnp.mean(xf * xf, axis=-1, keepdims=True) + EPS)
    return (y * g.astype(jnp.float32)).astype(x.dtype)


def layernorm(x, g, b):
    xf = x.astype(jnp.float32)
    mu = jnp.mean(xf, axis=-1, keepdims=True)
    xc = xf - mu
    var = jnp.mean(xc * xc, axis=-1, keepdims=True)
    y = xc * lax.rsqrt(var + EPS) * g.astype(jnp.float32) + b.astype(jnp.float32)
    return y.astype(x.dtype)


def dwconv(x, w, b, pad_left, pad_right):
    C = x.shape[-1]
    y = lax.conv_general_dilated(
        x, w[:, None, :].astype(x.dtype), window_strides=(1,),
        padding=[(pad_left, pad_right)],
        dimension_numbers=("NWC", "WIO", "NWC"), feature_group_count=C)
    return y + b.astype(x.dtype)


def hyena_filters(L, w1, b1, w2, b2, w3, b3, w4, freq):
    f32 = jnp.float32
    t = jnp.linspace(0.0, 1.0, L, dtype=f32)[:, None]
    w = (2.0 * math.pi / L) * jnp.arange(L, dtype=f32)[:, None]
    f = jnp.linspace(1e-4, HYENA_BANDS - 1, HYENA_BANDS, dtype=f32)[None]
    z = jnp.concatenate([t, jnp.cos(f * w), -jnp.sin(f * w)], axis=-1)
    fr = freq.astype(f32)
    hdn = jnp.sin(fr * (z @ w1.astype(f32) + b1.astype(f32)))
    hdn = jnp.sin(fr * (hdn @ w2.astype(f32) + b2.astype(f32)))
    hdn = jnp.sin(fr * (hdn @ w3.astype(f32) + b3.astype(f32)))
    h = hdn @ w4.astype(f32)
    max_decay = math.log(HYENA_TARGET) / HYENA_FAST_DECAY_PCT
    min_decay = math.log(HYENA_TARGET) / HYENA_SLOW_DECAY_PCT
    deltas = jnp.abs(jnp.linspace(min_decay, max_decay, D_HYENA, dtype=f32))
    decay = jnp.exp(-t * deltas[None])
    return h[:, :D_HYENA] * decay, h[:, D_HYENA:] * decay


def two_sided_fftconv(u, h_fwd, h_bwd):
    L, C = h_fwd.shape
    k = jnp.concatenate([h_fwd, jnp.zeros((1, C), jnp.float32), h_bwd[1:][::-1]], axis=0)
    u_f = jnp.fft.rfft(u, n=2 * L, axis=1)
    k_f = jnp.fft.rfft(k, n=2 * L, axis=0)
    return jnp.fft.irfft(u_f * k_f[None], n=2 * L, axis=1)[:, :L]


def hyena_branch(p, conv_w, conv_b, w1, b1, w2, b2, w3, b3, w4, freq, d_skip):
    L = p.shape[1]
    uc = dwconv(p, conv_w, conv_b, 1, 1)
    x0, x1, v = uc[..., :D_HYENA], uc[..., D_HYENA:2 * D_HYENA], uc[..., 2 * D_HYENA:]
    v = (v * x1).astype(jnp.float32)
    h_fwd, h_bwd = hyena_filters(L, w1, b1, w2, b2, w3, b3, w4, freq)
    y = two_sided_fftconv(v, h_fwd, h_bwd) + v * d_skip.astype(jnp.float32)
    return (y * x0.astype(jnp.float32)).astype(p.dtype)


def conformer_branch(p, dw_w, dw_b, ln_g, ln_b, pw_w, pw_b):
    a, b = p[..., :D_CONF], p[..., D_CONF:]
    u = a * jax.nn.sigmoid(b)
    half = (CONF_K - 1) // 2
    u = dwconv(u, dw_w, dw_b, half, half)
    u = jax.nn.silu(layernorm(u, ln_g, ln_b))
    return jnp.einsum('blc,ce->ble', u, pw_w) + pw_b


def linear_scan(a, b, reverse):
    def comb(e1, e2):
        a1, b1 = e1
        a2, b2 = e2
        return a1 * a2, a2 * b1 + b2
    return lax.associative_scan(comb, (a, b), reverse=reverse, axis=1)[1]


def rglru_direction(xr, wa, ba, wx, bx, lam, reverse):
    B, L, _ = xr.shape
    xb = xr.reshape(B, L, RG_HEADS, GROUP_WIDTH)
    gate_a = jnp.einsum('blhi,hij->blhj', xb, wa).reshape(B, L, D_RG) + ba
    gate_x = jnp.einsum('blhi,hij->blhj', xb, wx).reshape(B, L, D_RG) + bx
    r = jax.nn.sigmoid(gate_a.astype(jnp.float32))
    i = jax.nn.sigmoid(gate_x.astype(jnp.float32))
    log_a = -RG_C * r * jax.nn.softplus(-lam.astype(jnp.float32))
    a = jnp.exp(log_a)
    mult = jnp.sqrt(-jnp.expm1(2.0 * log_a))
    bterm = mult * (i * xr.astype(jnp.float32))
    return linear_scan(a, bterm, reverse)


def rglru_branch(p, conv_w, conv_b, wa, ba, wx, bx, lam):
    xr = dwconv(p, conv_w, conv_b, RG_CONV_K // 2, RG_CONV_K - 1 - RG_CONV_K // 2)
    h_f = rglru_direction(xr, wa[0], ba[0], wx[0], bx[0], lam[0], False)
    h_b = rglru_direction(xr, wa[1], ba[1], wx[1], bx[1], lam[1], True)
    return (h_f + h_b).astype(p.dtype)


def mixer_layer(x, norm_g, w_in, hy_conv_w, hy_conv_b, hy_w1, hy_b1, hy_w2, hy_b2, hy_w3, hy_b3,
                hy_w4, hy_freq, hy_d, cf_dw_w, cf_dw_b, cf_ln_g, cf_ln_b, cf_pw_w, cf_pw_b,
                rg_conv_w, rg_conv_b, rg_wa, rg_ba, rg_wx, rg_bx, rg_lam, grp_g, w_out):
    h = rmsnorm(x, norm_g)
    p = jnp.einsum('bld,de->ble', h, w_in)
    s1 = 3 * D_HYENA
    s2 = s1 + 2 * D_CONF
    s3 = s2 + D_RG
    p_hy, p_cf, p_rg, gate = p[..., :s1], p[..., s1:s2], p[..., s2:s3], p[..., s3:]
    y_hy = hyena_branch(p_hy, hy_conv_w, hy_conv_b, hy_w1, hy_b1, hy_w2, hy_b2, hy_w3, hy_b3,
                        hy_w4, hy_freq, hy_d)
    y_cf = conformer_branch(p_cf, cf_dw_w, cf_dw_b, cf_ln_g, cf_ln_b, cf_pw_w, cf_pw_b)
    y_rg = rglru_branch(p_rg, rg_conv_w, rg_conv_b, rg_wa, rg_ba, rg_wx, rg_bx, rg_lam)
    y = jnp.concatenate([
        rmsnorm(y_hy, grp_g[:D_HYENA]),
        rmsnorm(y_cf, grp_g[D_HYENA:D_HYENA + D_CONF]),
        rmsnorm(y_rg, grp_g[D_HYENA + D_CONF:])], axis=-1)
    y = y * jax.nn.silu(gate)
    return jnp.einsum('ble,ed->bld', y, w_out)


def trunk(x, layer_params, final_g):
    for l in range(DEPTH):
        x = x + mixer_layer(x, *[w[l] for w in layer_params])
    return rmsnorm(x, final_g)


def setup_inputs(seed: int = 0) -> dict:
    key = jax.random.key(seed)
    ks = jax.random.split(key, 32)
    f32 = jnp.float32

    def nrm(k, shape, scale):
        return jax.random.normal(k, shape, f32) * scale

    u = jax.random.uniform(ks[28], (DEPTH, 2, D_RG), f32, minval=0.9, maxval=0.999)
    a0 = u ** (1.0 / RG_C)
    rg_lam = jnp.log(a0) - jnp.log1p(-a0)
    return {
        "x_prompt": nrm(ks[0], (BATCH, SEQ, D_MODEL), 1.0),
        "x_sample": nrm(ks[1], (DEC_BATCH, DEC_SEQ, D_MODEL), 1.0),
        "norm_g": 1.0 + nrm(ks[2], (DEPTH, D_MODEL), 0.02),
        "w_in": nrm(ks[3], (DEPTH, D_MODEL, IN_COLS), D_MODEL ** -0.5),
        "hy_conv_w": nrm(ks[4], (DEPTH, HYENA_SHORT_K, 3 * D_HYENA), HYENA_SHORT_K ** -0.5),
        "hy_conv_b": nrm(ks[5], (DEPTH, 3 * D_HYENA), 0.02),
        "hy_w1": nrm(ks[6], (DEPTH, HYENA_EMB, HYENA_FILTER_ORDER), HYENA_EMB ** -0.5),
        "hy_b1": nrm(ks[7], (DEPTH, HYENA_FILTER_ORDER), 0.02),
        "hy_w2": nrm(ks[8], (DEPTH, HYENA_FILTER_ORDER, HYENA_FILTER_ORDER), HYENA_FILTER_ORDER ** -0.5),
        "hy_b2": nrm(ks[9], (DEPTH, HYENA_FILTER_ORDER), 0.02),
        "hy_w3": nrm(ks[10], (DEPTH, HYENA_FILTER_ORDER, HYENA_FILTER_ORDER), HYENA_FILTER_ORDER ** -0.5),
        "hy_b3": nrm(ks[11], (DEPTH, HYENA_FILTER_ORDER), 0.02),
        "hy_w4": nrm(ks[12], (DEPTH, HYENA_FILTER_ORDER, 2 * D_HYENA), HYENA_FILTER_ORDER ** -0.5),
        "hy_freq": 1.0 + nrm(ks[13], (DEPTH, HYENA_FILTER_ORDER), 0.02),
        "hy_d": nrm(ks[14], (DEPTH, D_HYENA), 0.1),
        "cf_dw_w": nrm(ks[15], (DEPTH, CONF_K, D_CONF), CONF_K ** -0.5),
        "cf_dw_b": nrm(ks[16], (DEPTH, D_CONF), 0.02),
        "cf_ln_g": 1.0 + nrm(ks[17], (DEPTH, D_CONF), 0.02),
        "cf_ln_b": nrm(ks[18], (DEPTH, D_CONF), 0.02),
        "cf_pw_w": nrm(ks[19], (DEPTH, D_CONF, D_CONF), D_CONF ** -0.5),
        "cf_pw_b": nrm(ks[20], (DEPTH, D_CONF), 0.02),
        "rg_conv_w": nrm(ks[21], (DEPTH, RG_CONV_K, D_RG), RG_CONV_K ** -0.5),
        "rg_conv_b": nrm(ks[22], (DEPTH, D_RG), 0.02),
        "rg_wa": nrm(ks[23], (DEPTH, 2, RG_HEADS, GROUP_WIDTH, GROUP_WIDTH), GROUP_WIDTH ** -0.5),
        "rg_ba": nrm(ks[24], (DEPTH, 2, D_RG), 0.02),
        "rg_wx": nrm(ks[25], (DEPTH, 2, RG_HEADS, GROUP_WIDTH, GROUP_WIDTH), GROUP_WIDTH ** -0.5),
        "rg_bx": nrm(ks[26], (DEPTH, 2, D_RG), 0.02),
        "rg_lam": rg_lam,
        "grp_g": 1.0 + nrm(ks[27], (DEPTH, D_MIX), 0.02),
        "w_out": nrm(ks[29], (DEPTH, D_MIX, D_MODEL), D_MIX ** -0.5),
        "final_g": 1.0 + nrm(ks[30], (D_MODEL,), 0.02),
    }


def reference(x_prompt, x_sample, norm_g, w_in, hy_conv_w, hy_conv_b, hy_w1, hy_b1, hy_w2, hy_b2,
              hy_w3, hy_b3, hy_w4, hy_freq, hy_d, cf_dw_w, cf_dw_b, cf_ln_g, cf_ln_b, cf_pw_w,
              cf_pw_b, rg_conv_w, rg_conv_b, rg_wa, rg_ba, rg_wx, rg_bx, rg_lam, grp_g, w_out,
              final_g):
    layer_params = (norm_g, w_in, hy_conv_w, hy_conv_b, hy_w1, hy_b1, hy_w2, hy_b2, hy_w3, hy_b3,
                    hy_w4, hy_freq, hy_d, cf_dw_w, cf_dw_b, cf_ln_g, cf_ln_b, cf_pw_w, cf_pw_b,
                    rg_conv_w, rg_conv_b, rg_wa, rg_ba, rg_wx, rg_bx, rg_lam, grp_g, w_out)
    y_prompt = trunk(x_prompt, layer_params, final_g)
    y_sample = trunk(x_sample, layer_params, final_g)
    return (y_prompt, y_sample)
```

```cpp
#include <hip/hip_runtime.h>
#include <hip/hip_cooperative_groups.h>
#include <cstdio>
#include <cstdint>
namespace cg = cooperative_groups;

namespace pg8 {
#define PG8_LAS __attribute__((address_space(3)))
typedef unsigned short bf16_t;
typedef short bf16x8 __attribute__((ext_vector_type(8)));
typedef float f32x4 __attribute__((ext_vector_type(4)));
typedef unsigned u32x4 __attribute__((ext_vector_type(4)));
constexpr int BM = 256, BK = 64, HALF = 128, HTB = HALF * BK * 2, STAGE_BYTES = 8 * HTB, NXCD = 8, WGM = 8;

__host__ __device__ __forceinline__ int lds_byte(int r, int c) { const int st = (r >> 4) * 2 + (c >> 5), rr = r & 15, cc = c & 31, ob = rr * 64 + cc * 2; return st * 1024 + (ob ^ (((ob >> 9) & 1) << 5)); }
__host__ __device__ __forceinline__ void stage_rc(int b, int& R, int& C) { const int st = b / 1024, sb = b % 1024, swz = sb ^ (((sb >> 9) & 1) << 5); R = (st >> 1) * 16 + swz / 64; C = (st & 1) * 32 + (swz % 64) / 2; }
__host__ __device__ __forceinline__ int perm32(int rho) { const int n = rho >> 4, i = rho & 15; return 8 * (i >> 2) + 4 * n + (i & 3); }

struct Unit { int pm, pn; };
struct Gemm { const bf16_t* A; const bf16_t* Bt; int M, N, K; };

struct StaticOrder {
    int nM, nN, nwg, G, c;
    __host__ __device__ void init(int M, int N, int G_, int c_) { nM = M / BM; nN = N / BM; nwg = nM * nN; G = G_; c = c_; }
    __host__ __device__ bool next(int i, Unit& u) const {
        const long L = (long)i * G + c; if (L >= nwg) return false;
        int wgid = (int)L; { const int q = nwg / NXCD, r = nwg % NXCD, xcd = wgid % NXCD, off = wgid / NXCD; wgid = (xcd < r ? xcd * (q + 1) : r * (q + 1) + (xcd - r) * q) + off; }
        const int nig = WGM * nN, gid = wgid / nig, fm = gid * WGM, gsz = (nM - fm) < WGM ? (nM - fm) : WGM;
        u.pm = fm + ((wgid % nig) % gsz); u.pn = (wgid % nig) / gsz; return true;
    }
    __device__ __forceinline__ void a_ready(const Unit&) const {}
    __device__ __forceinline__ void done(const Unit&) const {}
};

__device__ __forceinline__ unsigned cvt_pk_bf16(float lo, float hi) { unsigned r; asm volatile("v_cvt_pk_bf16_f32 %0, %1, %2" : "=v"(r) : "v"(lo), "v"(hi)); return r; }

struct EpiBf16 {
    static constexpr bool PERM = true, AFTER_DRAIN = false;
    bf16_t* O; int ldc;
    __device__ __forceinline__ void operator()(const f32x4 (&acc)[2][2][4][2], const Unit& u, int wr, int wc, int fr, int fq) const {
        const int row0 = u.pm * BM + wr * 64 + fr; const int col0 = u.pn * BM + wc * 32 + 8 * fq;
#pragma unroll
        for (int ai = 0; ai < 2; ++ai)
#pragma unroll
            for (int m = 0; m < 4; ++m) { bf16_t* rowp = O + (size_t)(row0 + ai * HALF + m * 16) * ldc + col0;
#pragma unroll
                for (int bj = 0; bj < 2; ++bj) { const f32x4 v0 = acc[ai][bj][m][0], v1 = acc[ai][bj][m][1];
                    u32x4 w; w.x = cvt_pk_bf16(v0[0], v0[1]); w.y = cvt_pk_bf16(v0[2], v0[3]); w.z = cvt_pk_bf16(v1[0], v1[1]); w.w = cvt_pk_bf16(v1[2], v1[3]);
                    *(u32x4*)(rowp + bj * HALF) = w; } }
    }
};
struct EpiResF32 {
    static constexpr bool PERM = false, AFTER_DRAIN = false;
    float* C; const float* ra; const float* rb; int split; int ldc;
    __device__ __forceinline__ void operator()(const f32x4 (&acc)[2][2][4][2], const Unit& u, int wr, int wc, int fr, int fq) const {
        const int row0 = u.pm * BM + wr * 64 + fr, col0 = u.pn * BM + wc * 32 + 4 * fq;
        const float* rbase = (u.pm * BM < split) ? ra : rb - (size_t)split * ldc;
#pragma unroll
        for (int ai = 0; ai < 2; ++ai)
#pragma unroll
            for (int m = 0; m < 4; ++m) { const size_t off = (size_t)(row0 + ai * HALF + m * 16) * ldc + col0;
#pragma unroll
                for (int bj = 0; bj < 2; ++bj)
#pragma unroll
                    for (int n = 0; n < 2; ++n) { const f32x4 rs = *(const f32x4*)(rbase + off + bj * HALF + n * 16); *(f32x4*)(C + off + bj * HALF + n * 16) = acc[ai][bj][m][n] + rs; } }
    }
};

template <class Epi, class Sched, bool STAMP = false>
__device__ __forceinline__ void gemm_phase(PG8_LAS unsigned char* lds, const Gemm g, const Sched& S, const Epi& E, unsigned long long* stamps) {
    const int tid = threadIdx.x, wid = __builtin_amdgcn_readfirstlane(tid >> 6), lane = tid & 63, wr = wid >> 2, wc = wid & 3, fr = lane & 15, fq = lane >> 4;
    const int K = g.K, nt = K / BK;
    int ts_lo = 0, ts_hi = 0, nts = 0; const unsigned long long rt_entry = STAMP ? (unsigned long long)wall_clock64() : 0ull;
#define PG8_STAMP() do { if (STAMP && wid == 0 && nts < 64) { const unsigned long long _c = (unsigned long long)clock64(); \
        ts_lo = (lane == nts) ? (int)(unsigned)_c : ts_lo; ts_hi = (lane == nts) ? (int)(unsigned)(_c >> 32) : ts_hi; ++nts; } } while (0)
    PG8_STAMP();
    unsigned voffA[2], voffB[2];
#pragma unroll
    for (int i = 0; i < 2; ++i) { int R, C; stage_rc(tid * 16 + i * 8192, R, C); const int Rb = Epi::PERM ? ((R & ~31) + perm32(R & 31)) : R;
        voffA[i] = (unsigned)(R * K + C) * 2u; voffB[i] = (unsigned)(Rb * K + C) * 2u; }
    const size_t kstep = (size_t)(BK * 2);
    const size_t hstep = (size_t)HALF * K * 2;
    const size_t tstep = 2 * hstep;
    const unsigned ldsw = (unsigned)wid * 1024u;
    const int aoff = lds_byte(wr * 64 + fr, fq * 8), boff = lds_byte(wc * 32 + fr, fq * 8);
#define PG8_SA(b, h) (((b) * 2 + (h)) * HTB)
#define PG8_SB(b, h) ((4 + (b) * 2 + (h)) * HTB)
#define PG8_STAGE(bufoff, gbase, voff) do { _Pragma("unroll") for (int _i = 0; _i < 2; ++_i) \
        __builtin_amdgcn_global_load_lds((const unsigned*)((const char*)(gbase) + (voff)[_i]), (PG8_LAS unsigned*)(lds + (bufoff) + ldsw + _i * 8192), 16, 0, 0); } while (0)
#define PG8_LDA(dst, b, h) do { _Pragma("unroll") for (int m = 0; m < 4; ++m) _Pragma("unroll") for (int k = 0; k < 2; ++k) dst[m][k] = *(const PG8_LAS bf16x8*)(lds + PG8_SA(b, h) + aoff + m * 2048 + k * 1024); } while (0)
#define PG8_LDB(dst, b, h) do { _Pragma("unroll") for (int n = 0; n < 2; ++n) _Pragma("unroll") for (int k = 0; k < 2; ++k) dst[n][k] = *(const PG8_LAS bf16x8*)(lds + PG8_SB(b, h) + boff + n * 2048 + k * 1024); } while (0)
#define PG8_MMA(ai, bj, At, Bt) do { __builtin_amdgcn_s_setprio(1); _Pragma("unroll") for (int m = 0; m < 4; ++m) _Pragma("unroll") for (int n = 0; n < 2; ++n) _Pragma("unroll") for (int k = 0; k < 2; ++k) \
        acc[ai][bj][m][n] = __builtin_amdgcn_mfma_f32_16x16x32_bf16(Bt[n][k], At[m][k], acc[ai][bj][m][n], 0, 0, 0); __builtin_amdgcn_s_setprio(0); } while (0)
#define PG8_WAIT_V(n) asm volatile("s_waitcnt vmcnt(" #n ")" ::: "memory")
#define PG8_WAIT_L(n) asm volatile("s_waitcnt lgkmcnt(" #n ")" ::: "memory")
#define PG8_BAR __builtin_amdgcn_s_barrier()
#define PG8_SCHED __builtin_amdgcn_sched_barrier(0)
    Unit cur, nxt; int ui = 0;
    if (!S.next(0, cur)) return;
    f32x4 acc[2][2][4][2];
#pragma unroll
    for (int a = 0; a < 2; ++a)
#pragma unroll
        for (int b = 0; b < 2; ++b)
#pragma unroll
            for (int m = 0; m < 4; ++m)
#pragma unroll
                for (int n = 0; n < 2; ++n) acc[a][b][m][n] = (f32x4){0.f, 0.f, 0.f, 0.f};
    bf16x8 At[4][2], B0[2][2], B1[2][2];
    const char* cA = (const char*)g.A + (size_t)cur.pm * tstep; const char* cB = (const char*)g.Bt + (size_t)cur.pn * tstep;
    S.a_ready(cur);
    PG8_STAGE(PG8_SB(0, 0), cB, voffB); PG8_STAGE(PG8_SA(0, 0), cA, voffA); PG8_STAGE(PG8_SB(0, 1), cB + hstep, voffB); PG8_STAGE(PG8_SA(0, 1), cA + hstep, voffA);
    if (wr == 1) PG8_BAR;
    PG8_WAIT_V(4); PG8_BAR;
    PG8_STAGE(PG8_SB(1, 0), cB + kstep, voffB); PG8_STAGE(PG8_SA(1, 0), cA + kstep, voffA); PG8_STAGE(PG8_SB(1, 1), cB + hstep + kstep, voffB);
    PG8_WAIT_V(6); PG8_BAR;
    PG8_STAMP();
    for (;;) {
        const bool has_next = S.next(ui + 1, nxt);
        const char* nA = has_next ? (const char*)g.A + (size_t)nxt.pm * tstep : cA; const char* nB = has_next ? (const char*)g.Bt + (size_t)nxt.pn * tstep : cB;
        for (int t = 0; t < nt; t += 2) {
            const bool last = (t == nt - 2);
            const char* a1 = cA + (size_t)(t + 1) * kstep;
            const char* a2 = last ? nA : cA + (size_t)(t + 2) * kstep; const char* b2 = last ? nB : cB + (size_t)(t + 2) * kstep;
            const char* a3 = a2 + kstep; const char* b3 = b2 + kstep;
            if (last && has_next) S.a_ready(nxt);
            PG8_LDB(B0, 0, 0); PG8_SCHED; PG8_LDA(At, 0, 0); PG8_STAGE(PG8_SA(1, 1), a1 + hstep, voffA);
            PG8_WAIT_L(8); PG8_BAR; PG8_WAIT_L(0); PG8_MMA(0, 0, At, B0); PG8_BAR; PG8_SCHED;
            PG8_LDB(B1, 0, 1); PG8_STAGE(PG8_SB(0, 0), b2, voffB);
            PG8_BAR; PG8_WAIT_L(0); PG8_MMA(0, 1, At, B1); PG8_BAR;
            PG8_LDA(At, 0, 1); PG8_STAGE(PG8_SA(0, 0), a2, voffA);
            PG8_BAR; PG8_WAIT_L(0); PG8_MMA(1, 0, At, B0); PG8_BAR; PG8_SCHED;
            PG8_STAGE(PG8_SB(0, 1), b2 + hstep, voffB);
            PG8_WAIT_V(6); PG8_BAR; PG8_MMA(1, 1, At, B1); PG8_BAR;
            PG8_LDB(B0, 1, 0); PG8_SCHED; PG8_LDA(At, 1, 0); PG8_STAGE(PG8_SA(0, 1), a2 + hstep, voffA);
            PG8_WAIT_L(8); PG8_BAR; PG8_WAIT_L(0); PG8_MMA(0, 0, At, B0); PG8_BAR; PG8_SCHED;
            PG8_LDB(B1, 1, 1); PG8_STAGE(PG8_SB(1, 0), b3, voffB);
            PG8_BAR; PG8_WAIT_L(0); PG8_MMA(0, 1, At, B1); PG8_BAR;
            PG8_LDA(At, 1, 1); PG8_STAGE(PG8_SA(1, 0), a3, voffA);
            PG8_BAR; PG8_WAIT_L(0); PG8_MMA(1, 0, At, B0); PG8_BAR; PG8_SCHED;
            PG8_STAGE(PG8_SB(1, 1), b3 + hstep, voffB);
            PG8_WAIT_V(6); PG8_BAR; PG8_MMA(1, 1, At, B1); PG8_BAR;
        }
        PG8_STAMP();
        if constexpr (!Epi::AFTER_DRAIN) { E(acc, cur, wr, wc, fr, fq); S.done(cur); }
        PG8_STAMP();
        if (!has_next) break;
#pragma unroll
        for (int a = 0; a < 2; ++a)
#pragma unroll
            for (int b = 0; b < 2; ++b)
#pragma unroll
                for (int m = 0; m < 4; ++m)
#pragma unroll
                    for (int n = 0; n < 2; ++n) acc[a][b][m][n] = (f32x4){0.f, 0.f, 0.f, 0.f};
        cur = nxt; cA = nA; cB = nB; ++ui;
    }
    PG8_WAIT_V(0);
    if (wr == 0) PG8_BAR;
    PG8_BAR;
    if constexpr (Epi::AFTER_DRAIN) { E.fused(acc, cur, wr, wc, fr, fq, lds, wid, lane); S.done(cur); }
    PG8_STAMP();
    if (STAMP && wid == 0) { stamps[lane] = lane < nts ? (((unsigned long long)(unsigned)ts_hi << 32) | (unsigned)ts_lo) : 0ull;
        if (lane == 62) stamps[62] = rt_entry; if (lane == 63) stamps[63] = (unsigned long long)wall_clock64(); }
#undef PG8_STAMP
#undef PG8_SA
#undef PG8_SB
#undef PG8_STAGE
#undef PG8_LDA
#undef PG8_LDB
#undef PG8_MMA
#undef PG8_WAIT_V
#undef PG8_WAIT_L
#undef PG8_BAR
#undef PG8_SCHED
}
}

typedef unsigned short bf16_t;
typedef short bf16x8 __attribute__((ext_vector_type(8)));
typedef float f32x4 __attribute__((ext_vector_type(4)));
typedef unsigned u32x4 __attribute__((ext_vector_type(4)));
typedef unsigned u32x2 __attribute__((ext_vector_type(2)));
constexpr int NB = 12, SL = 8192, T = NB * SL, DM = 1024, NC = 3072, NPROMPT = 8 * SL;
constexpr int DH = 384, DC = 256, DR = 384;
constexpr int C_X0 = 0, C_X1 = 384, C_V = 768, C_CA = 1152, C_CB = 1408, C_RG = 1664, C_GATE = 2048;
constexpr int NFFT = 16384;
constexpr int LDS_BYTES = (NFFT + NFFT / 16) * 8;
constexpr float EPS = 1e-6f;
constexpr int NCHUNK = 16, CHUNK = 512;

constexpr size_t WS_P = 0;
constexpr size_t WS_HY = WS_P + (size_t)T * NC * 2;
constexpr size_t WS_U = WS_HY + (size_t)T * DM * 2;
constexpr size_t WS_KF = WS_U + (size_t)NB * DH * SL * 4;
constexpr size_t WS_WINT = WS_KF + (size_t)DH * NFFT * 8;
constexpr size_t WS_WOUTT = WS_WINT + (size_t)2 * NC * DM * 2;
constexpr size_t WS_PWT = WS_WOUTT + (size_t)2 * DM * DM * 2;
constexpr size_t WS_RGWT = WS_PWT + (size_t)2 * DC * DC * 2;
constexpr size_t WS_AGG = WS_RGWT + (size_t)2 * 2 * 2 * 6 * 64 * 64 * 2;
constexpr size_t WS_END = WS_AGG + (size_t)NB * NCHUNK * 2 * 2 * DR * 4;

struct Params {
    const float* in[31];
    float* out;
    unsigned char* ws;
    int ph_lo, ph_hi;
};
enum { I_XP = 0, I_XS, I_NORMG, I_WIN, I_HCW, I_HCB, I_HW1, I_HB1, I_HW2, I_HB2, I_HW3, I_HB3, I_HW4, I_HFREQ, I_HD, I_CDW, I_CDB, I_CLG, I_CLB, I_CPW, I_CPB,
       I_RCW, I_RCB, I_RWA, I_RBA, I_RWX, I_RBX, I_RLAM, I_GRPG, I_WOUT, I_FING };

__device__ __forceinline__ float bf2f(bf16_t b) { return __uint_as_float(((unsigned)b) << 16); }
__device__ __forceinline__ bf16_t f2bf(float f) { unsigned u = __float_as_uint(f); u += 0x7FFFu + ((u >> 16) & 1u); return (bf16_t)(u >> 16); }
__device__ __forceinline__ unsigned pk2(float lo, float hi) { return (unsigned)f2bf(lo) | ((unsigned)f2bf(hi) << 16); }
__device__ __forceinline__ float wave_sum(float v) {
#pragma unroll
    for (int o = 32; o >= 1; o >>= 1) v += __shfl_xor(v, o);
    return v;
}
__device__ __forceinline__ int launder_tid() { int t = threadIdx.x; asm volatile("" : "+v"(t)); return t; }
__device__ __forceinline__ float sigmoidf_(float x) { return 1.0f / (1.0f + __expf(-x)); }
__device__ __forceinline__ float siluf_(float x) { return x / (1.0f + __expf(-x)); }

__device__ __forceinline__ void transpose_tile(const float* src, int src_ld, bf16_t* dst, int dst_ld, int k0, int n0, float* tile  ) {
    const int tid = threadIdx.x, lo = tid & 63, hi = tid >> 6;
#pragma unroll
    for (int i = 0; i < 8; ++i) { const int kk = i * 8 + hi; tile[kk * 65 + lo] = src[(size_t)(k0 + kk) * src_ld + n0 + lo]; }
    __syncthreads();
#pragma unroll
    for (int i = 0; i < 8; ++i) { const int nn = i * 8 + hi; dst[(size_t)(n0 + nn) * dst_ld + k0 + lo] = f2bf(tile[lo * 65 + nn]); }
    __syncthreads();
}
__device__ __forceinline__ void phase_prep_weights(const Params& p, unsigned char* lds) {
    float* tile = (float*)lds;
    constexpr int N_WIN = 16 * 48, N_WOUT = 16 * 16, N_PW = 16, N_RG = 24;
    constexpr int PER_LAYER = N_WIN + N_WOUT + N_PW + 2 * N_RG;
    for (int it = blockIdx.x; it < 2 * PER_LAYER; it += gridDim.x) {
        const int l = it / PER_LAYER; int r = it % PER_LAYER;
        if (r < N_WIN) { transpose_tile(p.in[I_WIN] + (size_t)l * DM * NC, NC, (bf16_t*)(p.ws + WS_WINT) + (size_t)l * NC * DM, DM, (r / 48) * 64, (r % 48) * 64, tile); continue; }
        r -= N_WIN;
        if (r < N_WOUT) { transpose_tile(p.in[I_WOUT] + (size_t)l * DM * DM, DM, (bf16_t*)(p.ws + WS_WOUTT) + (size_t)l * DM * DM, DM, (r / 16) * 64, (r % 16) * 64, tile); continue; }
        r -= N_WOUT;
        if (r < N_PW) { transpose_tile(p.in[I_CPW] + (size_t)l * DC * DC, DC, (bf16_t*)(p.ws + WS_PWT) + (size_t)l * DC * DC, DC, (r / 4) * 64, (r % 4) * 64, tile); continue; }
        r -= N_PW;
        const int gate = r / N_RG, dh = r % N_RG, dir = dh / 6, h = dh % 6;
        const float* src = p.in[gate ? I_RWX : I_RWA] + ((size_t)(l * 2 + dir) * 6 + h) * 4096;
        bf16_t* dst = (bf16_t*)(p.ws + WS_RGWT) + ((size_t)((l * 2 + dir) * 2 + gate) * 6 + h) * 4096;
        transpose_tile(src, 64, dst, 64, 0, 0, tile);
    }
}

template <bool FINAL>
__device__ __forceinline__ void phase_rmsnorm_rows(const float* xa, const float* xb, const float* g, bf16_t* H, float* outf) {
    const int lane = threadIdx.x & 63, wave = threadIdx.x >> 6;
    f32x4 gv[4];
#pragma unroll
    for (int j = 0; j < 4; ++j) gv[j] = *(const f32x4*)(g + lane * 4 + 256 * j);
    for (int row = blockIdx.x * 8 + wave; row < T; row += gridDim.x * 8) {
        const float* xr = (row < NPROMPT) ? xa + (size_t)row * DM : xb + (size_t)(row - NPROMPT) * DM;
        f32x4 v[4]; float ss = 0.f;
#pragma unroll
        for (int j = 0; j < 4; ++j) { v[j] = *(const f32x4*)(xr + lane * 4 + 256 * j); ss += v[j].x * v[j].x + v[j].y * v[j].y + v[j].z * v[j].z + v[j].w * v[j].w; }
        const float rstd = rsqrtf(wave_sum(ss) * (1.0f / DM) + EPS);
#pragma unroll
        for (int j = 0; j < 4; ++j) {
            const f32x4 o = v[j] * rstd * gv[j];
            if (FINAL) *(f32x4*)(outf + (size_t)row * DM + lane * 4 + 256 * j) = o;
            else { u32x2 w; w.x = pk2(o.x, o.y); w.y = pk2(o.z, o.w); *(u32x2*)(H + (size_t)row * DM + lane * 4 + 256 * j) = w; }
        }
    }
}

__device__ __forceinline__ void phase_filters(const Params& p, int l, unsigned char* lds) {
    float* Z = (float*)lds;
    float* H1 = Z + 32 * 33;
    float* H2 = H1 + 32 * 65;
    float* OT = H2 + 32 * 65;
    const float* w1 = p.in[I_HW1] + (size_t)l * 33 * 64; const float* b1 = p.in[I_HB1] + l * 64;
    const float* w2 = p.in[I_HW2] + (size_t)l * 64 * 64; const float* b2 = p.in[I_HB2] + l * 64;
    const float* w3 = p.in[I_HW3] + (size_t)l * 64 * 64; const float* b3 = p.in[I_HB3] + l * 64;
    const float* w4 = p.in[I_HW4] + (size_t)l * 64 * 768; const float* fr = p.in[I_HFREQ] + l * 64;
    float2* KF = (float2*)(p.ws + WS_KF);
    for (int it = blockIdx.x; it < SL / 32; it += gridDim.x) {
        const int t0 = it * 32; const int tid = launder_tid();
        for (int idx = tid; idx < 32 * 33; idx += 512) {
            const int tl = idx / 33, f = idx % 33; const float t = (float)(t0 + tl);
            float z;
            if (f == 0) z = t / (float)(SL - 1);
            else { const int j = (f - 1) & 15; const float fj = 1e-4f + (float)j * ((15.0f - 1e-4f) / 15.0f); const float ang = 2.0f * fj * t * (1.0f / SL);
                   z = (f <= 16) ? cospif(ang) : -sinpif(ang); }
            Z[tl * 33 + f] = z;
        }
        __syncthreads();
        { const int o = tid & 63; const float frq = fr[o], bb = b1[o];
#pragma unroll
          for (int i = 0; i < 4; ++i) { const int tl = (tid >> 6) + 8 * i; float a = bb;
_Pragma("unroll 3") for (int f = 0; f < 33; ++f) a += Z[tl * 33 + f] * w1[f * 64 + o]; H1[tl * 65 + o] = sinf(frq * a); } }
        __syncthreads();
        { const int o = tid & 63; const float frq = fr[o], bb = b2[o];
#pragma unroll
          for (int i = 0; i < 4; ++i) { const int tl = (tid >> 6) + 8 * i; float a = bb;
_Pragma("unroll 4") for (int f = 0; f < 64; ++f) a += H1[tl * 65 + f] * w2[f * 64 + o]; H2[tl * 65 + o] = sinf(frq * a); } }
        __syncthreads();
        { const int o = tid & 63; const float frq = fr[o], bb = b3[o];
#pragma unroll
          for (int i = 0; i < 4; ++i) { const int tl = (tid >> 6) + 8 * i; float a = bb;
_Pragma("unroll 4") for (int f = 0; f < 64; ++f) a += H2[tl * 65 + f] * w3[f * 64 + o]; H1[tl * 65 + o] = sinf(frq * a); } }
        __syncthreads();
#pragma unroll 1
        for (int cr = tid; cr < 2 * 768; cr += 512) {
            const int c = cr % 768, rnd = cr / 768;
            float acc[16];
#pragma unroll
            for (int tl = 0; tl < 16; ++tl) acc[tl] = 0.f;
#pragma unroll 2
            for (int k = 0; k < 64; ++k) { const float w = w4[k * 768 + c];
#pragma unroll
                for (int tl = 0; tl < 16; ++tl) acc[tl] += H1[(rnd * 16 + tl) * 65 + k] * w; }
#pragma unroll
            for (int tl = 0; tl < 16; ++tl) OT[c * 33 + rnd * 16 + tl] = acc[tl];
        }
        __syncthreads();
        for (int idx = tid; idx < 768 * 32; idx += 512) {
            const int c768 = idx >> 5, tl = idx & 31, t = t0 + tl, c = c768 % DH;
            const float minD = -3.0701134573253944f, maxD = -15.350567286626972f;
            const float delta = fabsf(minD + (maxD - minD) * ((float)c / (float)(DH - 1)));
            const float val = OT[c768 * 33 + tl] * __expf(-((float)t / (float)(SL - 1)) * delta) * (1.0f / NFFT);
            if (c768 < DH) KF[(size_t)c * NFFT + t] = make_float2(val, 0.f);
            else if (t > 0) KF[(size_t)c * NFFT + (NFFT - t)] = make_float2(val, 0.f);
            else KF[(size_t)c * NFFT + SL] = make_float2(0.f, 0.f);
        }
        __syncthreads();
    }
}

__device__ __forceinline__ int PH(int i) { return i + (i >> 4); }
__device__ __forceinline__ float2 cmul(float2 a, float2 b) { return make_float2(a.x * b.x - a.y * b.y, a.x * b.y + a.y * b.x); }
__device__ __forceinline__ float2 tw16(int m, bool inv) {
    const float cs[8] = {1.0f, 0.92387953251128674f, 0.70710678118654752f, 0.38268343236508977f, 0.0f, -0.38268343236508977f, -0.70710678118654752f, -0.92387953251128674f};
    const float sn[8] = {0.0f, 0.38268343236508977f, 0.70710678118654752f, 0.92387953251128674f, 1.0f, 0.92387953251128674f, 0.70710678118654752f, 0.38268343236508977f};
    return make_float2(cs[m], inv ? sn[m] : -sn[m]);
}
template <int LR, bool INV, bool ZEROJ>
__device__ __forceinline__ void bfly(float2 (&x)[1 << LR], float ang0) {
    constexpr int R = 1 << LR;
    float2 w[LR];
    if (!ZEROJ) {
        const float s0 = __builtin_amdgcn_sinf(ang0), c0 = __builtin_amdgcn_cosf(ang0);
        w[0] = make_float2(c0, INV ? s0 : -s0);
#pragma unroll
        for (int t = 1; t < LR; ++t) w[t] = cmul(w[t - 1], w[t - 1]);
    }
#pragma unroll
    for (int tt = 0; tt < LR; ++tt) {
        const int t = INV ? (LR - 1 - tt) : tt;
        const int half = R >> (t + 1);
#pragma unroll
        for (int q = 0; q < R; ++q) {
            if (q & half) continue;
            const int ql = q & (half - 1);
            const int m = (ql << t) * (16 / R);
            float2 tw;
            if (ZEROJ) tw = tw16(m, INV);
            else if (m == 0) tw = w[t];
            else tw = cmul(w[t], tw16(m, INV));
            const bool triv = ZEROJ && (m == 0);
            if (!INV) {
                const float2 a = x[q], b = x[q + half];
                x[q] = make_float2(a.x + b.x, a.y + b.y);
                const float2 d = make_float2(a.x - b.x, a.y - b.y);
                x[q + half] = triv ? d : cmul(d, tw);
            } else {
                const float2 a = x[q]; const float2 b = triv ? x[q + half] : cmul(x[q + half], tw);
                x[q] = make_float2(a.x + b.x, a.y + b.y);
                x[q + half] = make_float2(a.x - b.x, a.y - b.y);
            }
        }
    }
}
template <int LR, bool INV>
__device__ __forceinline__ void fft_pass(float2* X, int Blog) {
    constexpr int R = 1 << LR;
    const int Slog = Blog - LR;
    const int tid0 = launder_tid();
#pragma unroll 1
    for (int id = tid0; id < (NFFT >> LR); id += 512) {
        const int blk = id >> Slog, j = id & ((1 << Slog) - 1);
        const int base = (blk << Blog) + j;
        float2 x[R];
#pragma unroll
        for (int q = 0; q < R; ++q) x[q] = X[PH(base + (q << Slog))];
        bfly<LR, INV, false>(x, (float)j * (1.0f / (float)(1 << Blog)));
#pragma unroll
        for (int q = 0; q < R; ++q) X[PH(base + (q << Slog))] = x[q];
    }
    __syncthreads();
}
template <bool CONV>
__device__ __forceinline__ void fft_mid(float2* X, const float2* kf) {
    const int tid0 = launder_tid();
#pragma unroll 1
    for (int id = tid0; id < (NFFT >> 4); id += 512) {
        float2 x[16];
#pragma unroll
        for (int q = 0; q < 16; ++q) x[q] = X[17 * id + q];
        bfly<4, false, true>(x, 0.f);
        if (CONV) {
#pragma unroll
            for (int q = 0; q < 16; q += 2) { const f32x4 k2 = *(const f32x4*)(kf + 16 * id + q);
                x[q] = cmul(x[q], make_float2(k2.x, k2.y)); x[q + 1] = cmul(x[q + 1], make_float2(k2.z, k2.w)); }
            bfly<4, true, true>(x, 0.f);
        }
#pragma unroll
        for (int q = 0; q < 16; ++q) X[17 * id + q] = x[q];
    }
    __syncthreads();
}
__device__ __forceinline__ void phase_kf_fft(const Params& p, unsigned char* lds) {
    float2* X = (float2*)lds; float2* KF = (float2*)(p.ws + WS_KF);
    for (int c = blockIdx.x; c < DH; c += gridDim.x) {
        float2* kc = KF + (size_t)c * NFFT;
        for (int i = threadIdx.x; i < NFFT; i += 512) X[PH(i)] = kc[i];
        __syncthreads();
        fft_pass<2, false>(X, 14); fft_pass<4, false>(X, 12); fft_pass<4, false>(X, 8); fft_mid<false>(X, nullptr);
        for (int i = threadIdx.x; i < NFFT; i += 512) kc[i] = X[PH(i)];
        __syncthreads();
    }
}
__device__ __forceinline__ void phase_fftconv(const Params& p, int l, unsigned char* lds) {
    float2* X = (float2*)lds; const float2* KF = (const float2*)(p.ws + WS_KF); float* U = (float*)(p.ws + WS_U);
    const float* dsk = p.in[I_HD] + l * DH;
    for (int it = blockIdx.x; it < DH * (NB / 2); it += gridDim.x) {
        const int c = it / (NB / 2), pr = it % (NB / 2);
        float* u1 = U + ((size_t)(2 * pr) * DH + c) * SL; float* u2 = u1 + (size_t)DH * SL;
        for (int i = threadIdx.x; i < SL; i += 512) { X[PH(i)] = make_float2(u1[i], u2[i]); X[PH(i + SL)] = make_float2(0.f, 0.f); }
        __syncthreads();
        fft_pass<2, false>(X, 14); fft_pass<4, false>(X, 12); fft_pass<4, false>(X, 8);
        fft_mid<true>(X, KF + (size_t)c * NFFT);
        fft_pass<4, true>(X, 8); fft_pass<4, true>(X, 12); fft_pass<2, true>(X, 14);
        const float d = dsk[c];
        for (int i = threadIdx.x; i < SL; i += 512) { const float2 y = X[PH(i)]; const float a = u1[i], b = u2[i]; u1[i] = y.x + d * a; u2[i] = y.y + d * b; }
        __syncthreads();
    }
}

__device__ __forceinline__ void phase_hyena_prep(const Params& p, int l, unsigned char* lds) {
    float* tile = (float*)lds;
    const bf16_t* P = (const bf16_t*)(p.ws + WS_P); float* U = (float*)(p.ws + WS_U);
    const float* cw = p.in[I_HCW] + (size_t)l * 3 * 1152; const float* cb = p.in[I_HCB] + l * 1152;
    const int tid = threadIdx.x, cc = tid & 63, tq = tid >> 6;
    for (int it = blockIdx.x; it < NB * 64 * 6; it += gridDim.x) {
        const int cgp = it % 6, tt = (it / 6) % 64, b = it / 384;
        const int c = cgp * 64 + cc, t0 = tt * 128 + tq * 16;
        const float wx0 = cw[C_X1 + c], wx1 = cw[1152 + C_X1 + c], wx2 = cw[2304 + C_X1 + c], bx = cb[C_X1 + c];
        const float wv0 = cw[C_V + c], wv1 = cw[1152 + C_V + c], wv2 = cw[2304 + C_V + c], bv = cb[C_V + c];
        const bf16_t* pb = P + (size_t)b * SL * NC;
        float xm = 0.f, vm = 0.f, x0, v0;
        if (t0 > 0) { xm = bf2f(pb[(size_t)(t0 - 1) * NC + C_X1 + c]); vm = bf2f(pb[(size_t)(t0 - 1) * NC + C_V + c]); }
        x0 = bf2f(pb[(size_t)t0 * NC + C_X1 + c]); v0 = bf2f(pb[(size_t)t0 * NC + C_V + c]);
#pragma unroll
        for (int i = 0; i < 16; ++i) {
            const int t = t0 + i; float xp = 0.f, vp = 0.f;
            if (t + 1 < SL) { xp = bf2f(pb[(size_t)(t + 1) * NC + C_X1 + c]); vp = bf2f(pb[(size_t)(t + 1) * NC + C_V + c]); }
            const float cx = wx0 * xm + wx1 * x0 + wx2 * xp + bx, cv = wv0 * vm + wv1 * v0 + wv2 * vp + bv;
            tile[cc * 129 + tq * 16 + i] = cx * cv;
            xm = x0; x0 = xp; vm = v0; v0 = vp;
        }
        __syncthreads();
#pragma unroll
        for (int i = 0; i < 16; ++i) { const int idx = tid + 512 * i, c2 = idx >> 7, tl = idx & 127;
            U[((size_t)b * DH + cgp * 64 + c2) * SL + tt * 128 + tl] = tile[c2 * 129 + tl]; }
        __syncthreads();
    }
}

__device__ __forceinline__ void phase_conformer(const Params& p, int l, unsigned char* lds) {
    bf16_t* G = (bf16_t*)lds;
    bf16_t* A = (bf16_t*)lds;
    float* CV = (float*)(lds + 49152);
    const bf16_t* P = (const bf16_t*)(p.ws + WS_P); bf16_t* Y = (bf16_t*)(p.ws + WS_HY);
    const bf16_t* PwT = (const bf16_t*)(p.ws + WS_PWT) + (size_t)l * DC * DC;
    const float* dww = p.in[I_CDW] + (size_t)l * 31 * DC; const float* dwb = p.in[I_CDB] + l * DC;
    const float* lng = p.in[I_CLG] + l * DC; const float* lnb = p.in[I_CLB] + l * DC; const float* pwb = p.in[I_CPB] + l * DC;
    const float* gg = p.in[I_GRPG] + l * DM + DH;
    const int tid = threadIdx.x, lane = tid & 63, wave = tid >> 6, fr = lane & 15, fq = lane >> 4;
    for (int it = blockIdx.x; it < NB * (SL / 64); it += gridDim.x) {
        const int b = it / (SL / 64), t0 = (it % (SL / 64)) * 64;
        const bf16_t* pb = P + (size_t)b * SL * NC;
        for (int idx = tid; idx < 94 * 32; idx += 512) {
            const int i = idx >> 5, c8 = (idx & 31) * 8, t = t0 - 15 + i;
            u32x4 o = {0u, 0u, 0u, 0u};
            if (t >= 0 && t < SL) {
                const u32x4 av = *(const u32x4*)(pb + (size_t)t * NC + C_CA + c8), bv = *(const u32x4*)(pb + (size_t)t * NC + C_CB + c8);
#pragma unroll
                for (int j = 0; j < 4; ++j) { const float a0 = __uint_as_float(av[j] << 16), a1 = __uint_as_float(av[j] & 0xffff0000u), b0 = __uint_as_float(bv[j] << 16), b1 = __uint_as_float(bv[j] & 0xffff0000u);
                    o[j] = pk2(a0 * sigmoidf_(b0), a1 * sigmoidf_(b1)); }
            }
            *(u32x4*)(G + i * 256 + c8) = o;
        }
        __syncthreads();
        { const int c = tid & 255, hf = tid >> 8;
          float w[31];
#pragma unroll
          for (int k = 0; k < 31; ++k) w[k] = dww[k * DC + c];
          const float bias = dwb[c];
#pragma unroll 1
          for (int rnd = 0; rnd < 2; ++rnd) {
              const int r0 = hf * 32 + rnd * 16;
              float acc[16];
#pragma unroll
              for (int o = 0; o < 16; ++o) acc[o] = bias;
#pragma unroll
              for (int r = 0; r < 46; ++r) { const float v = bf2f(G[(r0 + r) * 256 + c]);
#pragma unroll
                  for (int o = 0; o < 16; ++o) { if (r - o >= 0 && r - o < 31) acc[o] += w[r - o] * v; } }
#pragma unroll
              for (int o = 0; o < 16; ++o) CV[(r0 + o) * 256 + c] = acc[o];
          } }
        __syncthreads();
#pragma unroll
        for (int i = 0; i < 8; ++i) { const int tl = wave * 8 + i;
            const f32x4 v = *(const f32x4*)(CV + tl * 256 + lane * 4);
            const float mu = wave_sum(v.x + v.y + v.z + v.w) * (1.0f / DC);
            const f32x4 d = v - mu;
            const float var = wave_sum(d.x * d.x + d.y * d.y + d.z * d.z + d.w * d.w) * (1.0f / DC);
            const float rstd = rsqrtf(var + EPS);
            const f32x4 gv = *(const f32x4*)(lng + lane * 4), bv = *(const f32x4*)(lnb + lane * 4);
            f32x4 y = d * rstd * gv + bv;
            u32x2 w; w.x = pk2(siluf_(y.x), siluf_(y.y)); w.y = pk2(siluf_(y.z), siluf_(y.w));
            *(u32x2*)(A + tl * 264 + lane * 4) = w; }
        __syncthreads();
        { f32x4 acc[4][2];
#pragma unroll
          for (int m = 0; m < 4; ++m) { acc[m][0] = (f32x4){0.f, 0.f, 0.f, 0.f}; acc[m][1] = (f32x4){0.f, 0.f, 0.f, 0.f}; }
          const int n0 = wave * 32;
#pragma unroll
          for (int ks = 0; ks < 8; ++ks) {
              bf16x8 bf[2], af[4];
#pragma unroll
              for (int n = 0; n < 2; ++n) bf[n] = *(const bf16x8*)(PwT + (size_t)(n0 + n * 16 + fr) * DC + ks * 32 + fq * 8);
#pragma unroll
              for (int m = 0; m < 4; ++m) af[m] = *(const bf16x8*)(A + (m * 16 + fr) * 264 + ks * 32 + fq * 8);
#pragma unroll
              for (int m = 0; m < 4; ++m)
#pragma unroll
                  for (int n = 0; n < 2; ++n) acc[m][n] = __builtin_amdgcn_mfma_f32_16x16x32_bf16(af[m], bf[n], acc[m][n], 0, 0, 0);
          }
#pragma unroll
          for (int n = 0; n < 2; ++n) { const int col = n0 + n * 16 + fr; const float bb = pwb[col];
#pragma unroll
              for (int m = 0; m < 4; ++m)
#pragma unroll
                  for (int j = 0; j < 4; ++j) CV[(m * 16 + fq * 4 + j) * 256 + col] = acc[m][n][j] + bb; } }
        __syncthreads();
#pragma unroll
        for (int i = 0; i < 8; ++i) { const int tl = wave * 8 + i; const size_t row = (size_t)b * SL + t0 + tl;
            const f32x4 v = *(const f32x4*)(CV + tl * 256 + lane * 4);
            const float rstd = rsqrtf(wave_sum(v.x * v.x + v.y * v.y + v.z * v.z + v.w * v.w) * (1.0f / DC) + EPS);
            const f32x4 gv = *(const f32x4*)(gg + lane * 4);
            const u32x2 gt = *(const u32x2*)(P + row * NC + C_GATE + DH + lane * 4);
            const float g0 = __uint_as_float(gt.x << 16), g1 = __uint_as_float(gt.x & 0xffff0000u), g2 = __uint_as_float(gt.y << 16), g3 = __uint_as_float(gt.y & 0xffff0000u);
            u32x2 w; w.x = pk2(v.x * rstd * gv.x * siluf_(g0), v.y * rstd * gv.y * siluf_(g1)); w.y = pk2(v.z * rstd * gv.z * siluf_(g2), v.w * rstd * gv.w * siluf_(g3));
            *(u32x2*)(Y + row * DM + DH + lane * 4) = w; }
        __syncthreads();
    }
}

template <bool PASSB>
__device__ __forceinline__ void phase_rglru(const Params& p, int l, unsigned char* lds) {
    float* XRF = (float*)lds;
    bf16_t* XRB = (bf16_t*)(lds + 32768);
    float* AS = (float*)(lds + 32768 + 18432);
    float* BS = AS + 128 * 64;
    float* SEGA = BS + 128 * 64;
    float* SEGB = SEGA + 512;
    float* CARRY = SEGB + 512;
    bf16_t* P = (bf16_t*)(p.ws + WS_P); float* AGG = (float*)(p.ws + WS_AGG);
    const float* cw = p.in[I_RCW] + (size_t)l * 4 * DR; const float* cb = p.in[I_RCB] + l * DR;
    const int tid = threadIdx.x, lane = tid & 63, wave = tid >> 6, fr = lane & 15, fq = lane >> 4;
    const int cc = tid & 63, seg = tid >> 6;
    const int mh = wave >> 2, jq = wave & 3;
    for (int it = blockIdx.x; it < NB * 6 * NCHUNK * 2; it += gridDim.x) {
        const int dir = it & 1, ch = (it >> 1) % NCHUNK, h = ((it >> 1) / NCHUNK) % 6, b = (it >> 1) / (NCHUNK * 6);
        bf16_t* pb = P + (size_t)b * SL * NC;
        bf16x8 Ba[2], Bx[2];
        { const bf16_t* wa = (const bf16_t*)(p.ws + WS_RGWT) + ((size_t)((l * 2 + dir) * 2 + 0) * 6 + h) * 4096;
          const bf16_t* wx = (const bf16_t*)(p.ws + WS_RGWT) + ((size_t)((l * 2 + dir) * 2 + 1) * 6 + h) * 4096;
#pragma unroll
          for (int ks = 0; ks < 2; ++ks) { Ba[ks] = *(const bf16x8*)(wa + (jq * 16 + fr) * 64 + ks * 32 + fq * 8); Bx[ks] = *(const bf16x8*)(wx + (jq * 16 + fr) * 64 + ks * 32 + fq * 8); } }
        const int gch = h * 64 + jq * 16 + fr;
        const float bga = p.in[I_RBA][(l * 2 + dir) * DR + gch], bgx = p.in[I_RBX][(l * 2 + dir) * DR + gch];
        const float lam = p.in[I_RLAM][(l * 2 + dir) * DR + gch];
        const float sp8 = 8.0f * log1pf(__expf(-lam));
        const int c = h * 64 + cc;
        const float w0 = cw[c], w1 = cw[DR + c], w2 = cw[2 * DR + c], w3 = cw[3 * DR + c], cbias = cb[c];
        if (tid < 64) {
            float cin = 0.f;
            if (PASSB) {
                if (dir == 0) { for (int j = 0; j < ch; ++j) { const float* ag = AGG + ((size_t)((b * NCHUNK + j) * 2 + 0) * 2) * DR + c; cin = ag[0] * cin + ag[DR]; } }
                else { for (int j = NCHUNK - 1; j > ch; --j) { const float* ag = AGG + ((size_t)((b * NCHUNK + j) * 2 + 1) * 2) * DR + c; cin = ag[0] * cin + ag[DR]; } }
            }
            CARRY[tid] = cin;
        }
        float totA = 1.f;
        for (int s = 0; s < 4; ++s) {
            const int st = dir ? 3 - s : s, t0 = ch * CHUNK + st * 128;
            { const int ta = t0 + seg * 16;
              float pm2 = (ta - 2 >= 0) ? bf2f(pb[(size_t)(ta - 2) * NC + C_RG + c]) : 0.f;
              float pm1 = (ta - 1 >= 0) ? bf2f(pb[(size_t)(ta - 1) * NC + C_RG + c]) : 0.f;
              float p0 = bf2f(pb[(size_t)ta * NC + C_RG + c]);
#pragma unroll
              for (int i = 0; i < 16; ++i) { const int t = ta + i;
                  const float pp = (t + 1 < SL) ? bf2f(pb[(size_t)(t + 1) * NC + C_RG + c]) : 0.f;
                  const float xr = w0 * pm2 + w1 * pm1 + w2 * p0 + w3 * pp + cbias;
                  const int tl = seg * 16 + i, si = dir ? 127 - tl : tl;
                  XRF[si * 64 + cc] = xr; XRB[si * 72 + cc] = f2bf(xr);
                  pm2 = pm1; pm1 = p0; p0 = pp; } }
            __syncthreads();
#pragma unroll
            for (int m = 0; m < 4; ++m) {
                f32x4 ga = {0.f, 0.f, 0.f, 0.f}, gx = {0.f, 0.f, 0.f, 0.f};
#pragma unroll
                for (int ks = 0; ks < 2; ++ks) { const bf16x8 af = *(const bf16x8*)(XRB + (mh * 64 + m * 16 + fr) * 72 + ks * 32 + fq * 8);
                    ga = __builtin_amdgcn_mfma_f32_16x16x32_bf16(af, Ba[ks], ga, 0, 0, 0); gx = __builtin_amdgcn_mfma_f32_16x16x32_bf16(af, Bx[ks], gx, 0, 0, 0); }
#pragma unroll
                for (int j = 0; j < 4; ++j) { const int si = mh * 64 + m * 16 + fq * 4 + j, col = jq * 16 + fr;
                    const float r = sigmoidf_(ga[j] + bga), ig = sigmoidf_(gx[j] + bgx);
                    const float la = -sp8 * r; const float a = __expf(la); const float mult = sqrtf(fmaxf(1.0f - __expf(2.0f * la), 0.f));
                    AS[si * 64 + col] = a; BS[si * 64 + col] = mult * ig * XRF[si * 64 + col]; }
            }
            __syncthreads();
            float hl[16], ca[16];
            { float hh = 0.f, cum = 1.f;
#pragma unroll
              for (int i = 0; i < 16; ++i) { const float a = AS[(seg * 16 + i) * 64 + cc], bb = BS[(seg * 16 + i) * 64 + cc]; hh = a * hh + bb; cum *= a; hl[i] = hh; ca[i] = cum; }
              SEGA[seg * 64 + cc] = cum; SEGB[seg * 64 + cc] = hh; }
            __syncthreads();
            float cin = CARRY[cc];
            for (int q = 0; q < seg; ++q) cin = SEGA[q * 64 + cc] * cin + SEGB[q * 64 + cc];
            if (PASSB) {
                bf16_t* dst = pb + (dir ? C_V : C_X1) + c;
#pragma unroll
                for (int i = 0; i < 16; ++i) { const int si = seg * 16 + i, tl = dir ? 127 - si : si; dst[(size_t)(t0 + tl) * NC] = f2bf(hl[i] + ca[i] * cin); }
            }
            float ncar = 0.f, prodA = 1.f;
            if (seg == 7) { ncar = hl[15] + ca[15] * cin;
#pragma unroll
                for (int q = 0; q < 8; ++q) prodA *= SEGA[q * 64 + cc]; }
            __syncthreads();
            if (seg == 7) { CARRY[cc] = ncar; totA *= prodA; }
        }
        __syncthreads();
        if (!PASSB && seg == 7) { float* ag = AGG + ((size_t)((b * NCHUNK + ch) * 2 + dir) * 2) * DR + c; ag[0] = totA; ag[DR] = CARRY[cc]; }
        __syncthreads();
    }
}

__device__ __forceinline__ void phase_finalize(const Params& p, int l, unsigned char* lds) {
    float* UT = (float*)lds;
    const bf16_t* P = (const bf16_t*)(p.ws + WS_P); bf16_t* Y = (bf16_t*)(p.ws + WS_HY); const float* U = (const float*)(p.ws + WS_U);
    const float* cw = p.in[I_HCW] + (size_t)l * 3 * 1152; const float* cb = p.in[I_HCB] + l * 1152; const float* gg = p.in[I_GRPG] + l * DM;
    const int tid = threadIdx.x, lane = tid & 63, wave = tid >> 6;
    float w0[6], w1[6], w2[6], wb[6], ghy[6], grg[6];
#pragma unroll
    for (int q = 0; q < 6; ++q) { const int c = lane + 64 * q; w0[q] = cw[c]; w1[q] = cw[1152 + c]; w2[q] = cw[2304 + c]; wb[q] = cb[c]; ghy[q] = gg[c]; grg[q] = gg[640 + c]; }
    for (int it = blockIdx.x; it < NB * (SL / 64); it += gridDim.x) {
        const int b = it / (SL / 64), t0 = (it % (SL / 64)) * 64;
        for (int idx = tid; idx < DH * 64; idx += 512) { const int c = idx >> 6, tl = idx & 63; UT[c * 65 + tl] = U[((size_t)b * DH + c) * SL + t0 + tl]; }
        __syncthreads();
        const bf16_t* pb = P + (size_t)b * SL * NC;
#pragma unroll 1
        for (int i = 0; i < 8; ++i) { const int tl = wave * 8 + i, t = t0 + tl; const size_t row = (size_t)b * SL + t;
            const bf16_t* pr = pb + (size_t)t * NC;
            float y[6], ss = 0.f;
#pragma unroll
            for (int q = 0; q < 6; ++q) { const int c = lane + 64 * q;
                const float xm = (t > 0) ? bf2f(pr[c - NC]) : 0.f, xc = bf2f(pr[c]), xp = (t + 1 < SL) ? bf2f(pr[c + NC]) : 0.f;
                const float x0 = w0[q] * xm + w1[q] * xc + w2[q] * xp + wb[q];
                y[q] = UT[c * 65 + tl] * x0; ss += y[q] * y[q]; }
            float rstd = rsqrtf(wave_sum(ss) * (1.0f / DH) + EPS);
#pragma unroll
            for (int q = 0; q < 6; ++q) { const int c = lane + 64 * q; Y[row * DM + c] = f2bf(y[q] * rstd * ghy[q] * siluf_(bf2f(pr[C_GATE + c]))); }
            ss = 0.f;
#pragma unroll
            for (int q = 0; q < 6; ++q) { const int c = lane + 64 * q; y[q] = bf2f(pr[C_X1 + c]) + bf2f(pr[C_V + c]); ss += y[q] * y[q]; }
            rstd = rsqrtf(wave_sum(ss) * (1.0f / DR) + EPS);
#pragma unroll
            for (int q = 0; q < 6; ++q) { const int c = lane + 64 * q; Y[row * DM + 640 + c] = f2bf(y[q] * rstd * grg[q] * siluf_(bf2f(pr[C_GATE + 640 + c]))); }
        }
        __syncthreads();
    }
}

constexpr int NPHASE = 13;
template <int PH>
__device__ __forceinline__ void run_phase(const Params& p, unsigned char* lds) {
    if constexpr (PH == 0) {
        phase_prep_weights(p, lds);
        phase_filters(p, 0, lds);
        phase_rmsnorm_rows<false>(p.in[I_XP], p.in[I_XS], p.in[I_NORMG], (bf16_t*)(p.ws + WS_HY), nullptr);
    } else {
        constexpr int l = (PH - 1) / 6, s = (PH - 1) % 6;
        if constexpr (s == 0) {
            pg8::Gemm g; g.A = (const bf16_t*)(p.ws + WS_HY); g.Bt = (const bf16_t*)(p.ws + WS_WINT) + (size_t)l * NC * DM; g.M = T; g.N = NC; g.K = DM;
            pg8::StaticOrder S; S.init(T, NC, (int)gridDim.x, (int)blockIdx.x);
            pg8::EpiBf16 E; E.O = (bf16_t*)(p.ws + WS_P); E.ldc = NC;
            pg8::gemm_phase<pg8::EpiBf16, pg8::StaticOrder, false>((PG8_LAS unsigned char*)lds, g, S, E, nullptr);
        } else if constexpr (s == 1) {
            phase_kf_fft(p, lds);
            phase_conformer(p, l, lds);
            phase_hyena_prep(p, l, lds);
            phase_rglru<false>(p, l, lds);
        } else if constexpr (s == 2) {
            phase_fftconv(p, l, lds);
            phase_rglru<true>(p, l, lds);
        } else if constexpr (s == 3) {
            phase_finalize(p, l, lds);
        } else if constexpr (s == 4) {
            pg8::Gemm g; g.A = (const bf16_t*)(p.ws + WS_HY); g.Bt = (const bf16_t*)(p.ws + WS_WOUTT) + (size_t)l * DM * DM; g.M = T; g.N = DM; g.K = DM;
            pg8::StaticOrder S; S.init(T, DM, (int)gridDim.x, (int)blockIdx.x);
            pg8::EpiResF32 E; E.C = p.out; E.ldc = DM; E.split = NPROMPT;
            if (l == 0) { E.ra = p.in[I_XP]; E.rb = p.in[I_XS]; } else { E.ra = p.out; E.rb = p.out + (size_t)NPROMPT * DM; }
            pg8::gemm_phase<pg8::EpiResF32, pg8::StaticOrder, false>((PG8_LAS unsigned char*)lds, g, S, E, nullptr);
        } else {
            if constexpr (l == 0) {
                phase_filters(p, 1, lds);
                phase_rmsnorm_rows<false>(p.out, p.out + (size_t)NPROMPT * DM, p.in[I_NORMG] + DM, (bf16_t*)(p.ws + WS_HY), nullptr);
            } else {
                phase_rmsnorm_rows<true>(p.out, p.out + (size_t)NPROMPT * DM, p.in[I_FING], nullptr, p.out);
            }
        }
    }
}
__global__ __launch_bounds__(512, 2) void mega(Params p) {
    extern __shared__ __attribute__((aligned(16))) unsigned char lds[];
    cg::grid_group grid = cg::this_grid();
#ifndef MK_MASK
#define MK_MASK 0x1fff
#endif
#define RUN_PH(PH) if constexpr ((MK_MASK >> PH) & 1) if (p.ph_lo <= PH && PH < p.ph_hi) { run_phase<PH>(p, lds); asm volatile("" ::: "memory"); if (PH + 1 < p.ph_hi) grid.sync(); }
    RUN_PH(0) RUN_PH(1) RUN_PH(2) RUN_PH(3) RUN_PH(4) RUN_PH(5) RUN_PH(6) RUN_PH(7) RUN_PH(8) RUN_PH(9) RUN_PH(10) RUN_PH(11) RUN_PH(12)
#undef RUN_PH
}

#ifndef MK_LAUNCHES
#define MK_LAUNCHES 1
#endif
extern "C" void kernel_launch(void* const* d_in, const int* in_sizes, int n_in, void* d_out, int out_size, void* d_ws, size_t ws_size, hipStream_t stream) {
    static int grid = 0;
    if (grid == 0) {
        if (n_in != 31 || out_size != T * DM || ws_size < WS_END) { fprintf(stderr, "kernel_launch: unexpected shapes (n_in %d out %d ws %zu need %zu)\n", n_in, out_size, ws_size, (size_t)WS_END); grid = -1; return; }
        int dev = 0, cus = 0, per_cu = 0;
        (void)hipGetDevice(&dev); (void)hipDeviceGetAttribute(&cus, hipDeviceAttributeMultiprocessorCount, dev);
        if (hipFuncSetAttribute((const void*)mega, hipFuncAttributeMaxDynamicSharedMemorySize, LDS_BYTES) != hipSuccess) { fprintf(stderr, "kernel_launch: hipFuncSetAttribute failed\n"); grid = -1; return; }
        if (hipOccupancyMaxActiveBlocksPerMultiprocessor(&per_cu, (const void*)mega, 512, LDS_BYTES) != hipSuccess || per_cu < 1) { fprintf(stderr, "kernel_launch: occupancy query gave %d\n", per_cu); per_cu = 1; }
        (void)hipGetLastError();
        grid = cus * per_cu;
    }
    if (grid < 0) return;
    Params p{};
    for (int i = 0; i < 31; ++i) p.in[i] = (const float*)d_in[i];
    p.out = (float*)d_out; p.ws = (unsigned char*)d_ws;
#if MK_LAUNCHES == 1
    p.ph_lo = 0; p.ph_hi = NPHASE;
    void* args[] = {&p};
    hipError_t e = hipLaunchCooperativeKernel((const void*)mega, dim3(grid), dim3(512), args, LDS_BYTES, stream);
    if (e != hipSuccess) fprintf(stderr, "cooperative launch failed: %s (grid %d)\n", hipGetErrorString(e), grid);
#else
    for (int ph = 0; ph < NPHASE; ++ph) { p.ph_lo = ph; p.ph_hi = ph + 1; hipLaunchKernelGGL(mega, dim3(grid), dim3(512), LDS_BYTES, stream, p); }
#endif
}
```

```cpp
#include <hip/hip_runtime.h>
#include <hip/hip_cooperative_groups.h>
#include <cstdio>
#include <cstdint>
namespace cg = cooperative_groups;

namespace pg8 {
#define PG8_LAS __attribute__((address_space(3)))
typedef unsigned short bf16_t;
typedef short bf16x8 __attribute__((ext_vector_type(8)));
typedef float f32x4 __attribute__((ext_vector_type(4)));
typedef unsigned u32x4 __attribute__((ext_vector_type(4)));
constexpr int BM = 256, BK = 64, HALF = 128, HTB = HALF * BK * 2, STAGE_BYTES = 8 * HTB, NXCD = 8, WGM = 8;

__host__ __device__ __forceinline__ int lds_byte(int r, int c) { const int st = (r >> 4) * 2 + (c >> 5), rr = r & 15, cc = c & 31, ob = rr * 64 + cc * 2; return st * 1024 + (ob ^ (((ob >> 9) & 1) << 5)); }
__host__ __device__ __forceinline__ void stage_rc(int b, int& R, int& C) { const int st = b / 1024, sb = b % 1024, swz = sb ^ (((sb >> 9) & 1) << 5); R = (st >> 1) * 16 + swz / 64; C = (st & 1) * 32 + (swz % 64) / 2; }
__host__ __device__ __forceinline__ int perm32(int rho) { const int n = rho >> 4, i = rho & 15; return 8 * (i >> 2) + 4 * n + (i & 3); }

struct Unit { int pm, pn; };
struct Gemm { const bf16_t* A; const bf16_t* Bt; int M, N, K; };

struct StaticOrder {
    int nM, nN, nwg, G, c, wgm;
    __host__ __device__ void init(int M, int N, int G_, int c_, int wgm_ = WGM) { nM = M / BM; nN = N / BM; nwg = nM * nN; G = G_; c = c_; wgm = wgm_; }
    __host__ __device__ bool next(int i, Unit& u) const {
        const long L = (long)i * G + c; if (L >= nwg) return false;
        int wgid = (int)L; { const int q = nwg / NXCD, r = nwg % NXCD, xcd = wgid % NXCD, off = wgid / NXCD; wgid = (xcd < r ? xcd * (q + 1) : r * (q + 1) + (xcd - r) * q) + off; }
        const int nig = wgm * nN, gid = wgid / nig, fm = gid * wgm, gsz = (nM - fm) < wgm ? (nM - fm) : wgm;
        u.pm = fm + ((wgid % nig) % gsz); u.pn = (wgid % nig) / gsz; return true;
    }
    __device__ __forceinline__ void a_ready(const Unit&) const {}
    __device__ __forceinline__ void done(const Unit&) const {}
};

__device__ __forceinline__ unsigned cvt_pk_bf16(float lo, float hi) { unsigned r; asm volatile("v_cvt_pk_bf16_f32 %0, %1, %2" : "=v"(r) : "v"(lo), "v"(hi)); return r; }

struct EpiBf16 {
    static constexpr bool PERM = true, AFTER_DRAIN = false;
    bf16_t* O; int ldc; const float* ss; float invk, eps; int glu_tiles;
    __device__ __forceinline__ void operator()(const f32x4 (&acc)[2][2][4][2], const Unit& u, int wr, int wc, int fr, int fq) const {
        const int row0 = u.pm * BM + wr * 64 + fr; const int col0 = u.pn * BM + wc * 32 + 8 * fq;
        float sv[2][4];
#pragma unroll
        for (int ai = 0; ai < 2; ++ai)
#pragma unroll
            for (int m = 0; m < 4; ++m) sv[ai][m] = ss[row0 + ai * HALF + m * 16];
        asm volatile("s_waitcnt vmcnt(0)" ::: "memory");
        if (u.pn >= glu_tiles) {
#pragma unroll
            for (int ai = 0; ai < 2; ++ai)
#pragma unroll
                for (int m = 0; m < 4; ++m) { const int row = row0 + ai * HALF + m * 16; bf16_t* rowp = O + (size_t)row * ldc + col0;
                    const float rs = __builtin_amdgcn_rsqf(sv[ai][m] * invk + eps);
#pragma unroll
                    for (int bj = 0; bj < 2; ++bj) { const f32x4 v0 = acc[ai][bj][m][0] * rs, v1 = acc[ai][bj][m][1] * rs;
                        u32x4 w; w.x = cvt_pk_bf16(v0[0], v0[1]); w.y = cvt_pk_bf16(v0[2], v0[3]); w.z = cvt_pk_bf16(v1[0], v1[1]); w.w = cvt_pk_bf16(v1[2], v1[3]);
                        *(u32x4*)(rowp + bj * HALF) = w; } }
        } else {
#pragma unroll
            for (int ai = 0; ai < 2; ++ai)
#pragma unroll
                for (int m = 0; m < 4; ++m) { const int row = row0 + ai * HALF + m * 16; bf16_t* rowp = O + (size_t)row * ldc + col0;
                    const float rs = __builtin_amdgcn_rsqf(sv[ai][m] * invk + eps), rg = -1.4426950408889634f * rs;
                    f32x4 v0 = acc[ai][0][m][0] * rs, v1 = acc[ai][0][m][1] * rs; const f32x4 g0 = acc[ai][1][m][0] * rg, g1 = acc[ai][1][m][1] * rg;
#pragma unroll
                    for (int j = 0; j < 4; ++j) { v0[j] *= __builtin_amdgcn_rcpf(1.0f + __builtin_amdgcn_exp2f(g0[j])); v1[j] *= __builtin_amdgcn_rcpf(1.0f + __builtin_amdgcn_exp2f(g1[j])); }
                    u32x4 w; w.x = cvt_pk_bf16(v0[0], v0[1]); w.y = cvt_pk_bf16(v0[2], v0[3]); w.z = cvt_pk_bf16(v1[0], v1[1]); w.w = cvt_pk_bf16(v1[2], v1[3]);
                    *(u32x4*)rowp = w; }
        }
    }
};
struct EpiResB {
    static constexpr bool PERM = true, AFTER_DRAIN = false;
    bf16_t* O; const bf16_t* R; int ldc; float* ssq;
    __device__ __forceinline__ void operator()(const f32x4 (&acc)[2][2][4][2], const Unit& u, int wr, int wc, int fr, int fq) const {
        const int row0 = u.pm * BM + wr * 64 + fr, col0 = u.pn * BM + wc * 32 + 8 * fq;
#pragma unroll
        for (int ai = 0; ai < 2; ++ai) {
            u32x4 rv[4][2];
#pragma unroll
            for (int m = 0; m < 4; ++m)
#pragma unroll
                for (int bj = 0; bj < 2; ++bj) rv[m][bj] = *(const u32x4*)(R + (size_t)(row0 + ai * HALF + m * 16) * ldc + col0 + bj * HALF);
            asm volatile("s_waitcnt vmcnt(0)" ::: "memory");
#pragma unroll
            for (int m = 0; m < 4; ++m) { const int row = row0 + ai * HALF + m * 16; const size_t off = (size_t)row * ldc + col0; float s2 = 0.f;
#pragma unroll
                for (int bj = 0; bj < 2; ++bj) {
                    f32x4 v0 = acc[ai][bj][m][0], v1 = acc[ai][bj][m][1]; const u32x4 r4 = rv[m][bj];
                    v0[0] += __uint_as_float(r4.x << 16); v0[1] += __uint_as_float(r4.x & 0xffff0000u); v0[2] += __uint_as_float(r4.y << 16); v0[3] += __uint_as_float(r4.y & 0xffff0000u);
                    v1[0] += __uint_as_float(r4.z << 16); v1[1] += __uint_as_float(r4.z & 0xffff0000u); v1[2] += __uint_as_float(r4.w << 16); v1[3] += __uint_as_float(r4.w & 0xffff0000u);
                    s2 += v0[0] * v0[0] + v0[1] * v0[1] + v0[2] * v0[2] + v0[3] * v0[3] + v1[0] * v1[0] + v1[1] * v1[1] + v1[2] * v1[2] + v1[3] * v1[3];
                    u32x4 w; w.x = cvt_pk_bf16(v0[0], v0[1]); w.y = cvt_pk_bf16(v0[2], v0[3]); w.z = cvt_pk_bf16(v1[0], v1[1]); w.w = cvt_pk_bf16(v1[2], v1[3]);
                    *(u32x4*)(O + off + bj * HALF) = w; }
                s2 += __shfl_xor(s2, 16); s2 += __shfl_xor(s2, 32);
                if (fq == 0) atomicAdd(ssq + row, s2); }
        }
    }
};

template <class Epi, class Sched, bool STAMP = false>
__device__ __forceinline__ void gemm_phase(PG8_LAS unsigned char* lds, const Gemm g, const Sched& S, const Epi& E, unsigned long long* stamps) {
    const int tid = threadIdx.x, wid = __builtin_amdgcn_readfirstlane(tid >> 6), lane = tid & 63, wr = wid >> 2, wc = wid & 3, fr = lane & 15, fq = lane >> 4;
    const int K = g.K, nt = K / BK;
    int ts_lo = 0, ts_hi = 0, nts = 0; const unsigned long long rt_entry = STAMP ? (unsigned long long)wall_clock64() : 0ull;
#define PG8_STAMP() do { if (STAMP && wid == 0 && nts < 64) { const unsigned long long _c = (unsigned long long)clock64(); \
        ts_lo = (lane == nts) ? (int)(unsigned)_c : ts_lo; ts_hi = (lane == nts) ? (int)(unsigned)(_c >> 32) : ts_hi; ++nts; } } while (0)
    PG8_STAMP();
    unsigned voffA[2], voffB[2];
#pragma unroll
    for (int i = 0; i < 2; ++i) { int R, C; stage_rc(tid * 16 + i * 8192, R, C); const int Rb = Epi::PERM ? ((R & ~31) + perm32(R & 31)) : R;
        voffA[i] = (unsigned)(R * K + C) * 2u; voffB[i] = (unsigned)(Rb * K + C) * 2u; }
    const size_t kstep = (size_t)(BK * 2);
    const size_t hstep = (size_t)HALF * K * 2;
    const size_t tstep = 2 * hstep;
    const unsigned ldsw = (unsigned)wid * 1024u;
    const int aoff = lds_byte(wr * 64 + fr, fq * 8), boff = lds_byte(wc * 32 + fr, fq * 8);
#define PG8_SA(b, h) (((b) * 2 + (h)) * HTB)
#define PG8_SB(b, h) ((4 + (b) * 2 + (h)) * HTB)
#define PG8_STAGE(bufoff, gbase, voff) do { _Pragma("unroll") for (int _i = 0; _i < 2; ++_i) \
        __builtin_amdgcn_global_load_lds((const unsigned*)((const char*)(gbase) + (voff)[_i]), (PG8_LAS unsigned*)(lds + (bufoff) + ldsw + _i * 8192), 16, 0, 0); } while (0)
#define PG8_LDA(dst, b, h) do { _Pragma("unroll") for (int m = 0; m < 4; ++m) _Pragma("unroll") for (int k = 0; k < 2; ++k) dst[m][k] = *(const PG8_LAS bf16x8*)(lds + PG8_SA(b, h) + aoff + m * 2048 + k * 1024); } while (0)
#define PG8_LDB(dst, b, h) do { _Pragma("unroll") for (int n = 0; n < 2; ++n) _Pragma("unroll") for (int k = 0; k < 2; ++k) dst[n][k] = *(const PG8_LAS bf16x8*)(lds + PG8_SB(b, h) + boff + n * 2048 + k * 1024); } while (0)
#define PG8_MMA(ai, bj, At, Bt) do { __builtin_amdgcn_s_setprio(1); _Pragma("unroll") for (int m = 0; m < 4; ++m) _Pragma("unroll") for (int n = 0; n < 2; ++n) _Pragma("unroll") for (int k = 0; k < 2; ++k) \
        acc[ai][bj][m][n] = __builtin_amdgcn_mfma_f32_16x16x32_bf16(Bt[n][k], At[m][k], acc[ai][bj][m][n], 0, 0, 0); __builtin_amdgcn_s_setprio(0); } while (0)
#define PG8_WAIT_V(n) asm volatile("s_waitcnt vmcnt(" #n ")" ::: "memory")
#define PG8_WAIT_L(n) asm volatile("s_waitcnt lgkmcnt(" #n ")" ::: "memory")
#define PG8_BAR __builtin_amdgcn_s_barrier()
#define PG8_SCHED __builtin_amdgcn_sched_barrier(0)
    Unit cur, nxt; int ui = 0;
    if (!S.next(0, cur)) return;
    f32x4 acc[2][2][4][2];
#pragma unroll
    for (int a = 0; a < 2; ++a)
#pragma unroll
        for (int b = 0; b < 2; ++b)
#pragma unroll
            for (int m = 0; m < 4; ++m)
#pragma unroll
                for (int n = 0; n < 2; ++n) acc[a][b][m][n] = (f32x4){0.f, 0.f, 0.f, 0.f};
    bf16x8 At[4][2], B0[2][2], B1[2][2];
    const char* cA = (const char*)g.A + (size_t)cur.pm * tstep; const char* cB = (const char*)g.Bt + (size_t)cur.pn * tstep;
    S.a_ready(cur);
    PG8_STAGE(PG8_SB(0, 0), cB, voffB); PG8_STAGE(PG8_SA(0, 0), cA, voffA); PG8_STAGE(PG8_SB(0, 1), cB + hstep, voffB); PG8_STAGE(PG8_SA(0, 1), cA + hstep, voffA);
    if (wr == 1) PG8_BAR;
    PG8_WAIT_V(4); PG8_BAR;
    PG8_STAGE(PG8_SB(1, 0), cB + kstep, voffB); PG8_STAGE(PG8_SA(1, 0), cA + kstep, voffA); PG8_STAGE(PG8_SB(1, 1), cB + hstep + kstep, voffB);
    PG8_WAIT_V(6); PG8_BAR;
    PG8_STAMP();
    for (;;) {
        const bool has_next = S.next(ui + 1, nxt);
        const char* nA = has_next ? (const char*)g.A + (size_t)nxt.pm * tstep : cA; const char* nB = has_next ? (const char*)g.Bt + (size_t)nxt.pn * tstep : cB;
        for (int t = 0; t < nt; t += 2) {
            const bool last = (t == nt - 2);
            const char* a1 = cA + (size_t)(t + 1) * kstep;
            const char* a2 = last ? nA : cA + (size_t)(t + 2) * kstep; const char* b2 = last ? nB : cB + (size_t)(t + 2) * kstep;
            const char* a3 = a2 + kstep; const char* b3 = b2 + kstep;
            if (last && has_next) S.a_ready(nxt);
            PG8_LDB(B0, 0, 0); PG8_SCHED; PG8_LDA(At, 0, 0); PG8_STAGE(PG8_SA(1, 1), a1 + hstep, voffA);
            PG8_WAIT_L(8); PG8_BAR; PG8_WAIT_L(0); PG8_MMA(0, 0, At, B0); PG8_BAR; PG8_SCHED;
            PG8_LDB(B1, 0, 1); PG8_STAGE(PG8_SB(0, 0), b2, voffB);
            PG8_BAR; PG8_WAIT_L(0); PG8_MMA(0, 1, At, B1); PG8_BAR;
            PG8_LDA(At, 0, 1); PG8_STAGE(PG8_SA(0, 0), a2, voffA);
            PG8_BAR; PG8_WAIT_L(0); PG8_MMA(1, 0, At, B0); PG8_BAR; PG8_SCHED;
            PG8_STAGE(PG8_SB(0, 1), b2 + hstep, voffB);
            PG8_WAIT_V(6); PG8_BAR; PG8_MMA(1, 1, At, B1); PG8_BAR;
            PG8_LDB(B0, 1, 0); PG8_SCHED; PG8_LDA(At, 1, 0); PG8_STAGE(PG8_SA(0, 1), a2 + hstep, voffA);
            PG8_WAIT_L(8); PG8_BAR; PG8_WAIT_L(0); PG8_MMA(0, 0, At, B0); PG8_BAR; PG8_SCHED;
            PG8_LDB(B1, 1, 1); PG8_STAGE(PG8_SB(1, 0), b3, voffB);
            PG8_BAR; PG8_WAIT_L(0); PG8_MMA(0, 1, At, B1); PG8_BAR;
            PG8_LDA(At, 1, 1); PG8_STAGE(PG8_SA(1, 0), a3, voffA);
            PG8_BAR; PG8_WAIT_L(0); PG8_MMA(1, 0, At, B0); PG8_BAR; PG8_SCHED;
            PG8_STAGE(PG8_SB(1, 1), b3 + hstep, voffB);
            PG8_WAIT_V(6); PG8_BAR; PG8_MMA(1, 1, At, B1); PG8_BAR;
        }
        PG8_STAMP();
        if constexpr (!Epi::AFTER_DRAIN) { E(acc, cur, wr, wc, fr, fq); S.done(cur); }
        PG8_STAMP();
        if (!has_next) break;
#pragma unroll
        for (int a = 0; a < 2; ++a)
#pragma unroll
            for (int b = 0; b < 2; ++b)
#pragma unroll
                for (int m = 0; m < 4; ++m)
#pragma unroll
                    for (int n = 0; n < 2; ++n) acc[a][b][m][n] = (f32x4){0.f, 0.f, 0.f, 0.f};
        cur = nxt; cA = nA; cB = nB; ++ui;
    }
    PG8_WAIT_V(0);
    if (wr == 0) PG8_BAR;
    PG8_BAR;
    if constexpr (Epi::AFTER_DRAIN) { E.fused(acc, cur, wr, wc, fr, fq, lds, wid, lane); S.done(cur); }
    PG8_STAMP();
    if (STAMP && wid == 0) { stamps[lane] = lane < nts ? (((unsigned long long)(unsigned)ts_hi << 32) | (unsigned)ts_lo) : 0ull;
        if (lane == 62) stamps[62] = rt_entry; if (lane == 63) stamps[63] = (unsigned long long)wall_clock64(); }
#undef PG8_STAMP
#undef PG8_SA
#undef PG8_SB
#undef PG8_STAGE
#undef PG8_LDA
#undef PG8_LDB
#undef PG8_MMA
#undef PG8_WAIT_V
#undef PG8_WAIT_L
#undef PG8_BAR
#undef PG8_SCHED
}
}

typedef unsigned short bf16_t;
typedef short bf16x8 __attribute__((ext_vector_type(8)));
typedef float f32x4 __attribute__((ext_vector_type(4)));
typedef unsigned u32x4 __attribute__((ext_vector_type(4)));
typedef unsigned u32x2 __attribute__((ext_vector_type(2)));
constexpr int NB = 12, SL = 8192, T = NB * SL, DM = 1024, NC = 3072, NPROMPT = 8 * SL;
constexpr int DH = 384, DC = 256, DR = 384;
constexpr int C_X0 = 512, C_X1 = 896, C_V = 1280, C_RG = 1664, C_GATE = 2048;
__host__ __device__ __forceinline__ int origcol(int n) {
    if (n < 128) return 1152 + n; if (n < 256) return 1408 + (n - 128); if (n < 384) return 1280 + (n - 256); if (n < 512) return 1536 + (n - 384);
    if (n < 896) return n - 512; if (n < 1280) return 384 + (n - 896); if (n < 1664) return 768 + (n - 1280); return n; }
constexpr int NFFT = 16384;
constexpr int LDS_BYTES = (NFFT + NFFT / 16) * 8;
constexpr float EPS = 1e-6f;
constexpr int NCHUNK = 16, CHUNK = 512;
constexpr int XCD_BAR_WORDS_C = 3456;

constexpr size_t WS_P = 0;
constexpr size_t WS_HY = WS_P + (size_t)T * NC * 2;
constexpr size_t WS_U = WS_HY + (size_t)T * DM * 2;
constexpr size_t WS_KF = WS_U + (size_t)NB * DH * SL * 2;
constexpr size_t WS_WINT = WS_KF + (size_t)DH * NFFT * 8;
constexpr size_t WS_WOUTT = WS_WINT + (size_t)2 * NC * DM * 2;
constexpr size_t WS_PWT = WS_WOUTT + (size_t)2 * DM * DM * 2;
constexpr size_t WS_RGWT = WS_PWT + (size_t)2 * DC * DC * 2;
constexpr size_t WS_AGG = WS_RGWT + (size_t)2 * 2 * 2 * 6 * 64 * 64 * 2;
constexpr size_t WS_BAR = WS_AGG + (size_t)NB * NCHUNK * 2 * 2 * DR * 4;
constexpr int RK_BASE = XCD_BAR_WORDS_C;
constexpr size_t CTL_BYTES = (size_t)(XCD_BAR_WORDS_C + 16 * 64) * 4;
constexpr size_t WS_GRAN = WS_BAR + CTL_BYTES;
constexpr size_t GRAN_BYTES = (size_t)2 * 64 * 144 * 64 * 8;
constexpr size_t WS_SS = WS_GRAN + GRAN_BYTES;
constexpr size_t WS_END = WS_SS + (size_t)3 * T * 4;

struct Params {
    const float* in[31];
    float* out;
    unsigned char* ws;
    int ph_lo, ph_hi;
};
enum { I_XP = 0, I_XS, I_NORMG, I_WIN, I_HCW, I_HCB, I_HW1, I_HB1, I_HW2, I_HB2, I_HW3, I_HB3, I_HW4, I_HFREQ, I_HD, I_CDW, I_CDB, I_CLG, I_CLB, I_CPW, I_CPB,
       I_RCW, I_RCB, I_RWA, I_RBA, I_RWX, I_RBX, I_RLAM, I_GRPG, I_WOUT, I_FING };

__device__ __forceinline__ float bf2f(bf16_t b) { return __uint_as_float(((unsigned)b) << 16); }
__device__ __forceinline__ unsigned pk2(float lo, float hi) { unsigned r; asm("v_cvt_pk_bf16_f32 %0, %1, %2" : "=v"(r) : "v"(lo), "v"(hi)); return r; }
__device__ __forceinline__ bf16_t f2bf(float f) { return (bf16_t)(pk2(f, f) & 0xffffu); }
__device__ __forceinline__ float wave_sum(float v) {
#pragma unroll
    for (int o = 32; o >= 1; o >>= 1) v += __shfl_xor(v, o);
    return v;
}
template <int N>
__device__ __forceinline__ void wave_sum_n(float (&v)[N]) {
#pragma unroll
    for (int o = 32; o >= 1; o >>= 1) {
#pragma unroll
        for (int i = 0; i < N; ++i) v[i] += __shfl_xor(v[i], o); }
}
__device__ __forceinline__ void lds_barrier() { asm volatile("s_waitcnt lgkmcnt(0)" ::: "memory"); __builtin_amdgcn_s_barrier(); asm volatile("" ::: "memory"); }
__device__ __forceinline__ int launder_tid() { int t = threadIdx.x; asm volatile("" : "+v"(t)); return t; }
__device__ __forceinline__ float sigmoidf_(float x) { return __builtin_amdgcn_rcpf(1.0f + __builtin_amdgcn_exp2f(-1.4426950408889634f * x)); }
__device__ __forceinline__ float siluf_(float x) { return x * sigmoidf_(x); }
struct __attribute__((packed, aligned(4))) U3 { unsigned x, y, z; };

__device__ __forceinline__ void transpose_tile(const float* src, int src_ld, bf16_t* dst, int dst_ld, int k0, int n0, float* tile  , const float* kscale = nullptr, int n0src = -1) {
    if (n0src < 0) n0src = n0;
    const int tid = threadIdx.x, lo = tid & 63, hi = tid >> 6;
#pragma unroll
    for (int i = 0; i < 8; ++i) { const int kk = i * 8 + hi; tile[kk * 65 + lo] = src[(size_t)(k0 + kk) * src_ld + n0src + lo] * (kscale ? kscale[k0 + kk] : 1.0f); }
    __syncthreads();
#pragma unroll
    for (int i = 0; i < 8; ++i) { const int nn = i * 8 + hi; dst[(size_t)(n0 + nn) * dst_ld + k0 + lo] = f2bf(tile[lo * 65 + nn]); }
    __syncthreads();
}
__device__ __forceinline__ void phase_prep_weights(const Params& p, unsigned char* lds) {
    float* tile = (float*)lds;
    { u32x4* g = (u32x4*)(p.ws + WS_GRAN); const u32x4 z = {0u, 0u, 0u, 0u};
      for (size_t i = (size_t)blockIdx.x * 512 + threadIdx.x; i < GRAN_BYTES / 16; i += (size_t)gridDim.x * 512) g[i] = z; }
    constexpr int N_WIN = 16 * 48, N_WOUT = 16 * 16, N_PW = 16, N_RG = 24;
    constexpr int PER_LAYER = N_WIN + N_WOUT + N_PW + 2 * N_RG;
    for (int it = blockIdx.x; it < 2 * PER_LAYER; it += gridDim.x) {
        const int l = it / PER_LAYER; int r = it % PER_LAYER;
        if (r < N_WIN) { transpose_tile(p.in[I_WIN] + (size_t)l * DM * NC, NC, (bf16_t*)(p.ws + WS_WINT) + (size_t)l * NC * DM, DM, (r / 48) * 64, (r % 48) * 64, tile, p.in[I_NORMG] + l * DM, origcol((r % 48) * 64)); continue; }
        r -= N_WIN;
        if (r < N_WOUT) { transpose_tile(p.in[I_WOUT] + (size_t)l * DM * DM, DM, (bf16_t*)(p.ws + WS_WOUTT) + (size_t)l * DM * DM, DM, (r / 16) * 64, (r % 16) * 64, tile); continue; }
        r -= N_WOUT;
        if (r < N_PW) { transpose_tile(p.in[I_CPW] + (size_t)l * DC * DC, DC, (bf16_t*)(p.ws + WS_PWT) + (size_t)l * DC * DC, DC, (r / 4) * 64, (r % 4) * 64, tile); continue; }
        r -= N_PW;
        const int gate = r / N_RG, dh = r % N_RG, dir = dh / 6, h = dh % 6;
        const float* src = p.in[gate ? I_RWX : I_RWA] + ((size_t)(l * 2 + dir) * 6 + h) * 4096;
        bf16_t* dst = (bf16_t*)(p.ws + WS_RGWT) + ((size_t)((l * 2 + dir) * 2 + gate) * 6 + h) * 4096;
        transpose_tile(src, 64, dst, 64, 0, 0, tile);
    }
}

__device__ __forceinline__ void phase_x0_prep(const float* xa, const float* xb, bf16_t* H, float* ss) {
    const int lane = threadIdx.x & 63, wave = threadIdx.x >> 6;
    for (int i = blockIdx.x * 512 + threadIdx.x; i < 2 * T; i += gridDim.x * 512) ss[T + i] = 0.f;
    const int NW = gridDim.x * 8;
    for (int row0 = blockIdx.x * 8 + wave; row0 < T; row0 += 4 * NW) {
        f32x4 v[4][4];
#pragma unroll
        for (int r = 0; r < 4; ++r) { const int row = row0 + r * NW;
            if (row < T) { const float* xr = (row < NPROMPT) ? xa + (size_t)row * DM : xb + (size_t)(row - NPROMPT) * DM;
#pragma unroll
                for (int j = 0; j < 4; ++j) v[r][j] = *(const f32x4*)(xr + lane * 4 + 256 * j); } }
#pragma unroll
        for (int r = 0; r < 4; ++r) { const int row = row0 + r * NW;
            if (row < T) { float s2 = 0.f;
#pragma unroll
                for (int j = 0; j < 4; ++j) { s2 += v[r][j].x * v[r][j].x + v[r][j].y * v[r][j].y + v[r][j].z * v[r][j].z + v[r][j].w * v[r][j].w;
                    u32x2 w; w.x = pk2(v[r][j].x, v[r][j].y); w.y = pk2(v[r][j].z, v[r][j].w); *(u32x2*)(H + (size_t)row * DM + lane * 4 + 256 * j) = w; }
                s2 = wave_sum(s2); if (lane == 0) ss[row] = s2; } }
    }
}
__device__ __forceinline__ void phase_final_norm(const bf16_t* x2, const float* ss, const float* g, float* out) {
    const int lane = threadIdx.x & 63, wave = threadIdx.x >> 6;
    f32x4 gv[4];
#pragma unroll
    for (int j = 0; j < 4; ++j) gv[j] = *(const f32x4*)(g + lane * 4 + 256 * j);
    const int NW = gridDim.x * 8;
    for (int row0 = blockIdx.x * 8 + wave; row0 < T; row0 += 4 * NW) {
        u32x2 v[4][4]; float rs[4];
#pragma unroll
        for (int r = 0; r < 4; ++r) { const int row = row0 + r * NW; rs[r] = 0.f;
            if (row < T) { rs[r] = rsqrtf(ss[row] * (1.0f / DM) + EPS);
#pragma unroll
                for (int j = 0; j < 4; ++j) v[r][j] = *(const u32x2*)(x2 + (size_t)row * DM + lane * 4 + 256 * j); } }
#pragma unroll
        for (int r = 0; r < 4; ++r) { const int row = row0 + r * NW;
            if (row < T) {
#pragma unroll
                for (int j = 0; j < 4; ++j) { f32x4 x; x.x = __uint_as_float(v[r][j].x << 16); x.y = __uint_as_float(v[r][j].x & 0xffff0000u); x.z = __uint_as_float(v[r][j].y << 16); x.w = __uint_as_float(v[r][j].y & 0xffff0000u);
                    *(f32x4*)(out + (size_t)row * DM + lane * 4 + 256 * j) = x * rs[r] * gv[j]; } } }
    }
}

__device__ __forceinline__ void phase_filters(const Params& p, int l, unsigned char* lds) {
    float* Z = (float*)lds;
    float* H1 = Z + 32 * 33;
    float* H2 = H1 + 32 * 65;
    float* OT = H2 + 32 * 65;
    const float* w1 = p.in[I_HW1] + (size_t)l * 33 * 64; const float* b1 = p.in[I_HB1] + l * 64;
    const float* w2 = p.in[I_HW2] + (size_t)l * 64 * 64; const float* b2 = p.in[I_HB2] + l * 64;
    const float* w3 = p.in[I_HW3] + (size_t)l * 64 * 64; const float* b3 = p.in[I_HB3] + l * 64;
    const float* w4 = p.in[I_HW4] + (size_t)l * 64 * 768; const float* fr = p.in[I_HFREQ] + l * 64;
    float2* KF = (float2*)(p.ws + WS_KF);
    for (int it = blockIdx.x; it < SL / 32; it += gridDim.x) {
        const int t0 = it * 32; const int tid = launder_tid();
        for (int idx = tid; idx < 32 * 33; idx += 512) {
            const int tl = idx / 33, f = idx % 33; const float t = (float)(t0 + tl);
            float z;
            if (f == 0) z = t / (float)(SL - 1);
            else { const int j = (f - 1) & 15; const float fj = 1e-4f + (float)j * ((15.0f - 1e-4f) / 15.0f); const float ang = 2.0f * fj * t * (1.0f / SL);
                   z = (f <= 16) ? cospif(ang) : -sinpif(ang); }
            Z[tl * 33 + f] = z;
        }
        __syncthreads();
        { const int o = tid & 63; const float frq = fr[o], bb = b1[o];
#pragma unroll
          for (int i = 0; i < 4; ++i) { const int tl = (tid >> 6) + 8 * i; float a = bb;
_Pragma("unroll 3") for (int f = 0; f < 33; ++f) a += Z[tl * 33 + f] * w1[f * 64 + o]; H1[tl * 65 + o] = sinf(frq * a); } }
        __syncthreads();
        { const int o = tid & 63; const float frq = fr[o], bb = b2[o];
#pragma unroll
          for (int i = 0; i < 4; ++i) { const int tl = (tid >> 6) + 8 * i; float a = bb;
_Pragma("unroll 4") for (int f = 0; f < 64; ++f) a += H1[tl * 65 + f] * w2[f * 64 + o]; H2[tl * 65 + o] = sinf(frq * a); } }
        __syncthreads();
        { const int o = tid & 63; const float frq = fr[o], bb = b3[o];
#pragma unroll
          for (int i = 0; i < 4; ++i) { const int tl = (tid >> 6) + 8 * i; float a = bb;
_Pragma("unroll 4") for (int f = 0; f < 64; ++f) a += H2[tl * 65 + f] * w3[f * 64 + o]; H1[tl * 65 + o] = sinf(frq * a); } }
        __syncthreads();
#pragma unroll 1
        for (int cr = tid; cr < 2 * 768; cr += 512) {
            const int c = cr % 768, rnd = cr / 768;
            float acc[16];
#pragma unroll
            for (int tl = 0; tl < 16; ++tl) acc[tl] = 0.f;
#pragma unroll 2
            for (int k = 0; k < 64; ++k) { const float w = w4[k * 768 + c];
#pragma unroll
                for (int tl = 0; tl < 16; ++tl) acc[tl] += H1[(rnd * 16 + tl) * 65 + k] * w; }
#pragma unroll
            for (int tl = 0; tl < 16; ++tl) OT[c * 33 + rnd * 16 + tl] = acc[tl];
        }
        __syncthreads();
        for (int idx = tid; idx < 768 * 32; idx += 512) {
            const int c768 = idx >> 5, tl = idx & 31, t = t0 + tl, c = c768 % DH;
            const float minD = -3.0701134573253944f, maxD = -15.350567286626972f;
            const float delta = fabsf(minD + (maxD - minD) * ((float)c / (float)(DH - 1)));
            const float val = OT[c768 * 33 + tl] * __expf(-((float)t / (float)(SL - 1)) * delta) * (1.0f / NFFT);
            if (c768 < DH) KF[(size_t)c * NFFT + t] = make_float2(val, 0.f);
            else if (t > 0) KF[(size_t)c * NFFT + (NFFT - t)] = make_float2(val, 0.f);
            else KF[(size_t)c * NFFT + SL] = make_float2(0.f, 0.f);
        }
        __syncthreads();
    }
}

__device__ __forceinline__ int PH(int i) { return i + (i >> 4); }
__device__ __forceinline__ float2 opq(float2 v) { asm("" : "+v"(v.x), "+v"(v.y)); return v; }
__device__ __forceinline__ float2 cmul(float2 a, float2 b) { return make_float2(a.x * b.x - a.y * b.y, a.x * b.y + a.y * b.x); }
__device__ __forceinline__ float2 tw16(int m, bool inv) {
    const float cs[8] = {1.0f, 0.92387953251128674f, 0.70710678118654752f, 0.38268343236508977f, 0.0f, -0.38268343236508977f, -0.70710678118654752f, -0.92387953251128674f};
    const float sn[8] = {0.0f, 0.38268343236508977f, 0.70710678118654752f, 0.92387953251128674f, 1.0f, 0.92387953251128674f, 0.70710678118654752f, 0.38268343236508977f};
    return make_float2(cs[m], inv ? sn[m] : -sn[m]);
}
template <int LR, bool INV, bool ZEROJ>
__device__ __forceinline__ void bfly(float2 (&x)[1 << LR], float ang0) {
    constexpr int R = 1 << LR;
    float2 w[LR];
    if (!ZEROJ) {
        const float s0 = __builtin_amdgcn_sinf(ang0), c0 = __builtin_amdgcn_cosf(ang0);
        w[0] = make_float2(c0, INV ? s0 : -s0);
#pragma unroll
        for (int t = 1; t < LR; ++t) w[t] = cmul(w[t - 1], w[t - 1]);
    }
#pragma unroll
    for (int tt = 0; tt < LR; ++tt) {
        const int t = INV ? (LR - 1 - tt) : tt;
        const int half = R >> (t + 1);
#pragma unroll
        for (int q = 0; q < R; ++q) {
            if (q & half) continue;
            const int ql = q & (half - 1);
            const int m = (ql << t) * (16 / R);
            float2 tw;
            if (ZEROJ) tw = tw16(m, INV);
            else if (m == 0) tw = w[t];
            else tw = cmul(w[t], tw16(m, INV));
            const bool triv = ZEROJ && (m == 0);
            if (!INV) {
                const float2 a = x[q], b = x[q + half];
                x[q] = make_float2(a.x + b.x, a.y + b.y);
                const float2 d = make_float2(a.x - b.x, a.y - b.y);
                x[q + half] = triv ? d : cmul(d, tw);
            } else {
                const float2 a = x[q]; const float2 b = triv ? x[q + half] : cmul(x[q + half], tw);
                x[q] = make_float2(a.x + b.x, a.y + b.y);
                x[q + half] = make_float2(a.x - b.x, a.y - b.y);
            }
        }
    }
}
template <int LR, bool INV>
__device__ __forceinline__ void fft_pass(float2* X, int Blog) {
    constexpr int R = 1 << LR;
    const int Slog = Blog - LR;
    const int tid0 = launder_tid();
#pragma unroll 1
    for (int id = tid0; id < (NFFT >> LR); id += 512) {
        const int blk = id >> Slog, j = id & ((1 << Slog) - 1);
        const int base = (blk << Blog) + j;
        float2 x[R];
#pragma unroll
        for (int q = 0; q < R; ++q) x[q] = X[PH(base + (q << Slog))];
        bfly<LR, INV, false>(x, (float)j * (1.0f / (float)(1 << Blog)));
#pragma unroll
        for (int q = 0; q < R; ++q) X[PH(base + (q << Slog))] = opq(x[q]);
    }
    lds_barrier();
}
template <bool CONV>
__device__ __forceinline__ void fft_mid(float2* X, const float2* kf, float2* gout, bool do_store) {
    const int tid0 = launder_tid();
#pragma unroll 1
    for (int id = tid0; id < (NFFT >> 4); id += 512) {
        float2 x[16];
#pragma unroll
        for (int q = 0; q < 16; ++q) x[q] = X[17 * id + q];
        bfly<4, false, true>(x, 0.f);
        if (CONV) {
#pragma unroll
            for (int q = 0; q < 16; ++q) { const float2 k1 = kf[q * 1024 + id]; x[q] = cmul(x[q], k1); }
            bfly<4, true, true>(x, 0.f);
#pragma unroll
            for (int q = 0; q < 16; ++q) X[17 * id + q] = opq(x[q]);
        } else if (do_store) {
#pragma unroll
            for (int q = 0; q < 16; ++q) gout[q * 1024 + id] = opq(x[q]);
        }
    }
    lds_barrier();
}
__device__ __forceinline__ void phase_kf_fft(const Params& p, unsigned char* lds, bool do_store = true) {
    float2* X = (float2*)lds; float2* KF = (float2*)(p.ws + WS_KF);
    const bool xmap = gridDim.x == 256;
    for (int kk = 0; ; ++kk) {
        int c;
        if (xmap) { const int cl = (int)(blockIdx.x >> 3) + 32 * kk; if (cl >= DH / 8) break; c = (int)(blockIdx.x & 7) * (DH / 8) + cl; }
        else { c = (int)blockIdx.x + kk * (int)gridDim.x; if (c >= DH) break; }
        float2* kc = KF + (size_t)c * NFFT;
        const int tid0 = launder_tid();
#pragma unroll 1
        for (int id = tid0; id < 4096; id += 512) {
            float2 x[4];
#pragma unroll
            for (int q = 0; q < 4; ++q) x[q] = kc[id + q * 4096];
            bfly<2, false, false>(x, (float)id * (1.0f / 16384.0f));
#pragma unroll
            for (int q = 0; q < 4; ++q) X[PH(id + q * 4096)] = opq(x[q]);
        }
        lds_barrier();
        fft_pass<4, false>(X, 12); fft_pass<4, false>(X, 8); fft_mid<false>(X, nullptr, kc, do_store);
    }
}
__device__ __forceinline__ void phase_fftconv(const Params& p, int l, unsigned char* lds, bool do_store = true) {
    float2* X = (float2*)lds; const float2* KF = (const float2*)(p.ws + WS_KF); bf16_t* U = (bf16_t*)(p.ws + WS_U);
    const float* dsk = p.in[I_HD] + l * DH;
    for (int it = blockIdx.x; it < DH * (NB / 2); it += gridDim.x) {
        const int xq = it & 7, xr = it >> 3, c = xq * (DH / 8) + xr / (NB / 2), pr = xr % (NB / 2);
        unsigned* u1 = (unsigned*)(U + ((size_t)(2 * pr) * DH + c) * SL); unsigned* u2 = (unsigned*)(U + ((size_t)(2 * pr + 1) * DH + c) * SL);
        const int tid0 = launder_tid();
#pragma unroll 1
        for (int i = 0; i < 4; ++i) { const int k = tid0 + 512 * i;
            const unsigned a0 = u1[k], a1 = u1[k + 2048], b0 = u2[k], b1 = u2[k + 2048];
#pragma unroll
            for (int e = 0; e < 2; ++e) { const int id = 2 * k + e;
                float2 x[4];
                x[0] = make_float2(e ? __uint_as_float(a0 & 0xffff0000u) : __uint_as_float(a0 << 16), e ? __uint_as_float(b0 & 0xffff0000u) : __uint_as_float(b0 << 16));
                x[1] = make_float2(e ? __uint_as_float(a1 & 0xffff0000u) : __uint_as_float(a1 << 16), e ? __uint_as_float(b1 & 0xffff0000u) : __uint_as_float(b1 << 16));
                x[2] = make_float2(0.f, 0.f); x[3] = make_float2(0.f, 0.f);
                bfly<2, false, false>(x, (float)id * (1.0f / 16384.0f));
#pragma unroll
                for (int q = 0; q < 4; ++q) X[PH(id + q * 4096)] = opq(x[q]); } }
        lds_barrier();
        fft_pass<4, false>(X, 12); fft_pass<4, false>(X, 8);
        fft_mid<true>(X, KF + (size_t)c * NFFT, nullptr, false);
        fft_pass<4, true>(X, 8); fft_pass<4, true>(X, 12);
        const float d = dsk[c];
#pragma unroll 1
        for (int i = 0; i < 4; ++i) { const int k = tid0 + 512 * i;
            const unsigned a0 = u1[k], a1 = u1[k + 2048], b0 = u2[k], b1 = u2[k + 2048];
            float2 y0[2], y1[2];
#pragma unroll
            for (int e = 0; e < 2; ++e) { const int id = 2 * k + e;
                float2 x[4];
#pragma unroll
                for (int q = 0; q < 4; ++q) x[q] = X[PH(id + q * 4096)];
                bfly<2, true, false>(x, (float)id * (1.0f / 16384.0f));
                y0[e] = opq(x[0]); y1[e] = opq(x[1]); }
            if (do_store) {
                u1[k] = pk2(y0[0].x + d * __uint_as_float(a0 << 16), y0[1].x + d * __uint_as_float(a0 & 0xffff0000u));
                u1[k + 2048] = pk2(y1[0].x + d * __uint_as_float(a1 << 16), y1[1].x + d * __uint_as_float(a1 & 0xffff0000u));
                u2[k] = pk2(y0[0].y + d * __uint_as_float(b0 << 16), y0[1].y + d * __uint_as_float(b0 & 0xffff0000u));
                u2[k + 2048] = pk2(y1[0].y + d * __uint_as_float(b1 << 16), y1[1].y + d * __uint_as_float(b1 & 0xffff0000u)); } }
        lds_barrier();
    }
}

__device__ __forceinline__ void phase_hyena_prep(const Params& p, int l, unsigned char* lds) {
    bf16_t* RAW = (bf16_t*)lds;
    float* tile = (float*)(lds + 2 * 130 * 64 * 2);
    const bf16_t* P = (const bf16_t*)(p.ws + WS_P); bf16_t* U = (bf16_t*)(p.ws + WS_U);
    const float* cw = p.in[I_HCW] + (size_t)l * 3 * 1152; const float* cb = p.in[I_HCB] + l * 1152;
    u32x4 pf[5];
#define HP_PREFETCH(IT) do { const int _cg = (IT) % 6, _tt = ((IT) / 6) % 64, _b = (IT) / 384, _t0 = _tt * 128; const bf16_t* _pb = P + (size_t)_b * SL * NC; const int _tid = threadIdx.x; \
        _Pragma("unroll") for (int k = 0; k < 5; ++k) { const int idx = _tid + 512 * k, arr = idx / 1040, rem = idx % 1040, r = rem >> 3, sg = rem & 7, t = _t0 - 1 + r; pf[k] = (u32x4){0u, 0u, 0u, 0u}; \
            if (idx < 2080 && t >= 0 && t < SL) pf[k] = *(const u32x4*)(_pb + (size_t)t * NC + (arr ? C_V : C_X1) + _cg * 64 + sg * 8); } } while (0)
    if ((int)blockIdx.x < NB * 64 * 6) { HP_PREFETCH((int)blockIdx.x);
#pragma unroll
        for (int k = 0; k < 5; ++k) { const int idx = (int)threadIdx.x + 512 * k;
            if (idx < 2080) { const int arr = idx / 1040, rem = idx % 1040, r = rem >> 3, sg = rem & 7; *(u32x4*)(RAW + (arr * 130 + r) * 64 + sg * 8) = pf[k]; } } }
    lds_barrier();
    for (int it = blockIdx.x; it < NB * 64 * 6; it += gridDim.x) {
        const int tid = launder_tid(), cc = tid & 63, tq = tid >> 6;
        const int cgp = it % 6, tt = (it / 6) % 64, b = it / 384;
        const int c = cgp * 64 + cc, t0 = tt * 128;
        const float wx0 = cw[384 + c], wx1 = cw[1152 + 384 + c], wx2 = cw[2304 + 384 + c], bx = cb[384 + c];
        const float wv0 = cw[768 + c], wv1 = cw[1152 + 768 + c], wv2 = cw[2304 + 768 + c], bv = cb[768 + c];
        const bool has_next = it + (int)gridDim.x < NB * 64 * 6;
        if (has_next) HP_PREFETCH(it + (int)gridDim.x);
        { const bf16_t* rx = RAW + (tq * 16) * 64 + cc; const bf16_t* rv = rx + 130 * 64;
          float xm = bf2f(rx[0]), x0 = bf2f(rx[64]), vm = bf2f(rv[0]), v0 = bf2f(rv[64]);
#pragma unroll
          for (int i = 0; i < 16; ++i) {
              const float xp = bf2f(rx[(i + 2) * 64]), vp = bf2f(rv[(i + 2) * 64]);
              const float cx = wx0 * xm + wx1 * x0 + wx2 * xp + bx, cv = wv0 * vm + wv1 * v0 + wv2 * vp + bv;
              tile[cc * 129 + tq * 16 + i] = cx * cv;
              xm = x0; x0 = xp; vm = v0; v0 = vp; } }
        lds_barrier();
#pragma unroll
        for (int i = 0; i < 8; ++i) { const int idx = tid + 512 * i, c2 = idx >> 6, tl = (idx & 63) * 2;
            *(unsigned*)(U + ((size_t)b * DH + cgp * 64 + c2) * SL + t0 + tl) = pk2(tile[c2 * 129 + tl], tile[c2 * 129 + tl + 1]); }
        if (has_next) {
#pragma unroll
            for (int k = 0; k < 5; ++k) { const int idx = tid + 512 * k;
                if (idx < 2080) { const int arr = idx / 1040, rem = idx % 1040, r = rem >> 3, sg = rem & 7; *(u32x4*)(RAW + (arr * 130 + r) * 64 + sg * 8) = pf[k]; } } }
        lds_barrier();
    }
#undef HP_PREFETCH
}

__device__ __forceinline__ void phase_conformer(const Params& p, int l, unsigned char* lds) {
    bf16_t* G = (bf16_t*)lds;
    bf16_t* A = (bf16_t*)lds;
    float* CV = (float*)(lds + 49152);
    const bf16_t* P = (const bf16_t*)(p.ws + WS_P); bf16_t* Y = (bf16_t*)(p.ws + WS_HY);
    const bf16_t* PwT = (const bf16_t*)(p.ws + WS_PWT) + (size_t)l * DC * DC;
    const float* dww = p.in[I_CDW] + (size_t)l * 31 * DC; const float* dwb = p.in[I_CDB] + l * DC;
    const float* lng = p.in[I_CLG] + l * DC; const float* lnb = p.in[I_CLB] + l * DC; const float* pwb = p.in[I_CPB] + l * DC;
    const float* gg = p.in[I_GRPG] + l * DM + DH;
    float w[31];
#pragma unroll
    for (int k = 0; k < 31; ++k) w[k] = dww[k * DC + (threadIdx.x & 255)];
    const float bias = dwb[threadIdx.x & 255];
    u32x4 av[6];
#define CF_TILE(IT) ((((IT) & 7) * (NB * (SL / 64) / 8)) + ((IT) >> 3))
#define CF_PREFETCH(IT) do { const int _tile = CF_TILE(IT), _b = _tile / (SL / 64), _t0 = (_tile % (SL / 64)) * 64; const bf16_t* _pb = P + (size_t)_b * SL * NC; const int _tid = threadIdx.x; \
        _Pragma("unroll") for (int k = 0; k < 6; ++k) { const int idx = _tid + 512 * k, i = idx >> 5, c8 = (idx & 31) * 8, t = _t0 - 15 + i; \
            av[k] = (u32x4){0u, 0u, 0u, 0u}; \
            if (idx < 94 * 32 && t >= 0 && t < SL) av[k] = *(const u32x4*)(_pb + (size_t)t * NC + c8 + ((c8 >= 128) ? 128 : 0)); } } while (0)
    if ((int)blockIdx.x < NB * (SL / 64)) CF_PREFETCH((int)blockIdx.x);
    for (int it = blockIdx.x; it < NB * (SL / 64); it += gridDim.x) {
        const int tid = launder_tid(), lane = tid & 63, wave = tid >> 6, fr = lane & 15, fq = lane >> 4;
        const int tile = CF_TILE(it), b = tile / (SL / 64), t0 = (tile % (SL / 64)) * 64;
        const bf16_t* pb = P + (size_t)b * SL * NC;
#pragma unroll
        for (int k = 0; k < 6; ++k) { const int idx = tid + 512 * k, i = idx >> 5, c8 = (idx & 31) * 8;
            if (idx < 94 * 32) *(u32x4*)(G + i * 256 + c8) = av[k]; }
        lds_barrier();
        if (it + (int)gridDim.x < NB * (SL / 64)) CF_PREFETCH(it + (int)gridDim.x);
        { const int c = tid & 255, hf = tid >> 8;
#pragma unroll 1
          for (int rnd = 0; rnd < 2; ++rnd) {
              const int r0 = hf * 32 + rnd * 16;
              float acc[16];
#pragma unroll
              for (int o = 0; o < 16; ++o) acc[o] = bias;
#pragma unroll
              for (int r = 0; r < 46; ++r) { const float v = bf2f(G[(r0 + r) * 256 + c]);
#pragma unroll
                  for (int o = 0; o < 16; ++o) { if (r - o >= 0 && r - o < 31) acc[o] += w[r - o] * v; } }
#pragma unroll
              for (int o = 0; o < 16; ++o) CV[(r0 + o) * 256 + c] = acc[o];
          } }
        lds_barrier();
        { f32x4 v[8]; float s1[8], s2[8];
#pragma unroll
          for (int i = 0; i < 8; ++i) { v[i] = *(const f32x4*)(CV + (wave * 8 + i) * 256 + lane * 4); s1[i] = (v[i].x + v[i].y) + (v[i].z + v[i].w); }
          wave_sum_n<8>(s1);
#pragma unroll
          for (int i = 0; i < 8; ++i) { v[i] = v[i] - s1[i] * (1.0f / DC); s2[i] = (v[i].x * v[i].x + v[i].y * v[i].y) + (v[i].z * v[i].z + v[i].w * v[i].w); }
          wave_sum_n<8>(s2);
          const f32x4 gv = *(const f32x4*)(lng + lane * 4), bv = *(const f32x4*)(lnb + lane * 4);
#pragma unroll
          for (int i = 0; i < 8; ++i) { const float rstd = rsqrtf(s2[i] * (1.0f / DC) + EPS);
              const f32x4 y = v[i] * rstd * gv + bv;
              u32x2 w; w.x = pk2(siluf_(y.x), siluf_(y.y)); w.y = pk2(siluf_(y.z), siluf_(y.w));
              *(u32x2*)(A + (wave * 8 + i) * 264 + lane * 4) = w; } }
        lds_barrier();
        { f32x4 acc[4][2];
#pragma unroll
          for (int m = 0; m < 4; ++m) { acc[m][0] = (f32x4){0.f, 0.f, 0.f, 0.f}; acc[m][1] = (f32x4){0.f, 0.f, 0.f, 0.f}; }
          const int n0 = wave * 32;
#pragma unroll
          for (int ks = 0; ks < 8; ++ks) {
              bf16x8 bf[2], af[4];
#pragma unroll
              for (int n = 0; n < 2; ++n) bf[n] = *(const bf16x8*)(PwT + (size_t)(n0 + n * 16 + fr) * DC + ks * 32 + fq * 8);
#pragma unroll
              for (int m = 0; m < 4; ++m) af[m] = *(const bf16x8*)(A + (m * 16 + fr) * 264 + ks * 32 + fq * 8);
#pragma unroll
              for (int m = 0; m < 4; ++m)
#pragma unroll
                  for (int n = 0; n < 2; ++n) acc[m][n] = __builtin_amdgcn_mfma_f32_16x16x32_bf16(af[m], bf[n], acc[m][n], 0, 0, 0);
          }
#pragma unroll
          for (int n = 0; n < 2; ++n) { const int col = n0 + n * 16 + fr; const float bb = pwb[col];
#pragma unroll
              for (int m = 0; m < 4; ++m)
#pragma unroll
                  for (int j = 0; j < 4; ++j) CV[(m * 16 + fq * 4 + j) * 256 + col] = acc[m][n][j] + bb; } }
        lds_barrier();
        { f32x4 v[8]; float s2[8]; u32x2 gt[8];
#pragma unroll
          for (int i = 0; i < 8; ++i) { const int tl = wave * 8 + i; const size_t row = (size_t)b * SL + t0 + tl;
              gt[i] = *(const u32x2*)(P + row * NC + C_GATE + DH + lane * 4);
              v[i] = *(const f32x4*)(CV + tl * 256 + lane * 4); s2[i] = (v[i].x * v[i].x + v[i].y * v[i].y) + (v[i].z * v[i].z + v[i].w * v[i].w); }
          wave_sum_n<8>(s2);
          const f32x4 gv = *(const f32x4*)(gg + lane * 4);
#pragma unroll
          for (int i = 0; i < 8; ++i) { const int tl = wave * 8 + i; const size_t row = (size_t)b * SL + t0 + tl;
              const float rstd = rsqrtf(s2[i] * (1.0f / DC) + EPS);
              const float g0 = __uint_as_float(gt[i].x << 16), g1 = __uint_as_float(gt[i].x & 0xffff0000u), g2 = __uint_as_float(gt[i].y << 16), g3 = __uint_as_float(gt[i].y & 0xffff0000u);
              u32x2 w; w.x = pk2(v[i].x * rstd * gv.x * siluf_(g0), v[i].y * rstd * gv.y * siluf_(g1)); w.y = pk2(v[i].z * rstd * gv.z * siluf_(g2), v[i].w * rstd * gv.w * siluf_(g3));
              *(u32x2*)(Y + row * DM + DH + lane * 4) = w; } }
        lds_barrier();
    }
}

template <bool PASSB>
__device__ __forceinline__ void phase_rglru(const Params& p, int l, unsigned char* lds) {
    float* XRF = (float*)lds;
    bf16_t* XRB = (bf16_t*)(lds + 32768);
    float* AS = (float*)(lds + 32768 + 18432);
    float* BS = AS + 128 * 64;
    float* SEGA = BS + 128 * 64;
    float* SEGB = SEGA + 512;
    float* CARRY = SEGB + 512;
    bf16_t* RAWR = (bf16_t*)(CARRY + 64);
    bf16_t* P = (bf16_t*)(p.ws + WS_P); float* AGG = (float*)(p.ws + WS_AGG);
    const float* cw = p.in[I_RCW] + (size_t)l * 4 * DR; const float* cb = p.in[I_RCB] + l * DR;
    const int tid = threadIdx.x, lane = tid & 63, wave = tid >> 6, fr = lane & 15, fq = lane >> 4;
    const int cc = tid & 63, seg = tid >> 6;
    const int mh = wave >> 2, jq = wave & 3;
    for (int it = blockIdx.x; it < NB * 6 * NCHUNK * 2; it += gridDim.x) {
        const int dir = it & 1, ch = (it >> 1) % NCHUNK, h = ((it >> 1) / NCHUNK) % 6, b = (it >> 1) / (NCHUNK * 6);
        bf16_t* pb = P + (size_t)b * SL * NC;
        bf16x8 Ba[2], Bx[2];
        { const bf16_t* wa = (const bf16_t*)(p.ws + WS_RGWT) + ((size_t)((l * 2 + dir) * 2 + 0) * 6 + h) * 4096;
          const bf16_t* wx = (const bf16_t*)(p.ws + WS_RGWT) + ((size_t)((l * 2 + dir) * 2 + 1) * 6 + h) * 4096;
#pragma unroll
          for (int ks = 0; ks < 2; ++ks) { Ba[ks] = *(const bf16x8*)(wa + (jq * 16 + fr) * 64 + ks * 32 + fq * 8); Bx[ks] = *(const bf16x8*)(wx + (jq * 16 + fr) * 64 + ks * 32 + fq * 8); } }
        const int gch = h * 64 + jq * 16 + fr;
        const float bga = p.in[I_RBA][(l * 2 + dir) * DR + gch], bgx = p.in[I_RBX][(l * 2 + dir) * DR + gch];
        const float lam = p.in[I_RLAM][(l * 2 + dir) * DR + gch];
        const float sp8l2 = 8.0f * 1.4426950408889634f * log1pf(__expf(-lam));
        const int c = h * 64 + cc;
        const float w0 = cw[c], w1 = cw[DR + c], w2 = cw[2 * DR + c], w3 = cw[3 * DR + c], cbias = cb[c];
        if (tid < 64) {
            float cin = 0.f;
            if (PASSB) {
                if (dir == 0) { for (int j = 0; j < ch; ++j) { const float* ag = AGG + ((size_t)((b * NCHUNK + j) * 2 + 0) * 2) * DR + c; cin = ag[0] * cin + ag[DR]; } }
                else { for (int j = NCHUNK - 1; j > ch; --j) { const float* ag = AGG + ((size_t)((b * NCHUNK + j) * 2 + 1) * 2) * DR + c; cin = ag[0] * cin + ag[DR]; } }
            }
            CARRY[tid] = cin;
        }
        float totA = 1.f;
        for (int s = 0; s < 4; ++s) {
            const int st = dir ? 3 - s : s, t0 = ch * CHUNK + st * 128;
#pragma unroll
            for (int k = 0; k < 3; ++k) { const int idx = tid + 512 * k;
                if (idx < 1048) { const int r = idx >> 3, sg = idx & 7, t = t0 - 2 + r;
                    u32x4 v = {0u, 0u, 0u, 0u};
                    if (t >= 0 && t < SL) v = *(const u32x4*)(pb + (size_t)t * NC + C_RG + h * 64 + sg * 8);
                    *(u32x4*)(RAWR + r * 64 + sg * 8) = v; } }
            __syncthreads();
            { const bf16_t* rr = RAWR + (seg * 16) * 64 + cc;
              float pm2 = bf2f(rr[0]), pm1 = bf2f(rr[64]), p0 = bf2f(rr[128]);
#pragma unroll
              for (int i = 0; i < 16; ++i) {
                  const float pp = bf2f(rr[(i + 3) * 64]);
                  const float xr = w0 * pm2 + w1 * pm1 + w2 * p0 + w3 * pp + cbias;
                  const int tl = seg * 16 + i, si = dir ? 127 - tl : tl;
                  XRF[si * 64 + cc] = xr; XRB[si * 72 + cc] = f2bf(xr);
                  pm2 = pm1; pm1 = p0; p0 = pp; } }
            __syncthreads();
#pragma unroll
            for (int m = 0; m < 4; ++m) {
                f32x4 ga = {0.f, 0.f, 0.f, 0.f}, gx = {0.f, 0.f, 0.f, 0.f};
#pragma unroll
                for (int ks = 0; ks < 2; ++ks) { const bf16x8 af = *(const bf16x8*)(XRB + (mh * 64 + m * 16 + fr) * 72 + ks * 32 + fq * 8);
                    ga = __builtin_amdgcn_mfma_f32_16x16x32_bf16(af, Ba[ks], ga, 0, 0, 0); gx = __builtin_amdgcn_mfma_f32_16x16x32_bf16(af, Bx[ks], gx, 0, 0, 0); }
#pragma unroll
                for (int j = 0; j < 4; ++j) { const int si = mh * 64 + m * 16 + fq * 4 + j, col = jq * 16 + fr;
                    const float r = sigmoidf_(ga[j] + bga), ig = sigmoidf_(gx[j] + bgx);
                    const float la2 = -sp8l2 * r; const float a = __builtin_amdgcn_exp2f(la2); const float mult = __builtin_amdgcn_sqrtf(fmaxf(1.0f - a * a, 0.f));
                    AS[si * 64 + col] = a; BS[si * 64 + col] = mult * ig * XRF[si * 64 + col]; }
            }
            __syncthreads();
            float hl[16], ca[16];
            { float hh = 0.f, cum = 1.f;
#pragma unroll
              for (int i = 0; i < 16; ++i) { const float a = AS[(seg * 16 + i) * 64 + cc], bb = BS[(seg * 16 + i) * 64 + cc]; hh = a * hh + bb; cum *= a; hl[i] = hh; ca[i] = cum; }
              SEGA[seg * 64 + cc] = cum; SEGB[seg * 64 + cc] = hh; }
            __syncthreads();
            float cin = CARRY[cc];
            for (int q = 0; q < seg; ++q) cin = SEGA[q * 64 + cc] * cin + SEGB[q * 64 + cc];
            if (PASSB) {
                bf16_t* dst = pb + (dir ? C_V : C_X1) + c;
#pragma unroll
                for (int i = 0; i < 16; ++i) { const int si = seg * 16 + i, tl = dir ? 127 - si : si; dst[(size_t)(t0 + tl) * NC] = f2bf(hl[i] + ca[i] * cin); }
            }
            float ncar = 0.f, prodA = 1.f;
            if (seg == 7) { ncar = hl[15] + ca[15] * cin;
#pragma unroll
                for (int q = 0; q < 8; ++q) prodA *= SEGA[q * 64 + cc]; }
            __syncthreads();
            if (seg == 7) { CARRY[cc] = ncar; totA *= prodA; }
        }
        __syncthreads();
        if (!PASSB && seg == 7) { float* ag = AGG + ((size_t)((b * NCHUNK + ch) * 2 + dir) * 2) * DR + c; ag[0] = totA; ag[DR] = CARRY[cc]; }
        __syncthreads();
    }
}

constexpr int NSUB = SL / 128, NSEQ = NB * 6 * 2;
__device__ __forceinline__ void phase_rglru_chain(const Params& p, int l, unsigned char* lds) {
    float* XRF = (float*)lds;
    bf16_t* XRB = (bf16_t*)(lds + 32768);
    float* AS = (float*)(lds + 32768 + 18432);
    float* BS = AS + 128 * 64;
    float* SEGA = BS + 128 * 64;
    float* SEGB = SEGA + 512;
    float* CARRY = SEGB + 512;
    bf16_t* RAWR = (bf16_t*)(CARRY + 64);
    bf16_t* P = (bf16_t*)(p.ws + WS_P);
    unsigned long long* GR = (unsigned long long*)(p.ws + WS_GRAN) + (size_t)l * NSUB * NSEQ * 64;
    const float* cw = p.in[I_RCW] + (size_t)l * 4 * DR; const float* cb = p.in[I_RCB] + l * DR;
    u32x4 pf[3];
#define RG_PREFETCH(IT) do { const int _sub = (IT) / NSEQ, _sq = (IT) % NSEQ, _dir = _sq & 1, _h = (_sq >> 1) % 6, _b = (_sq >> 1) / 6; \
        const int _t0 = (_dir ? NSUB - 1 - _sub : _sub) * 128; const bf16_t* _pb = P + (size_t)_b * SL * NC; const int _tid = threadIdx.x; \
        _Pragma("unroll") for (int k = 0; k < 3; ++k) { const int idx = _tid + 512 * k, r = idx >> 3, sg = idx & 7, t = _t0 - 2 + r; pf[k] = (u32x4){0u, 0u, 0u, 0u}; \
            if (idx < 1048 && t >= 0 && t < SL) pf[k] = *(const u32x4*)(_pb + (size_t)t * NC + C_RG + _h * 64 + sg * 8); } } while (0)
    if ((int)blockIdx.x < NSUB * NSEQ) { RG_PREFETCH((int)blockIdx.x);
#pragma unroll
        for (int k = 0; k < 3; ++k) { const int idx = (int)threadIdx.x + 512 * k; if (idx < 1048) *(u32x4*)(RAWR + (idx >> 3) * 64 + (idx & 7) * 8) = pf[k]; } }
    lds_barrier();
    for (int it = blockIdx.x; it < NSUB * NSEQ; it += gridDim.x) {
        const int tid = launder_tid(), lane = tid & 63, wave = tid >> 6, fr = lane & 15, fq = lane >> 4;
        const int cc = tid & 63, seg = tid >> 6, mh = wave >> 2, jq = wave & 3;
        const int sub = it / NSEQ, sq = it % NSEQ, dir = sq & 1, h = (sq >> 1) % 6, b = (sq >> 1) / 6;
        const int st = dir ? NSUB - 1 - sub : sub, t0 = st * 128;
        bf16_t* pb = P + (size_t)b * SL * NC;
        unsigned long long gv0 = 0ull;
        if (wave == 0 && sub > 0) gv0 = __hip_atomic_load(GR + ((size_t)(sub - 1) * NSEQ + sq) * 64 + lane, __ATOMIC_RELAXED, __HIP_MEMORY_SCOPE_AGENT);
        bf16x8 Ba[2], Bx[2];
        { const bf16_t* wa = (const bf16_t*)(p.ws + WS_RGWT) + ((size_t)((l * 2 + dir) * 2 + 0) * 6 + h) * 4096;
          const bf16_t* wx = (const bf16_t*)(p.ws + WS_RGWT) + ((size_t)((l * 2 + dir) * 2 + 1) * 6 + h) * 4096;
#pragma unroll
          for (int ks = 0; ks < 2; ++ks) { Ba[ks] = *(const bf16x8*)(wa + (jq * 16 + fr) * 64 + ks * 32 + fq * 8); Bx[ks] = *(const bf16x8*)(wx + (jq * 16 + fr) * 64 + ks * 32 + fq * 8); } }
        const int gch = h * 64 + jq * 16 + fr;
        const float bga = p.in[I_RBA][(l * 2 + dir) * DR + gch], bgx = p.in[I_RBX][(l * 2 + dir) * DR + gch];
        const float lam = p.in[I_RLAM][(l * 2 + dir) * DR + gch];
        const float sp8l2 = 8.0f * 1.4426950408889634f * log1pf(__expf(-lam));
        const int c = h * 64 + cc;
        const float w0 = cw[c], w1 = cw[DR + c], w2 = cw[2 * DR + c], w3 = cw[3 * DR + c], cbias = cb[c];
        const bool has_next = it + (int)gridDim.x < NSUB * NSEQ;
        if (has_next) RG_PREFETCH(it + (int)gridDim.x);
        { const bf16_t* rr = RAWR + (seg * 16) * 64 + cc;
          float pm2 = bf2f(rr[0]), pm1 = bf2f(rr[64]), p0 = bf2f(rr[128]);
#pragma unroll
          for (int i = 0; i < 16; ++i) {
              const float pp = bf2f(rr[(i + 3) * 64]);
              const float xr = w0 * pm2 + w1 * pm1 + w2 * p0 + w3 * pp + cbias;
              const int tl = seg * 16 + i, si = dir ? 127 - tl : tl;
              XRF[si * 64 + cc] = xr; XRB[si * 72 + cc] = f2bf(xr);
              pm2 = pm1; pm1 = p0; p0 = pp; } }
        lds_barrier();
#pragma unroll
        for (int m = 0; m < 4; ++m) {
            f32x4 ga = {0.f, 0.f, 0.f, 0.f}, gx = {0.f, 0.f, 0.f, 0.f};
#pragma unroll
            for (int ks = 0; ks < 2; ++ks) { const bf16x8 af = *(const bf16x8*)(XRB + (mh * 64 + m * 16 + fr) * 72 + ks * 32 + fq * 8);
                ga = __builtin_amdgcn_mfma_f32_16x16x32_bf16(af, Ba[ks], ga, 0, 0, 0); gx = __builtin_amdgcn_mfma_f32_16x16x32_bf16(af, Bx[ks], gx, 0, 0, 0); }
#pragma unroll
            for (int j = 0; j < 4; ++j) { const int si = mh * 64 + m * 16 + fq * 4 + j, col = jq * 16 + fr;
                const float r = sigmoidf_(ga[j] + bga), ig = sigmoidf_(gx[j] + bgx);
                const float la2 = -sp8l2 * r; const float a = __builtin_amdgcn_exp2f(la2); const float mult = __builtin_amdgcn_sqrtf(fmaxf(1.0f - a * a, 0.f));
                AS[si * 64 + col] = a; BS[si * 64 + col] = mult * ig * XRF[si * 64 + col]; }
        }
        lds_barrier();
        float hl[16], ca[16];
        { float hh = 0.f, cum = 1.f;
#pragma unroll
          for (int i = 0; i < 16; ++i) { const float a = AS[(seg * 16 + i) * 64 + cc], bb = BS[(seg * 16 + i) * 64 + cc]; hh = a * hh + bb; cum *= a; hl[i] = hh; ca[i] = cum; }
          SEGA[seg * 64 + cc] = cum; SEGB[seg * 64 + cc] = hh; }
        if (wave == 0) {
            float cin = 0.f;
            if (sub > 0) {
                unsigned long long* g = GR + ((size_t)(sub - 1) * NSEQ + sq) * 64 + lane;
                unsigned long long v = gv0; unsigned sp = 0;
                while ((unsigned)(v >> 32) != 1u) { __builtin_amdgcn_s_sleep(1); if (++sp > (1u << 22)) break; v = __hip_atomic_load(g, __ATOMIC_RELAXED, __HIP_MEMORY_SCOPE_AGENT); }
                cin = __uint_as_float((unsigned)v);
            }
            CARRY[lane] = cin;
        }
        lds_barrier();
        float cin = CARRY[cc];
        for (int q = 0; q < seg; ++q) cin = SEGA[q * 64 + cc] * cin + SEGB[q * 64 + cc];
        if (seg == 7) {
            const float ncar = hl[15] + ca[15] * cin;
            __hip_atomic_store(GR + ((size_t)sub * NSEQ + sq) * 64 + cc, ((unsigned long long)1u << 32) | (unsigned long long)__float_as_uint(ncar), __ATOMIC_RELAXED, __HIP_MEMORY_SCOPE_AGENT);
        }
        { bf16_t* dst = pb + (dir ? C_V : C_X1) + c;
#pragma unroll
          for (int i = 0; i < 16; ++i) { const int si = seg * 16 + i, tl = dir ? 127 - si : si; dst[(size_t)(t0 + tl) * NC] = f2bf(hl[i] + ca[i] * cin); } }
        if (has_next) {
#pragma unroll
            for (int k = 0; k < 3; ++k) { const int idx = tid + 512 * k; if (idx < 1048) *(u32x4*)(RAWR + (idx >> 3) * 64 + (idx & 7) * 8) = pf[k]; } }
        lds_barrier();
    }
#undef RG_PREFETCH
}

__device__ __forceinline__ void unpack6(const U3 v, float (&o)[6]) {
    o[0] = __uint_as_float(v.x << 16); o[1] = __uint_as_float(v.x & 0xffff0000u); o[2] = __uint_as_float(v.y << 16); o[3] = __uint_as_float(v.y & 0xffff0000u);
    o[4] = __uint_as_float(v.z << 16); o[5] = __uint_as_float(v.z & 0xffff0000u);
}
__device__ __forceinline__ void phase_finalize(const Params& p, int l, unsigned char* lds) {
    float* UT = (float*)lds;
    const bf16_t* P = (const bf16_t*)(p.ws + WS_P); bf16_t* Y = (bf16_t*)(p.ws + WS_HY); const bf16_t* U = (const bf16_t*)(p.ws + WS_U);
    const float* cw = p.in[I_HCW] + (size_t)l * 3 * 1152; const float* cb = p.in[I_HCB] + l * 1152; const float* gg = p.in[I_GRPG] + l * DM;
    const int tid = threadIdx.x, lane = tid & 63, wave = tid >> 6;
    float w0[6], w1[6], w2[6], wb[6], ghy[6], grg[6];
#pragma unroll
    for (int q = 0; q < 6; ++q) { const int c = lane * 6 + q; w0[q] = cw[c]; w1[q] = cw[1152 + c]; w2[q] = cw[2304 + c]; wb[q] = cb[c]; ghy[q] = gg[c]; grg[q] = gg[640 + c]; }
    u32x4 pf[6];
#define FIN_TILE(IT) ((((IT) & 7) * (NB * (SL / 64) / 8)) + ((IT) >> 3))
#define FIN_PREFETCH(IT) do { const int _tile = FIN_TILE(IT), _b = _tile / (SL / 64), _t0 = (_tile % (SL / 64)) * 64; \
        _Pragma("unroll") for (int k = 0; k < 6; ++k) { const int idx = tid + 512 * k, c = idx >> 3, t8 = (idx & 7) * 8; pf[k] = *(const u32x4*)(U + ((size_t)_b * DH + c) * SL + _t0 + t8); } } while (0)
    if ((int)blockIdx.x < NB * (SL / 64)) FIN_PREFETCH((int)blockIdx.x);
    for (int it = blockIdx.x; it < NB * (SL / 64); it += gridDim.x) {
        const int tile = FIN_TILE(it), b = tile / (SL / 64), t0 = (tile % (SL / 64)) * 64;
#pragma unroll
        for (int k = 0; k < 6; ++k) { const int idx = tid + 512 * k, c = idx >> 3, t8 = (idx & 7) * 8;
            const u32x4 v = pf[k];
#pragma unroll
            for (int j = 0; j < 4; ++j) { UT[c * 65 + t8 + 2 * j] = __uint_as_float(v[j] << 16); UT[c * 65 + t8 + 2 * j + 1] = __uint_as_float(v[j] & 0xffff0000u); } }
        lds_barrier();
        if (it + (int)gridDim.x < NB * (SL / 64)) FIN_PREFETCH(it + (int)gridDim.x);
        const bf16_t* pb = P + (size_t)b * SL * NC;
#pragma unroll 4
        for (int i = 0; i < 8; ++i) { const int tl = wave * 8 + i, t = t0 + tl; const size_t row = (size_t)b * SL + t;
            const bf16_t* pq = pb + (size_t)t * NC + lane * 6; const bf16_t* pr = pq + C_X0;
            const int om = (t > 0) ? -NC : 0, op = (t + 1 < SL) ? NC : 0;
            const float fm = (t > 0) ? 1.f : 0.f, fp = (t + 1 < SL) ? 1.f : 0.f;
            const U3 rm = *(const U3*)(pr + om), rc = *(const U3*)pr, rp = *(const U3*)(pr + op), rg = *(const U3*)(pq + C_GATE);
            const U3 rf = *(const U3*)(pq + C_X1), rb = *(const U3*)(pq + C_V), rg2 = *(const U3*)(pq + C_GATE + 640);
            float xm[6], xc[6], xp[6], gt[6], y[6], ss = 0.f;
            unpack6(rm, xm); unpack6(rc, xc); unpack6(rp, xp); unpack6(rg, gt);
#pragma unroll
            for (int q = 0; q < 6; ++q) { const float x0 = w0[q] * (xm[q] * fm) + w1[q] * xc[q] + w2[q] * (xp[q] * fp) + wb[q];
                y[q] = UT[(lane * 6 + q) * 65 + tl] * x0; ss += y[q] * y[q]; }
            float rstd = rsqrtf(wave_sum(ss) * (1.0f / DH) + EPS);
            { U3 o; o.x = pk2(y[0] * rstd * ghy[0] * siluf_(gt[0]), y[1] * rstd * ghy[1] * siluf_(gt[1])); o.y = pk2(y[2] * rstd * ghy[2] * siluf_(gt[2]), y[3] * rstd * ghy[3] * siluf_(gt[3]));
              o.z = pk2(y[4] * rstd * ghy[4] * siluf_(gt[4]), y[5] * rstd * ghy[5] * siluf_(gt[5])); *(U3*)(Y + row * DM + lane * 6) = o; }
            unpack6(rf, xm); unpack6(rb, xc); unpack6(rg2, gt); ss = 0.f;
#pragma unroll
            for (int q = 0; q < 6; ++q) { y[q] = xm[q] + xc[q]; ss += y[q] * y[q]; }
            rstd = rsqrtf(wave_sum(ss) * (1.0f / DR) + EPS);
            { U3 o; o.x = pk2(y[0] * rstd * grg[0] * siluf_(gt[0]), y[1] * rstd * grg[1] * siluf_(gt[1])); o.y = pk2(y[2] * rstd * grg[2] * siluf_(gt[2]), y[3] * rstd * grg[3] * siluf_(gt[3]));
              o.z = pk2(y[4] * rstd * grg[4] * siluf_(gt[4]), y[5] * rstd * grg[5] * siluf_(gt[5])); *(U3*)(Y + row * DM + 640 + lane * 6) = o; }
        }
        lds_barrier();
    }
}

#define XB_TMO      128
#define XB_XCNT(j)  (256  + 64 * (j))
#define XB_XSUB(j)  (1280 + 64 * (j))
#define XB_XGEN(j)  (2304 + 64 * (j))
#define XB_TOP      3328
#define XB_TOPGEN   3392
#define XCD_BAR_WORDS 3456
#define XB_SPIN_CAP (1u << 22)
#define LAS __attribute__((address_space(3)))
__device__ __forceinline__ unsigned xb_ld(unsigned* p)              { return __hip_atomic_load(p, __ATOMIC_RELAXED, __HIP_MEMORY_SCOPE_AGENT); }
__device__ __forceinline__ unsigned xb_add(unsigned* p, unsigned v) { return __hip_atomic_fetch_add(p, v, __ATOMIC_RELAXED, __HIP_MEMORY_SCOPE_AGENT); }
__device__ __forceinline__ unsigned xb_xcc_id() { return (unsigned)__builtin_amdgcn_s_getreg((3 << 11) | 20) & 0xFu; }
#define XB_SPIN(cond, bar) do { unsigned _sp = 0; while (cond) { __builtin_amdgcn_s_sleep(1); \
    if ((++_sp & 255u) == 0u) { if (xb_ld(&(bar)[XB_TMO])) break; if (_sp > XB_SPIN_CAP) { atomicAdd(&(bar)[XB_TMO], 1u); break; } } } } while (0)
struct XcdBarrier { unsigned* bar; unsigned x; volatile LAS unsigned* st; };
__device__ __forceinline__ XcdBarrier xcd_barrier_post(unsigned* bar, volatile LAS unsigned* st) {
    XcdBarrier b; b.bar = bar; b.x = xb_xcc_id(); b.st = st;
    if (threadIdx.x == 0) (void)xb_add(&bar[XB_XCNT(b.x)], 1u);
    return b;
}
__device__ __forceinline__ void xcd_barrier_complete(unsigned* bar, unsigned x, unsigned& nloc, unsigned& nx) {
    const unsigned G = gridDim.x * gridDim.y * gridDim.z;
    unsigned sum, cnt, mine, sp = 0u;
    for (;;) {
        sum = 0u; cnt = 0u; mine = 0u;
#pragma unroll
        for (unsigned j = 0; j < 16; ++j) { const unsigned c = xb_ld(&bar[XB_XCNT(j)]); sum += c; cnt += (c > 0u) ? 1u : 0u; mine = (j == x) ? c : mine; }
        if (sum == G) break;
        __builtin_amdgcn_s_sleep(1);
        if ((++sp & 255u) == 0u) { if (xb_ld(&bar[XB_TMO])) break; if (sp > XB_SPIN_CAP) { atomicAdd(&bar[XB_TMO], 1u); break; } }
    }
    nloc = mine > 0u ? mine : 1u; nx = cnt > 0u ? cnt : 1u;
}
__device__ __forceinline__ void xcd_barrier(const XcdBarrier& b) {
    asm volatile("s_waitcnt vmcnt(0)" ::: "memory");
    __syncthreads();
    if (threadIdx.x == 0) {
        unsigned* bar = b.bar;
        __builtin_amdgcn_s_waitcnt(0);
        unsigned nloc = b.st[0], nx = b.st[1];
        if (nloc == 0u) { xcd_barrier_complete(bar, b.x, nloc, nx); b.st[0] = nloc; b.st[1] = nx; }
        const unsigned old = xb_add(&bar[XB_XSUB(b.x)], 1u);
        const unsigned gen = old / nloc;
        if (old + 1u == (gen + 1u) * nloc) {
            __builtin_amdgcn_fence(__ATOMIC_RELEASE, "agent");
            asm volatile("s_waitcnt vmcnt(0)" ::: "memory");
            const unsigned og = xb_add(&bar[XB_TOP], 1u);
            const unsigned tg = og / nx;
            if (og + 1u == (tg + 1u) * nx) xb_add(&bar[XB_TOPGEN], 1u);
            else XB_SPIN(xb_ld(&bar[XB_TOPGEN]) == tg, bar);
            __builtin_amdgcn_fence(__ATOMIC_ACQUIRE, "agent");
            xb_add(&bar[XB_XGEN(b.x)], 1u);
            asm volatile("s_waitcnt vmcnt(0)" ::: "memory");
        } else {
            XB_SPIN(xb_ld(&bar[XB_XGEN(b.x)]) == gen, bar);
            __builtin_amdgcn_fence(__ATOMIC_ACQUIRE, "agent");
            asm volatile("s_waitcnt vmcnt(0)" ::: "memory");
        }
    }
    __syncthreads();
}

constexpr int NPHASE = 13;
#ifndef MK_DUP
#define MK_DUP 0
#endif
#define DUPN(bit) (((MK_DUP >> (bit)) & 1) ? 2 : 1)
template <int PH>
__device__ __forceinline__ void run_phase(const Params& p, unsigned char* lds, int vc) {
    float* SS = (float*)(p.ws + WS_SS);
    if constexpr (PH == 0) {
        phase_prep_weights(p, lds);
        phase_filters(p, 0, lds);
        phase_x0_prep(p.in[I_XP], p.in[I_XS], (bf16_t*)p.out, SS);
    } else if constexpr (PH == 12) {
        phase_final_norm((const bf16_t*)(p.ws + WS_P), SS + 2 * T, p.in[I_FING], p.out);
    } else {
        constexpr int l = (PH - 1) / 6, s = (PH - 1) % 6;
        if constexpr (s == 0) {
            pg8::Gemm g; g.A = (const bf16_t*)p.out; g.Bt = (const bf16_t*)(p.ws + WS_WINT) + (size_t)l * NC * DM; g.M = T; g.N = NC; g.K = DM;
            pg8::StaticOrder S; S.init(T, NC, (int)gridDim.x, vc);
            pg8::EpiBf16 E; E.O = (bf16_t*)(p.ws + WS_P); E.ldc = NC; E.ss = SS + l * T; E.invk = 1.0f / DM; E.eps = EPS; E.glu_tiles = 2;
            pg8::gemm_phase<pg8::EpiBf16, pg8::StaticOrder, false>((PG8_LAS unsigned char*)lds, g, S, E, nullptr);
        } else if constexpr (s == 1) {
            phase_kf_fft(p, lds);
            for (int r = 0; r < DUPN(0); ++r) phase_conformer(p, l, lds);
            for (int r = 0; r < DUPN(1); ++r) phase_hyena_prep(p, l, lds);
        } else if constexpr (s == 2) {
            phase_fftconv(p, l, lds);
            for (int r = 0; r < DUPN(3); ++r) phase_rglru_chain(p, l, lds);
        } else if constexpr (s == 3) {
            for (int r = 0; r < DUPN(4); ++r) phase_finalize(p, l, lds);
            if constexpr (l == 0) phase_filters(p, 1, lds);
        } else if constexpr (s == 4) {
            pg8::Gemm g; g.A = (const bf16_t*)(p.ws + WS_HY); g.Bt = (const bf16_t*)(p.ws + WS_WOUTT) + (size_t)l * DM * DM; g.M = T; g.N = DM; g.K = DM;
            pg8::StaticOrder S; S.init(T, DM, (int)gridDim.x, vc);
            pg8::EpiResB E; E.R = (const bf16_t*)p.out; E.O = (l == 0) ? (bf16_t*)p.out : (bf16_t*)(p.ws + WS_P); E.ldc = DM; E.ssq = SS + (l + 1) * T;
            pg8::gemm_phase<pg8::EpiResB, pg8::StaticOrder, false>((PG8_LAS unsigned char*)lds, g, S, E, nullptr);
        }
    }
}
__global__ __launch_bounds__(512, 2) void mega(Params p) {
    extern __shared__ __attribute__((aligned(16))) unsigned char lds[];
    cg::grid_group grid = cg::this_grid();
    volatile LAS unsigned* xst = (volatile LAS unsigned*)(PG8_LAS unsigned char*)(lds + LDS_BYTES);
    if (threadIdx.x == 0) { xst[0] = 0u; xst[1] = 0u; xst[2] = blockIdx.x; xst[3] = 0u; }
    __syncthreads();
    const bool multi = (p.ph_hi - p.ph_lo) > 1;
    XcdBarrier xb; xb.bar = (unsigned*)(p.ws + WS_BAR); xb.x = 0; xb.st = xst;
    unsigned myrank = 0u;
    if (multi) { xb = xcd_barrier_post((unsigned*)(p.ws + WS_BAR), xst);
        if (threadIdx.x == 0) myrank = xb_add(&xb.bar[RK_BASE + 64 * xb.x], 1u); }
#ifndef MK_MASK
#define MK_MASK 0x1fff
#endif
#define RUN_PH(PH) if constexpr ((MK_MASK >> PH) & 1) if (p.ph_lo <= PH && PH < p.ph_hi) { run_phase<PH>(p, lds, (int)xst[2]); asm volatile("" ::: "memory"); if (PH + 1 < p.ph_hi) { if (p.ph_lo > 1000) grid.sync(); else xcd_barrier(xb); } }
    RUN_PH(0)
    if (multi) {
        if (threadIdx.x == 0) { bool ok = (gridDim.x % 8u) == 0u;
            for (unsigned j = 0; j < 16; ++j) { const unsigned cnt = xb_ld(&xb.bar[RK_BASE + 64 * j]); if (cnt != ((j < 8u) ? gridDim.x / 8u : 0u)) ok = false; }
            if (ok && xb.x < 8u && myrank < gridDim.x / 8u) xst[2] = myrank * 8u + xb.x; }
        __syncthreads();
    }
    RUN_PH(1) RUN_PH(2) RUN_PH(3) RUN_PH(4) RUN_PH(5) RUN_PH(7) RUN_PH(8) RUN_PH(9) RUN_PH(10) RUN_PH(11) RUN_PH(12)
#undef RUN_PH
}

#ifndef MK_LAUNCHES
#define MK_LAUNCHES 1
#endif
extern "C" void kernel_launch(void* const* d_in, const int* in_sizes, int n_in, void* d_out, int out_size, void* d_ws, size_t ws_size, hipStream_t stream) {
    static int grid = 0;
    if (grid == 0) {
        if (n_in != 31 || out_size != T * DM || ws_size < WS_END) { fprintf(stderr, "kernel_launch: unexpected shapes (n_in %d out %d ws %zu need %zu)\n", n_in, out_size, ws_size, (size_t)WS_END); grid = -1; return; }
        int dev = 0, cus = 0, per_cu = 0;
        (void)hipGetDevice(&dev); (void)hipDeviceGetAttribute(&cus, hipDeviceAttributeMultiprocessorCount, dev);
        if (hipFuncSetAttribute((const void*)mega, hipFuncAttributeMaxDynamicSharedMemorySize, LDS_BYTES + 16) != hipSuccess) { fprintf(stderr, "kernel_launch: hipFuncSetAttribute failed\n"); grid = -1; return; }
        if (hipOccupancyMaxActiveBlocksPerMultiprocessor(&per_cu, (const void*)mega, 512, LDS_BYTES + 16) != hipSuccess || per_cu < 1) { fprintf(stderr, "kernel_launch: occupancy query gave %d\n", per_cu); per_cu = 1; }
        (void)hipGetLastError();
        grid = cus * per_cu;
    }
    if (grid < 0) return;
    if (hipMemsetAsync((char*)d_ws + WS_BAR, 0, CTL_BYTES, stream) != hipSuccess) { fprintf(stderr, "kernel_launch: memset failed\n"); return; }
    Params p{};
    for (int i = 0; i < 31; ++i) p.in[i] = (const float*)d_in[i];
    p.out = (float*)d_out; p.ws = (unsigned char*)d_ws;
#if MK_LAUNCHES == 1
    p.ph_lo = 0; p.ph_hi = NPHASE;
    void* args[] = {&p};
    hipError_t e = hipLaunchCooperativeKernel((const void*)mega, dim3(grid), dim3(512), args, LDS_BYTES + 16, stream);
    if (e != hipSuccess) fprintf(stderr, "cooperative launch failed: %s (grid %d)\n", hipGetErrorString(e), grid);
#else
    for (int ph = 0; ph < NPHASE; ++ph) { p.ph_lo = ph; p.ph_hi = ph + 1; hipLaunchKernelGGL(mega, dim3(grid), dim3(512), LDS_BYTES + 16, stream, p); }
#endif
}
```

```cpp
#include <hip/hip_runtime.h>
#include <hip/hip_cooperative_groups.h>
#include <cstdio>
#include <cstdint>
namespace cg = cooperative_groups;

namespace pg8 {
#define PG8_LAS __attribute__((address_space(3)))
typedef unsigned short bf16_t;
typedef short bf16x8 __attribute__((ext_vector_type(8)));
typedef float f32x4 __attribute__((ext_vector_type(4)));
typedef unsigned u32x4 __attribute__((ext_vector_type(4)));
constexpr int BM = 256, BK = 64, HALF = 128, HTB = HALF * BK * 2, STAGE_BYTES = 8 * HTB, NXCD = 8, WGM = 8;

__host__ __device__ __forceinline__ int lds_byte(int r, int c) { const int st = (r >> 4) * 2 + (c >> 5), rr = r & 15, cc = c & 31, ob = rr * 64 + cc * 2; return st * 1024 + (ob ^ (((ob >> 9) & 1) << 5)); }
__host__ __device__ __forceinline__ void stage_rc(int b, int& R, int& C) { const int st = b / 1024, sb = b % 1024, swz = sb ^ (((sb >> 9) & 1) << 5); R = (st >> 1) * 16 + swz / 64; C = (st & 1) * 32 + (swz % 64) / 2; }
__host__ __device__ __forceinline__ int perm32(int rho) { const int n = rho >> 4, i = rho & 15; return 8 * (i >> 2) + 4 * n + (i & 3); }

struct Unit { int pm, pn; };
struct Gemm { const bf16_t* A; const bf16_t* Bt; int M, N, K; };

struct StaticOrder {
    int nM, nN, nwg, G, c, wgm;
    __host__ __device__ void init(int M, int N, int G_, int c_, int wgm_ = WGM) { nM = M / BM; nN = N / BM; nwg = nM * nN; G = G_; c = c_; wgm = wgm_; }
    __host__ __device__ bool next(int i, Unit& u) const {
        const long L = (long)i * G + c; if (L >= nwg) return false;
        int wgid = (int)L; { const int q = nwg / NXCD, r = nwg % NXCD, xcd = wgid % NXCD, off = wgid / NXCD; wgid = (xcd < r ? xcd * (q + 1) : r * (q + 1) + (xcd - r) * q) + off; }
        const int nig = wgm * nN, gid = wgid / nig, fm = gid * wgm, gsz = (nM - fm) < wgm ? (nM - fm) : wgm;
        u.pm = fm + ((wgid % nig) % gsz); u.pn = (wgid % nig) / gsz; return true;
    }
    __device__ __forceinline__ void a_ready(const Unit&) const {}
    __device__ __forceinline__ void done(const Unit&) const {}
};

__device__ __forceinline__ unsigned cvt_pk_bf16(float lo, float hi) { unsigned r; asm volatile("v_cvt_pk_bf16_f32 %0, %1, %2" : "=v"(r) : "v"(lo), "v"(hi)); return r; }

struct EpiBf16 {
    static constexpr bool PERM = true, AFTER_DRAIN = false;
    bf16_t* O; int ldc; const float* ss; float invk, eps; int glu_tiles;
    __device__ __forceinline__ void operator()(const f32x4 (&acc)[2][2][4][2], const Unit& u, int wr, int wc, int fr, int fq) const {
        const int row0 = u.pm * BM + wr * 64 + fr; const int col0 = u.pn * BM + wc * 32 + 8 * fq;
        float sv[2][4];
#pragma unroll
        for (int ai = 0; ai < 2; ++ai)
#pragma unroll
            for (int m = 0; m < 4; ++m) sv[ai][m] = ss[row0 + ai * HALF + m * 16];
        asm volatile("s_waitcnt vmcnt(0)" ::: "memory");
        if (u.pn >= glu_tiles) {
#pragma unroll
            for (int ai = 0; ai < 2; ++ai)
#pragma unroll
                for (int m = 0; m < 4; ++m) { const int row = row0 + ai * HALF + m * 16; bf16_t* rowp = O + (size_t)row * ldc + col0;
                    const float rs = __builtin_amdgcn_rsqf(sv[ai][m] * invk + eps);
#pragma unroll
                    for (int bj = 0; bj < 2; ++bj) { const f32x4 v0 = acc[ai][bj][m][0] * rs, v1 = acc[ai][bj][m][1] * rs;
                        u32x4 w; w.x = cvt_pk_bf16(v0[0], v0[1]); w.y = cvt_pk_bf16(v0[2], v0[3]); w.z = cvt_pk_bf16(v1[0], v1[1]); w.w = cvt_pk_bf16(v1[2], v1[3]);
                        *(u32x4*)(rowp + bj * HALF) = w; } }
        } else {
#pragma unroll
            for (int ai = 0; ai < 2; ++ai)
#pragma unroll
                for (int m = 0; m < 4; ++m) { const int row = row0 + ai * HALF + m * 16; bf16_t* rowp = O + (size_t)row * ldc + col0;
                    const float rs = __builtin_amdgcn_rsqf(sv[ai][m] * invk + eps), rg = -1.4426950408889634f * rs;
                    f32x4 v0 = acc[ai][0][m][0] * rs, v1 = acc[ai][0][m][1] * rs; const f32x4 g0 = acc[ai][1][m][0] * rg, g1 = acc[ai][1][m][1] * rg;
#pragma unroll
                    for (int j = 0; j < 4; ++j) { v0[j] *= __builtin_amdgcn_rcpf(1.0f + __builtin_amdgcn_exp2f(g0[j])); v1[j] *= __builtin_amdgcn_rcpf(1.0f + __builtin_amdgcn_exp2f(g1[j])); }
                    u32x4 w; w.x = cvt_pk_bf16(v0[0], v0[1]); w.y = cvt_pk_bf16(v0[2], v0[3]); w.z = cvt_pk_bf16(v1[0], v1[1]); w.w = cvt_pk_bf16(v1[2], v1[3]);
                    *(u32x4*)rowp = w; }
        }
    }
};
struct EpiResB {
    static constexpr bool PERM = true, AFTER_DRAIN = false;
    bf16_t* O; const bf16_t* R; int ldc; float* ssq;
    __device__ __forceinline__ void operator()(const f32x4 (&acc)[2][2][4][2], const Unit& u, int wr, int wc, int fr, int fq) const {
        const int row0 = u.pm * BM + wr * 64 + fr, col0 = u.pn * BM + wc * 32 + 8 * fq;
#pragma unroll
        for (int ai = 0; ai < 2; ++ai) {
            u32x4 rv[4][2];
#pragma unroll
            for (int m = 0; m < 4; ++m)
#pragma unroll
                for (int bj = 0; bj < 2; ++bj) rv[m][bj] = *(const u32x4*)(R + (size_t)(row0 + ai * HALF + m * 16) * ldc + col0 + bj * HALF);
            asm volatile("s_waitcnt vmcnt(0)" ::: "memory");
#pragma unroll
            for (int m = 0; m < 4; ++m) { const int row = row0 + ai * HALF + m * 16; const size_t off = (size_t)row * ldc + col0; float s2 = 0.f;
#pragma unroll
                for (int bj = 0; bj < 2; ++bj) {
                    f32x4 v0 = acc[ai][bj][m][0], v1 = acc[ai][bj][m][1]; const u32x4 r4 = rv[m][bj];
                    v0[0] += __uint_as_float(r4.x << 16); v0[1] += __uint_as_float(r4.x & 0xffff0000u); v0[2] += __uint_as_float(r4.y << 16); v0[3] += __uint_as_float(r4.y & 0xffff0000u);
                    v1[0] += __uint_as_float(r4.z << 16); v1[1] += __uint_as_float(r4.z & 0xffff0000u); v1[2] += __uint_as_float(r4.w << 16); v1[3] += __uint_as_float(r4.w & 0xffff0000u);
                    s2 += v0[0] * v0[0] + v0[1] * v0[1] + v0[2] * v0[2] + v0[3] * v0[3] + v1[0] * v1[0] + v1[1] * v1[1] + v1[2] * v1[2] + v1[3] * v1[3];
                    u32x4 w; w.x = cvt_pk_bf16(v0[0], v0[1]); w.y = cvt_pk_bf16(v0[2], v0[3]); w.z = cvt_pk_bf16(v1[0], v1[1]); w.w = cvt_pk_bf16(v1[2], v1[3]);
                    *(u32x4*)(O + off + bj * HALF) = w; }
                s2 += __shfl_xor(s2, 16); s2 += __shfl_xor(s2, 32);
                if (fq == 0) atomicAdd(ssq + row, s2); }
        }
    }
};

template <class Epi, class Sched, bool STAMP = false>
__device__ __forceinline__ void gemm_phase(PG8_LAS unsigned char* lds, const Gemm g, const Sched& S, const Epi& E, unsigned long long* stamps) {
    const int tid = threadIdx.x, wid = __builtin_amdgcn_readfirstlane(tid >> 6), lane = tid & 63, wr = wid >> 2, wc = wid & 3, fr = lane & 15, fq = lane >> 4;
    const int K = g.K, nt = K / BK;
    int ts_lo = 0, ts_hi = 0, nts = 0; const unsigned long long rt_entry = STAMP ? (unsigned long long)wall_clock64() : 0ull;
#define PG8_STAMP() do { if (STAMP && wid == 0 && nts < 64) { const unsigned long long _c = (unsigned long long)clock64(); \
        ts_lo = (lane == nts) ? (int)(unsigned)_c : ts_lo; ts_hi = (lane == nts) ? (int)(unsigned)(_c >> 32) : ts_hi; ++nts; } } while (0)
    PG8_STAMP();
    unsigned voffA[2], voffB[2];
#pragma unroll
    for (int i = 0; i < 2; ++i) { int R, C; stage_rc(tid * 16 + i * 8192, R, C); const int Rb = Epi::PERM ? ((R & ~31) + perm32(R & 31)) : R;
        voffA[i] = (unsigned)(R * K + C) * 2u; voffB[i] = (unsigned)(Rb * K + C) * 2u; }
    const size_t kstep = (size_t)(BK * 2);
    const size_t hstep = (size_t)HALF * K * 2;
    const size_t tstep = 2 * hstep;
    const unsigned ldsw = (unsigned)wid * 1024u;
    const int aoff = lds_byte(wr * 64 + fr, fq * 8), boff = lds_byte(wc * 32 + fr, fq * 8);
#define PG8_SA(b, h) (((b) * 2 + (h)) * HTB)
#define PG8_SB(b, h) ((4 + (b) * 2 + (h)) * HTB)
#define PG8_STAGE(bufoff, gbase, voff) do { _Pragma("unroll") for (int _i = 0; _i < 2; ++_i) \
        __builtin_amdgcn_global_load_lds((const unsigned*)((const char*)(gbase) + (voff)[_i]), (PG8_LAS unsigned*)(lds + (bufoff) + ldsw + _i * 8192), 16, 0, 0); } while (0)
#define PG8_LDA(dst, b, h) do { _Pragma("unroll") for (int m = 0; m < 4; ++m) _Pragma("unroll") for (int k = 0; k < 2; ++k) dst[m][k] = *(const PG8_LAS bf16x8*)(lds + PG8_SA(b, h) + aoff + m * 2048 + k * 1024); } while (0)
#define PG8_LDB(dst, b, h) do { _Pragma("unroll") for (int n = 0; n < 2; ++n) _Pragma("unroll") for (int k = 0; k < 2; ++k) dst[n][k] = *(const PG8_LAS bf16x8*)(lds + PG8_SB(b, h) + boff + n * 2048 + k * 1024); } while (0)
#define PG8_MMA(ai, bj, At, Bt) do { __builtin_amdgcn_s_setprio(1); _Pragma("unroll") for (int m = 0; m < 4; ++m) _Pragma("unroll") for (int n = 0; n < 2; ++n) _Pragma("unroll") for (int k = 0; k < 2; ++k) \
        acc[ai][bj][m][n] = __builtin_amdgcn_mfma_f32_16x16x32_bf16(Bt[n][k], At[m][k], acc[ai][bj][m][n], 0, 0, 0); __builtin_amdgcn_s_setprio(0); } while (0)
#define PG8_WAIT_V(n) asm volatile("s_waitcnt vmcnt(" #n ")" ::: "memory")
#define PG8_WAIT_L(n) asm volatile("s_waitcnt lgkmcnt(" #n ")" ::: "memory")
#define PG8_BAR __builtin_amdgcn_s_barrier()
#define PG8_SCHED __builtin_amdgcn_sched_barrier(0)
    Unit cur, nxt; int ui = 0;
    if (!S.next(0, cur)) return;
    f32x4 acc[2][2][4][2];
#pragma unroll
    for (int a = 0; a < 2; ++a)
#pragma unroll
        for (int b = 0; b < 2; ++b)
#pragma unroll
            for (int m = 0; m < 4; ++m)
#pragma unroll
                for (int n = 0; n < 2; ++n) acc[a][b][m][n] = (f32x4){0.f, 0.f, 0.f, 0.f};
    bf16x8 At[4][2], B0[2][2], B1[2][2];
    const char* cA = (const char*)g.A + (size_t)cur.pm * tstep; const char* cB = (const char*)g.Bt + (size_t)cur.pn * tstep;
    S.a_ready(cur);
    PG8_STAGE(PG8_SB(0, 0), cB, voffB); PG8_STAGE(PG8_SA(0, 0), cA, voffA); PG8_STAGE(PG8_SB(0, 1), cB + hstep, voffB); PG8_STAGE(PG8_SA(0, 1), cA + hstep, voffA);
    if (wr == 1) PG8_BAR;
    PG8_WAIT_V(4); PG8_BAR;
    PG8_STAGE(PG8_SB(1, 0), cB + kstep, voffB); PG8_STAGE(PG8_SA(1, 0), cA + kstep, voffA); PG8_STAGE(PG8_SB(1, 1), cB + hstep + kstep, voffB);
    PG8_WAIT_V(6); PG8_BAR;
    PG8_STAMP();
    for (;;) {
        const bool has_next = S.next(ui + 1, nxt);
        const char* nA = has_next ? (const char*)g.A + (size_t)nxt.pm * tstep : cA; const char* nB = has_next ? (const char*)g.Bt + (size_t)nxt.pn * tstep : cB;
        for (int t = 0; t < nt; t += 2) {
            const bool last = (t == nt - 2);
            const char* a1 = cA + (size_t)(t + 1) * kstep;
            const char* a2 = last ? nA : cA + (size_t)(t + 2) * kstep; const char* b2 = last ? nB : cB + (size_t)(t + 2) * kstep;
            const char* a3 = a2 + kstep; const char* b3 = b2 + kstep;
            if (last && has_next) S.a_ready(nxt);
            PG8_LDB(B0, 0, 0); PG8_SCHED; PG8_LDA(At, 0, 0); PG8_STAGE(PG8_SA(1, 1), a1 + hstep, voffA);
            PG8_WAIT_L(8); PG8_BAR; PG8_WAIT_L(0); PG8_MMA(0, 0, At, B0); PG8_BAR; PG8_SCHED;
            PG8_LDB(B1, 0, 1); PG8_STAGE(PG8_SB(0, 0), b2, voffB);
            PG8_BAR; PG8_WAIT_L(0); PG8_MMA(0, 1, At, B1); PG8_BAR;
            PG8_LDA(At, 0, 1); PG8_STAGE(PG8_SA(0, 0), a2, voffA);
            PG8_BAR; PG8_WAIT_L(0); PG8_MMA(1, 0, At, B0); PG8_BAR; PG8_SCHED;
            PG8_STAGE(PG8_SB(0, 1), b2 + hstep, voffB);
            PG8_WAIT_V(6); PG8_BAR; PG8_MMA(1, 1, At, B1); PG8_BAR;
            PG8_LDB(B0, 1, 0); PG8_SCHED; PG8_LDA(At, 1, 0); PG8_STAGE(PG8_SA(0, 1), a2 + hstep, voffA);
            PG8_WAIT_L(8); PG8_BAR; PG8_WAIT_L(0); PG8_MMA(0, 0, At, B0); PG8_BAR; PG8_SCHED;
            PG8_LDB(B1, 1, 1); PG8_STAGE(PG8_SB(1, 0), b3, voffB);
            PG8_BAR; PG8_WAIT_L(0); PG8_MMA(0, 1, At, B1); PG8_BAR;
            PG8_LDA(At, 1, 1); PG8_STAGE(PG8_SA(1, 0), a3, voffA);
            PG8_BAR; PG8_WAIT_L(0); PG8_MMA(1, 0, At, B0); PG8_BAR; PG8_SCHED;
            PG8_STAGE(PG8_SB(1, 1), b3 + hstep, voffB);
            PG8_WAIT_V(6); PG8_BAR; PG8_MMA(1, 1, At, B1); PG8_BAR;
        }
        PG8_STAMP();
        if constexpr (!Epi::AFTER_DRAIN) { E(acc, cur, wr, wc, fr, fq); S.done(cur); }
        PG8_STAMP();
        if (!has_next) break;
#pragma unroll
        for (int a = 0; a < 2; ++a)
#pragma unroll
            for (int b = 0; b < 2; ++b)
#pragma unroll
                for (int m = 0; m < 4; ++m)
#pragma unroll
                    for (int n = 0; n < 2; ++n) acc[a][b][m][n] = (f32x4){0.f, 0.f, 0.f, 0.f};
        cur = nxt; cA = nA; cB = nB; ++ui;
    }
    PG8_WAIT_V(0);
    if (wr == 0) PG8_BAR;
    PG8_BAR;
    if constexpr (Epi::AFTER_DRAIN) { E.fused(acc, cur, wr, wc, fr, fq, lds, wid, lane); S.done(cur); }
    PG8_STAMP();
    if (STAMP && wid == 0) { stamps[lane] = lane < nts ? (((unsigned long long)(unsigned)ts_hi << 32) | (unsigned)ts_lo) : 0ull;
        if (lane == 62) stamps[62] = rt_entry; if (lane == 63) stamps[63] = (unsigned long long)wall_clock64(); }
#undef PG8_STAMP
#undef PG8_SA
#undef PG8_SB
#undef PG8_STAGE
#undef PG8_LDA
#undef PG8_LDB
#undef PG8_MMA
#undef PG8_WAIT_V
#undef PG8_WAIT_L
#undef PG8_BAR
#undef PG8_SCHED
}
}

typedef unsigned short bf16_t;
typedef short bf16x8 __attribute__((ext_vector_type(8)));
typedef float f32x4 __attribute__((ext_vector_type(4)));
typedef unsigned u32x4 __attribute__((ext_vector_type(4)));
typedef unsigned u32x2 __attribute__((ext_vector_type(2)));
constexpr int NB = 12, SL = 8192, T = NB * SL, DM = 1024, NC = 3072, NPROMPT = 8 * SL;
constexpr int DH = 384, DC = 256, DR = 384;
constexpr int C_X0 = 512, C_X1 = 896, C_V = 1280, C_RG = 1664, C_GATE = 2048;
__host__ __device__ __forceinline__ int origcol(int n) {
    if (n < 128) return 1152 + n; if (n < 256) return 1408 + (n - 128); if (n < 384) return 1280 + (n - 256); if (n < 512) return 1536 + (n - 384);
    if (n < 896) return n - 512; if (n < 1280) return 384 + (n - 896); if (n < 1664) return 768 + (n - 1280); return n; }
constexpr int NFFT = 16384;
constexpr int LDS_BYTES = (NFFT + NFFT / 16) * 8;
constexpr float EPS = 1e-6f;
constexpr int NCHUNK = 16, CHUNK = 512;
constexpr int XCD_BAR_WORDS_C = 3456;

constexpr size_t WS_P = 0;
constexpr size_t WS_HY = WS_P + (size_t)T * NC * 2;
constexpr size_t WS_U = WS_HY + (size_t)T * DM * 2;
constexpr size_t WS_KF = WS_U + (size_t)NB * DH * SL * 2;
constexpr size_t WS_WINT = WS_KF + (size_t)DH * NFFT * 8;
constexpr size_t WS_WOUTT = WS_WINT + (size_t)2 * NC * DM * 2;
constexpr size_t WS_PWT = WS_WOUTT + (size_t)2 * DM * DM * 2;
constexpr size_t WS_RGWT = WS_PWT + (size_t)2 * DC * DC * 2;
constexpr size_t WS_AGG = WS_RGWT + (size_t)2 * 2 * 2 * 6 * 64 * 64 * 2;
constexpr size_t WS_BAR = WS_AGG + (size_t)NB * NCHUNK * 2 * 2 * DR * 4;
constexpr int RK_BASE = XCD_BAR_WORDS_C;
constexpr size_t CTL_BYTES = (size_t)(XCD_BAR_WORDS_C + 16 * 64) * 4;
constexpr size_t WS_GRAN = WS_BAR + CTL_BYTES;
constexpr size_t GRAN_BYTES = (size_t)2 * 64 * 144 * 64 * 8;
constexpr size_t WS_SS = WS_GRAN + GRAN_BYTES;
constexpr size_t WS_END = WS_SS + (size_t)3 * T * 4;

struct Params {
    const float* in[31];
    float* out;
    unsigned char* ws;
    int ph_lo, ph_hi;
};
enum { I_XP = 0, I_XS, I_NORMG, I_WIN, I_HCW, I_HCB, I_HW1, I_HB1, I_HW2, I_HB2, I_HW3, I_HB3, I_HW4, I_HFREQ, I_HD, I_CDW, I_CDB, I_CLG, I_CLB, I_CPW, I_CPB,
       I_RCW, I_RCB, I_RWA, I_RBA, I_RWX, I_RBX, I_RLAM, I_GRPG, I_WOUT, I_FING };

__device__ __forceinline__ float bf2f(bf16_t b) { return __uint_as_float(((unsigned)b) << 16); }
__device__ __forceinline__ unsigned pk2(float lo, float hi) { unsigned r; asm("v_cvt_pk_bf16_f32 %0, %1, %2" : "=v"(r) : "v"(lo), "v"(hi)); return r; }
__device__ __forceinline__ bf16_t f2bf(float f) { return (bf16_t)(pk2(f, f) & 0xffffu); }
__device__ __forceinline__ float wave_sum(float v) {
#pragma unroll
    for (int o = 32; o >= 1; o >>= 1) v += __shfl_xor(v, o);
    return v;
}
template <int N>
__device__ __forceinline__ void wave_sum_n(float (&v)[N]) {
#pragma unroll
    for (int o = 32; o >= 1; o >>= 1) {
#pragma unroll
        for (int i = 0; i < N; ++i) v[i] += __shfl_xor(v[i], o); }
}
__device__ __forceinline__ void lds_barrier() { asm volatile("s_waitcnt lgkmcnt(0)" ::: "memory"); __builtin_amdgcn_s_barrier(); asm volatile("" ::: "memory"); }
__device__ __forceinline__ int launder_tid() { int t = threadIdx.x; asm volatile("" : "+v"(t)); return t; }
__device__ __forceinline__ float sigmoidf_(float x) { return __builtin_amdgcn_rcpf(1.0f + __builtin_amdgcn_exp2f(-1.4426950408889634f * x)); }
__device__ __forceinline__ float siluf_(float x) { return x * sigmoidf_(x); }
struct __attribute__((packed, aligned(4))) U3 { unsigned x, y, z; };

__device__ __forceinline__ void transpose_tile(const float* src, int src_ld, bf16_t* dst, int dst_ld, int k0, int n0, float* tile  , const float* kscale = nullptr, int n0src = -1) {
    if (n0src < 0) n0src = n0;
    const int tid = threadIdx.x, lo = tid & 63, hi = tid >> 6;
#pragma unroll
    for (int i = 0; i < 8; ++i) { const int kk = i * 8 + hi; tile[kk * 65 + lo] = src[(size_t)(k0 + kk) * src_ld + n0src + lo] * (kscale ? kscale[k0 + kk] : 1.0f); }
    __syncthreads();
#pragma unroll
    for (int i = 0; i < 8; ++i) { const int nn = i * 8 + hi; dst[(size_t)(n0 + nn) * dst_ld + k0 + lo] = f2bf(tile[lo * 65 + nn]); }
    __syncthreads();
}
__device__ __forceinline__ void phase_prep_weights(const Params& p, unsigned char* lds) {
    float* tile = (float*)lds;
    { u32x4* g = (u32x4*)(p.ws + WS_GRAN); const u32x4 z = {0u, 0u, 0u, 0u};
      for (size_t i = (size_t)blockIdx.x * 512 + threadIdx.x; i < GRAN_BYTES / 16; i += (size_t)gridDim.x * 512) g[i] = z; }
    constexpr int N_WIN = 16 * 48, N_WOUT = 16 * 16, N_PW = 16, N_RG = 24;
    constexpr int PER_LAYER = N_WIN + N_WOUT + N_PW + 2 * N_RG;
    for (int it = blockIdx.x; it < 2 * PER_LAYER; it += gridDim.x) {
        const int l = it / PER_LAYER; int r = it % PER_LAYER;
        if (r < N_WIN) { transpose_tile(p.in[I_WIN] + (size_t)l * DM * NC, NC, (bf16_t*)(p.ws + WS_WINT) + (size_t)l * NC * DM, DM, (r / 48) * 64, (r % 48) * 64, tile, p.in[I_NORMG] + l * DM, origcol((r % 48) * 64)); continue; }
        r -= N_WIN;
        if (r < N_WOUT) { transpose_tile(p.in[I_WOUT] + (size_t)l * DM * DM, DM, (bf16_t*)(p.ws + WS_WOUTT) + (size_t)l * DM * DM, DM, (r / 16) * 64, (r % 16) * 64, tile); continue; }
        r -= N_WOUT;
        if (r < N_PW) { transpose_tile(p.in[I_CPW] + (size_t)l * DC * DC, DC, (bf16_t*)(p.ws + WS_PWT) + (size_t)l * DC * DC, DC, (r / 4) * 64, (r % 4) * 64, tile); continue; }
        r -= N_PW;
        const int gate = r / N_RG, dh = r % N_RG, dir = dh / 6, h = dh % 6;
        const float* src = p.in[gate ? I_RWX : I_RWA] + ((size_t)(l * 2 + dir) * 6 + h) * 4096;
        bf16_t* dst = (bf16_t*)(p.ws + WS_RGWT) + ((size_t)((l * 2 + dir) * 2 + gate) * 6 + h) * 4096;
        transpose_tile(src, 64, dst, 64, 0, 0, tile);
    }
}

__device__ __forceinline__ void phase_x0_prep(const float* xa, const float* xb, bf16_t* H, float* ss) {
    const int lane = threadIdx.x & 63, wave = threadIdx.x >> 6;
    for (int i = blockIdx.x * 512 + threadIdx.x; i < 2 * T; i += gridDim.x * 512) ss[T + i] = 0.f;
    const int NW = gridDim.x * 8;
    for (int row0 = blockIdx.x * 8 + wave; row0 < T; row0 += 4 * NW) {
        f32x4 v[4][4];
#pragma unroll
        for (int r = 0; r < 4; ++r) { const int row = row0 + r * NW;
            if (row < T) { const float* xr = (row < NPROMPT) ? xa + (size_t)row * DM : xb + (size_t)(row - NPROMPT) * DM;
#pragma unroll
                for (int j = 0; j < 4; ++j) v[r][j] = *(const f32x4*)(xr + lane * 4 + 256 * j); } }
#pragma unroll
        for (int r = 0; r < 4; ++r) { const int row = row0 + r * NW;
            if (row < T) { float s2 = 0.f;
#pragma unroll
                for (int j = 0; j < 4; ++j) { s2 += v[r][j].x * v[r][j].x + v[r][j].y * v[r][j].y + v[r][j].z * v[r][j].z + v[r][j].w * v[r][j].w;
                    u32x2 w; w.x = pk2(v[r][j].x, v[r][j].y); w.y = pk2(v[r][j].z, v[r][j].w); *(u32x2*)(H + (size_t)row * DM + lane * 4 + 256 * j) = w; }
                s2 = wave_sum(s2); if (lane == 0) ss[row] = s2; } }
    }
}
__device__ __forceinline__ void phase_final_norm(const bf16_t* x2, const float* ss, const float* g, float* out) {
    const int lane = threadIdx.x & 63, wave = threadIdx.x >> 6;
    f32x4 gv[4];
#pragma unroll
    for (int j = 0; j < 4; ++j) gv[j] = *(const f32x4*)(g + lane * 4 + 256 * j);
    const int NW = gridDim.x * 8;
    for (int row0 = blockIdx.x * 8 + wave; row0 < T; row0 += 4 * NW) {
        u32x2 v[4][4]; float rs[4];
#pragma unroll
        for (int r = 0; r < 4; ++r) { const int row = row0 + r * NW; rs[r] = 0.f;
            if (row < T) { rs[r] = rsqrtf(ss[row] * (1.0f / DM) + EPS);
#pragma unroll
                for (int j = 0; j < 4; ++j) v[r][j] = *(const u32x2*)(x2 + (size_t)row * DM + lane * 4 + 256 * j); } }
#pragma unroll
        for (int r = 0; r < 4; ++r) { const int row = row0 + r * NW;
            if (row < T) {
#pragma unroll
                for (int j = 0; j < 4; ++j) { f32x4 x; x.x = __uint_as_float(v[r][j].x << 16); x.y = __uint_as_float(v[r][j].x & 0xffff0000u); x.z = __uint_as_float(v[r][j].y << 16); x.w = __uint_as_float(v[r][j].y & 0xffff0000u);
                    *(f32x4*)(out + (size_t)row * DM + lane * 4 + 256 * j) = x * rs[r] * gv[j]; } } }
    }
}

__device__ __forceinline__ void phase_filters(const Params& p, int l, unsigned char* lds) {
    float* Z = (float*)lds;
    float* H1 = Z + 32 * 33;
    float* H2 = H1 + 32 * 65;
    float* OT = H2 + 32 * 65;
    const float* w1 = p.in[I_HW1] + (size_t)l * 33 * 64; const float* b1 = p.in[I_HB1] + l * 64;
    const float* w2 = p.in[I_HW2] + (size_t)l * 64 * 64; const float* b2 = p.in[I_HB2] + l * 64;
    const float* w3 = p.in[I_HW3] + (size_t)l * 64 * 64; const float* b3 = p.in[I_HB3] + l * 64;
    const float* w4 = p.in[I_HW4] + (size_t)l * 64 * 768; const float* fr = p.in[I_HFREQ] + l * 64;
    float2* KF = (float2*)(p.ws + WS_KF);
    for (int it = blockIdx.x; it < SL / 32; it += gridDim.x) {
        const int t0 = it * 32; const int tid = launder_tid();
        for (int idx = tid; idx < 32 * 33; idx += 512) {
            const int tl = idx / 33, f = idx % 33; const float t = (float)(t0 + tl);
            float z;
            if (f == 0) z = t / (float)(SL - 1);
            else { const int j = (f - 1) & 15; const float fj = 1e-4f + (float)j * ((15.0f - 1e-4f) / 15.0f); const float ang = 2.0f * fj * t * (1.0f / SL);
                   z = (f <= 16) ? cospif(ang) : -sinpif(ang); }
            Z[tl * 33 + f] = z;
        }
        __syncthreads();
        { const int o = tid & 63; const float frq = fr[o], bb = b1[o];
#pragma unroll
          for (int i = 0; i < 4; ++i) { const int tl = (tid >> 6) + 8 * i; float a = bb;
_Pragma("unroll 3") for (int f = 0; f < 33; ++f) a += Z[tl * 33 + f] * w1[f * 64 + o]; H1[tl * 65 + o] = sinf(frq * a); } }
        __syncthreads();
        { const int o = tid & 63; const float frq = fr[o], bb = b2[o];
#pragma unroll
          for (int i = 0; i < 4; ++i) { const int tl = (tid >> 6) + 8 * i; float a = bb;
_Pragma("unroll 4") for (int f = 0; f < 64; ++f) a += H1[tl * 65 + f] * w2[f * 64 + o]; H2[tl * 65 + o] = sinf(frq * a); } }
        __syncthreads();
        { const int o = tid & 63; const float frq = fr[o], bb = b3[o];
#pragma unroll
          for (int i = 0; i < 4; ++i) { const int tl = (tid >> 6) + 8 * i; float a = bb;
_Pragma("unroll 4") for (int f = 0; f < 64; ++f) a += H2[tl * 65 + f] * w3[f * 64 + o]; H1[tl * 65 + o] = sinf(frq * a); } }
        __syncthreads();
#pragma unroll 1
        for (int cr = tid; cr < 2 * 768; cr += 512) {
            const int c = cr % 768, rnd = cr / 768;
            float acc[16];
#pragma unroll
            for (int tl = 0; tl < 16; ++tl) acc[tl] = 0.f;
#pragma unroll 2
            for (int k = 0; k < 64; ++k) { const float w = w4[k * 768 + c];
#pragma unroll
                for (int tl = 0; tl < 16; ++tl) acc[tl] += H1[(rnd * 16 + tl) * 65 + k] * w; }
#pragma unroll
            for (int tl = 0; tl < 16; ++tl) OT[c * 33 + rnd * 16 + tl] = acc[tl];
        }
        __syncthreads();
        for (int idx = tid; idx < 768 * 32; idx += 512) {
            const int c768 = idx >> 5, tl = idx & 31, t = t0 + tl, c = c768 % DH;
            const float minD = -3.0701134573253944f, maxD = -15.350567286626972f;
            const float delta = fabsf(minD + (maxD - minD) * ((float)c / (float)(DH - 1)));
            const float val = OT[c768 * 33 + tl] * __expf(-((float)t / (float)(SL - 1)) * delta) * (1.0f / NFFT);
            if (c768 < DH) KF[(size_t)c * NFFT + t] = make_float2(val, 0.f);
            else if (t > 0) KF[(size_t)c * NFFT + (NFFT - t)] = make_float2(val, 0.f);
            else KF[(size_t)c * NFFT + SL] = make_float2(0.f, 0.f);
        }
        __syncthreads();
    }
}

__device__ __forceinline__ int PH(int i) { return i + (i >> 4); }
__device__ __forceinline__ float2 opq(float2 v) { asm("" : "+v"(v.x), "+v"(v.y)); return v; }
__device__ __forceinline__ float2 cmul(float2 a, float2 b) { return make_float2(a.x * b.x - a.y * b.y, a.x * b.y + a.y * b.x); }
__device__ __forceinline__ float2 tw16(int m, bool inv) {
    const float cs[8] = {1.0f, 0.92387953251128674f, 0.70710678118654752f, 0.38268343236508977f, 0.0f, -0.38268343236508977f, -0.70710678118654752f, -0.92387953251128674f};
    const float sn[8] = {0.0f, 0.38268343236508977f, 0.70710678118654752f, 0.92387953251128674f, 1.0f, 0.92387953251128674f, 0.70710678118654752f, 0.38268343236508977f};
    return make_float2(cs[m], inv ? sn[m] : -sn[m]);
}
template <int LR, bool INV, bool ZEROJ>
__device__ __forceinline__ void bfly(float2 (&x)[1 << LR], float ang0) {
    constexpr int R = 1 << LR;
    float2 w[LR];
    if (!ZEROJ) {
        const float s0 = __builtin_amdgcn_sinf(ang0), c0 = __builtin_amdgcn_cosf(ang0);
        w[0] = make_float2(c0, INV ? s0 : -s0);
#pragma unroll
        for (int t = 1; t < LR; ++t) w[t] = cmul(w[t - 1], w[t - 1]);
    }
#pragma unroll
    for (int tt = 0; tt < LR; ++tt) {
        const int t = INV ? (LR - 1 - tt) : tt;
        const int half = R >> (t + 1);
#pragma unroll
        for (int q = 0; q < R; ++q) {
            if (q & half) continue;
            const int ql = q & (half - 1);
            const int m = (ql << t) * (16 / R);
            float2 tw;
            if (ZEROJ) tw = tw16(m, INV);
            else if (m == 0) tw = w[t];
            else tw = cmul(w[t], tw16(m, INV));
            const bool triv = ZEROJ && (m == 0);
            if (!INV) {
                const float2 a = x[q], b = x[q + half];
                x[q] = make_float2(a.x + b.x, a.y + b.y);
                const float2 d = make_float2(a.x - b.x, a.y - b.y);
                x[q + half] = triv ? d : cmul(d, tw);
            } else {
                const float2 a = x[q]; const float2 b = triv ? x[q + half] : cmul(x[q + half], tw);
                x[q] = make_float2(a.x + b.x, a.y + b.y);
                x[q + half] = make_float2(a.x - b.x, a.y - b.y);
            }
        }
    }
}
template <int LR, bool INV>
__device__ __forceinline__ void fft_pass(float2* X, int Blog) {
    constexpr int R = 1 << LR;
    const int Slog = Blog - LR;
    const int tid0 = launder_tid();
#pragma unroll 1
    for (int id = tid0; id < (NFFT >> LR); id += 512) {
        const int blk = id >> Slog, j = id & ((1 << Slog) - 1);
        const int base = (blk << Blog) + j;
        float2 x[R];
#pragma unroll
        for (int q = 0; q < R; ++q) x[q] = X[PH(base + (q << Slog))];
        bfly<LR, INV, false>(x, (float)j * (1.0f / (float)(1 << Blog)));
#pragma unroll
        for (int q = 0; q < R; ++q) X[PH(base + (q << Slog))] = opq(x[q]);
    }
    lds_barrier();
}
template <bool CONV>
__device__ __forceinline__ void fft_mid(float2* X, const float2* kf, float2* gout, bool do_store) {
    const int tid0 = launder_tid();
#pragma unroll 1
    for (int id = tid0; id < (NFFT >> 4); id += 512) {
        float2 x[16];
#pragma unroll
        for (int q = 0; q < 16; ++q) x[q] = X[17 * id + q];
        bfly<4, false, true>(x, 0.f);
        if (CONV) {
#pragma unroll
            for (int q = 0; q < 16; ++q) { const float2 k1 = kf[q * 1024 + id]; x[q] = cmul(x[q], k1); }
            bfly<4, true, true>(x, 0.f);
#pragma unroll
            for (int q = 0; q < 16; ++q) X[17 * id + q] = opq(x[q]);
        } else if (do_store) {
#pragma unroll
            for (int q = 0; q < 16; ++q) gout[q * 1024 + id] = opq(x[q]);
        }
    }
    lds_barrier();
}
__device__ __forceinline__ void phase_kf_fft(const Params& p, unsigned char* lds, bool do_store = true) {
    float2* X = (float2*)lds; float2* KF = (float2*)(p.ws + WS_KF);
    for (int c = blockIdx.x; c < DH; c += gridDim.x) {
        float2* kc = KF + (size_t)c * NFFT;
        const int tid0 = launder_tid();
#pragma unroll 1
        for (int id = tid0; id < 4096; id += 512) {
            float2 x[4];
#pragma unroll
            for (int q = 0; q < 4; ++q) x[q] = kc[id + q * 4096];
            bfly<2, false, false>(x, (float)id * (1.0f / 16384.0f));
#pragma unroll
            for (int q = 0; q < 4; ++q) X[PH(id + q * 4096)] = opq(x[q]);
        }
        lds_barrier();
        fft_pass<4, false>(X, 12); fft_pass<4, false>(X, 8); fft_mid<false>(X, nullptr, kc, do_store);
    }
}
__device__ __forceinline__ void phase_fftconv(const Params& p, int l, unsigned char* lds, bool do_store = true) {
    float2* X = (float2*)lds; const float2* KF = (const float2*)(p.ws + WS_KF); bf16_t* U = (bf16_t*)(p.ws + WS_U);
    const float* dsk = p.in[I_HD] + l * DH;
    for (int it = blockIdx.x; it < DH * (NB / 2); it += gridDim.x) {
        const int xq = it & 7, xr = it >> 3, c = xq * (DH / 8) + xr / (NB / 2), pr = xr % (NB / 2);
        unsigned* u1 = (unsigned*)(U + ((size_t)(2 * pr) * DH + c) * SL); unsigned* u2 = (unsigned*)(U + ((size_t)(2 * pr + 1) * DH + c) * SL);
        const int tid0 = launder_tid();
#pragma unroll 1
        for (int i = 0; i < 4; ++i) { const int k = tid0 + 512 * i;
            const unsigned a0 = u1[k], a1 = u1[k + 2048], b0 = u2[k], b1 = u2[k + 2048];
#pragma unroll
            for (int e = 0; e < 2; ++e) { const int id = 2 * k + e;
                float2 x[4];
                x[0] = make_float2(e ? __uint_as_float(a0 & 0xffff0000u) : __uint_as_float(a0 << 16), e ? __uint_as_float(b0 & 0xffff0000u) : __uint_as_float(b0 << 16));
                x[1] = make_float2(e ? __uint_as_float(a1 & 0xffff0000u) : __uint_as_float(a1 << 16), e ? __uint_as_float(b1 & 0xffff0000u) : __uint_as_float(b1 << 16));
                x[2] = make_float2(0.f, 0.f); x[3] = make_float2(0.f, 0.f);
                bfly<2, false, false>(x, (float)id * (1.0f / 16384.0f));
#pragma unroll
                for (int q = 0; q < 4; ++q) X[PH(id + q * 4096)] = opq(x[q]); } }
        lds_barrier();
        fft_pass<4, false>(X, 12); fft_pass<4, false>(X, 8);
        fft_mid<true>(X, KF + (size_t)c * NFFT, nullptr, false);
        fft_pass<4, true>(X, 8); fft_pass<4, true>(X, 12);
        const float d = dsk[c];
#pragma unroll 1
        for (int i = 0; i < 4; ++i) { const int k = tid0 + 512 * i;
            const unsigned a0 = u1[k], a1 = u1[k + 2048], b0 = u2[k], b1 = u2[k + 2048];
            float2 y0[2], y1[2];
#pragma unroll
            for (int e = 0; e < 2; ++e) { const int id = 2 * k + e;
                float2 x[4];
#pragma unroll
                for (int q = 0; q < 4; ++q) x[q] = X[PH(id + q * 4096)];
                bfly<2, true, false>(x, (float)id * (1.0f / 16384.0f));
                y0[e] = opq(x[0]); y1[e] = opq(x[1]); }
            if (do_store) {
                u1[k] = pk2(y0[0].x + d * __uint_as_float(a0 << 16), y0[1].x + d * __uint_as_float(a0 & 0xffff0000u));
                u1[k + 2048] = pk2(y1[0].x + d * __uint_as_float(a1 << 16), y1[1].x + d * __uint_as_float(a1 & 0xffff0000u));
                u2[k] = pk2(y0[0].y + d * __uint_as_float(b0 << 16), y0[1].y + d * __uint_as_float(b0 & 0xffff0000u));
                u2[k + 2048] = pk2(y1[0].y + d * __uint_as_float(b1 << 16), y1[1].y + d * __uint_as_float(b1 & 0xffff0000u)); } }
        lds_barrier();
    }
}

__device__ __forceinline__ void phase_hyena_prep(const Params& p, int l, unsigned char* lds) {
    bf16_t* RAW = (bf16_t*)lds;
    float* tile = (float*)(lds + 2 * 130 * 64 * 2);
    const bf16_t* P = (const bf16_t*)(p.ws + WS_P); bf16_t* U = (bf16_t*)(p.ws + WS_U);
    const float* cw = p.in[I_HCW] + (size_t)l * 3 * 1152; const float* cb = p.in[I_HCB] + l * 1152;
    u32x4 pf[5];
#define HP_PREFETCH(IT) do { const int _cg = (IT) % 6, _tt = ((IT) / 6) % 64, _b = (IT) / 384, _t0 = _tt * 128; const bf16_t* _pb = P + (size_t)_b * SL * NC; const int _tid = threadIdx.x; \
        _Pragma("unroll") for (int k = 0; k < 5; ++k) { const int idx = _tid + 512 * k, arr = idx / 1040, rem = idx % 1040, r = rem >> 3, sg = rem & 7, t = _t0 - 1 + r; pf[k] = (u32x4){0u, 0u, 0u, 0u}; \
            if (idx < 2080 && t >= 0 && t < SL) pf[k] = *(const u32x4*)(_pb + (size_t)t * NC + (arr ? C_V : C_X1) + _cg * 64 + sg * 8); } } while (0)
    if ((int)blockIdx.x < NB * 64 * 6) { HP_PREFETCH((int)blockIdx.x);
#pragma unroll
        for (int k = 0; k < 5; ++k) { const int idx = (int)threadIdx.x + 512 * k;
            if (idx < 2080) { const int arr = idx / 1040, rem = idx % 1040, r = rem >> 3, sg = rem & 7; *(u32x4*)(RAW + (arr * 130 + r) * 64 + sg * 8) = pf[k]; } } }
    lds_barrier();
    for (int it = blockIdx.x; it < NB * 64 * 6; it += gridDim.x) {
        const int tid = launder_tid(), cc = tid & 63, tq = tid >> 6;
        const int cgp = it % 6, tt = (it / 6) % 64, b = it / 384;
        const int c = cgp * 64 + cc, t0 = tt * 128;
        const float wx0 = cw[384 + c], wx1 = cw[1152 + 384 + c], wx2 = cw[2304 + 384 + c], bx = cb[384 + c];
        const float wv0 = cw[768 + c], wv1 = cw[1152 + 768 + c], wv2 = cw[2304 + 768 + c], bv = cb[768 + c];
        const bool has_next = it + (int)gridDim.x < NB * 64 * 6;
        if (has_next) HP_PREFETCH(it + (int)gridDim.x);
        { const bf16_t* rx = RAW + (tq * 16) * 64 + cc; const bf16_t* rv = rx + 130 * 64;
          float xm = bf2f(rx[0]), x0 = bf2f(rx[64]), vm = bf2f(rv[0]), v0 = bf2f(rv[64]);
#pragma unroll
          for (int i = 0; i < 16; ++i) {
              const float xp = bf2f(rx[(i + 2) * 64]), vp = bf2f(rv[(i + 2) * 64]);
              const float cx = wx0 * xm + wx1 * x0 + wx2 * xp + bx, cv = wv0 * vm + wv1 * v0 + wv2 * vp + bv;
              tile[cc * 129 + tq * 16 + i] = cx * cv;
              xm = x0; x0 = xp; vm = v0; v0 = vp; } }
        lds_barrier();
#pragma unroll
        for (int i = 0; i < 8; ++i) { const int idx = tid + 512 * i, c2 = idx >> 6, tl = (idx & 63) * 2;
            *(unsigned*)(U + ((size_t)b * DH + cgp * 64 + c2) * SL + t0 + tl) = pk2(tile[c2 * 129 + tl], tile[c2 * 129 + tl + 1]); }
        if (has_next) {
#pragma unroll
            for (int k = 0; k < 5; ++k) { const int idx = tid + 512 * k;
                if (idx < 2080) { const int arr = idx / 1040, rem = idx % 1040, r = rem >> 3, sg = rem & 7; *(u32x4*)(RAW + (arr * 130 + r) * 64 + sg * 8) = pf[k]; } } }
        lds_barrier();
    }
#undef HP_PREFETCH
}

__device__ __forceinline__ void phase_conformer(const Params& p, int l, unsigned char* lds) {
    bf16_t* G = (bf16_t*)lds;
    bf16_t* A = (bf16_t*)lds;
    float* CV = (float*)(lds + 49152);
    const bf16_t* P = (const bf16_t*)(p.ws + WS_P); bf16_t* Y = (bf16_t*)(p.ws + WS_HY);
    const bf16_t* PwT = (const bf16_t*)(p.ws + WS_PWT) + (size_t)l * DC * DC;
    const float* dww = p.in[I_CDW] + (size_t)l * 31 * DC; const float* dwb = p.in[I_CDB] + l * DC;
    const float* lng = p.in[I_CLG] + l * DC; const float* lnb = p.in[I_CLB] + l * DC; const float* pwb = p.in[I_CPB] + l * DC;
    const float* gg = p.in[I_GRPG] + l * DM + DH;
    float w[31];
#pragma unroll
    for (int k = 0; k < 31; ++k) w[k] = dww[k * DC + (threadIdx.x & 255)];
    const float bias = dwb[threadIdx.x & 255];
    u32x4 av[6];
#define CF_TILE(IT) ((((IT) & 7) * (NB * (SL / 64) / 8)) + ((IT) >> 3))
#define CF_PREFETCH(IT) do { const int _tile = CF_TILE(IT), _b = _tile / (SL / 64), _t0 = (_tile % (SL / 64)) * 64; const bf16_t* _pb = P + (size_t)_b * SL * NC; const int _tid = threadIdx.x; \
        _Pragma("unroll") for (int k = 0; k < 6; ++k) { const int idx = _tid + 512 * k, i = idx >> 5, c8 = (idx & 31) * 8, t = _t0 - 15 + i; \
            av[k] = (u32x4){0u, 0u, 0u, 0u}; \
            if (idx < 94 * 32 && t >= 0 && t < SL) av[k] = *(const u32x4*)(_pb + (size_t)t * NC + c8 + ((c8 >= 128) ? 128 : 0)); } } while (0)
    if ((int)blockIdx.x < NB * (SL / 64)) CF_PREFETCH((int)blockIdx.x);
    for (int it = blockIdx.x; it < NB * (SL / 64); it += gridDim.x) {
        const int tid = launder_tid(), lane = tid & 63, wave = tid >> 6, fr = lane & 15, fq = lane >> 4;
        const int tile = CF_TILE(it), b = tile / (SL / 64), t0 = (tile % (SL / 64)) * 64;
        const bf16_t* pb = P + (size_t)b * SL * NC;
#pragma unroll
        for (int k = 0; k < 6; ++k) { const int idx = tid + 512 * k, i = idx >> 5, c8 = (idx & 31) * 8;
            if (idx < 94 * 32) *(u32x4*)(G + i * 256 + c8) = av[k]; }
        lds_barrier();
        if (it + (int)gridDim.x < NB * (SL / 64)) CF_PREFETCH(it + (int)gridDim.x);
        { const int c = tid & 255, hf = tid >> 8;
#pragma unroll 1
          for (int rnd = 0; rnd < 2; ++rnd) {
              const int r0 = hf * 32 + rnd * 16;
              float acc[16];
#pragma unroll
              for (int o = 0; o < 16; ++o) acc[o] = bias;
#pragma unroll
              for (int r = 0; r < 46; ++r) { const float v = bf2f(G[(r0 + r) * 256 + c]);
#pragma unroll
                  for (int o = 0; o < 16; ++o) { if (r - o >= 0 && r - o < 31) acc[o] += w[r - o] * v; } }
#pragma unroll
              for (int o = 0; o < 16; ++o) CV[(r0 + o) * 256 + c] = acc[o];
          } }
        lds_barrier();
        { f32x4 v[8]; float s1[8], s2[8];
#pragma unroll
          for (int i = 0; i < 8; ++i) { v[i] = *(const f32x4*)(CV + (wave * 8 + i) * 256 + lane * 4); s1[i] = (v[i].x + v[i].y) + (v[i].z + v[i].w); }
          wave_sum_n<8>(s1);
#pragma unroll
          for (int i = 0; i < 8; ++i) { v[i] = v[i] - s1[i] * (1.0f / DC); s2[i] = (v[i].x * v[i].x + v[i].y * v[i].y) + (v[i].z * v[i].z + v[i].w * v[i].w); }
          wave_sum_n<8>(s2);
          const f32x4 gv = *(const f32x4*)(lng + lane * 4), bv = *(const f32x4*)(lnb + lane * 4);
#pragma unroll
          for (int i = 0; i < 8; ++i) { const float rstd = rsqrtf(s2[i] * (1.0f / DC) + EPS);
              const f32x4 y = v[i] * rstd * gv + bv;
              u32x2 w; w.x = pk2(siluf_(y.x), siluf_(y.y)); w.y = pk2(siluf_(y.z), siluf_(y.w));
              *(u32x2*)(A + (wave * 8 + i) * 264 + lane * 4) = w; } }
        lds_barrier();
        { f32x4 acc[4][2];
#pragma unroll
          for (int m = 0; m < 4; ++m) { acc[m][0] = (f32x4){0.f, 0.f, 0.f, 0.f}; acc[m][1] = (f32x4){0.f, 0.f, 0.f, 0.f}; }
          const int n0 = wave * 32;
#pragma unroll
          for (int ks = 0; ks < 8; ++ks) {
              bf16x8 bf[2], af[4];
#pragma unroll
              for (int n = 0; n < 2; ++n) bf[n] = *(const bf16x8*)(PwT + (size_t)(n0 + n * 16 + fr) * DC + ks * 32 + fq * 8);
#pragma unroll
              for (int m = 0; m < 4; ++m) af[m] = *(const bf16x8*)(A + (m * 16 + fr) * 264 + ks * 32 + fq * 8);
#pragma unroll
              for (int m = 0; m < 4; ++m)
#pragma unroll
                  for (int n = 0; n < 2; ++n) acc[m][n] = __builtin_amdgcn_mfma_f32_16x16x32_bf16(af[m], bf[n], acc[m][n], 0, 0, 0);
          }
#pragma unroll
          for (int n = 0; n < 2; ++n) { const int col = n0 + n * 16 + fr; const float bb = pwb[col];
#pragma unroll
              for (int m = 0; m < 4; ++m)
#pragma unroll
                  for (int j = 0; j < 4; ++j) CV[(m * 16 + fq * 4 + j) * 256 + col] = acc[m][n][j] + bb; } }
        lds_barrier();
        { f32x4 v[8]; float s2[8]; u32x2 gt[8];
#pragma unroll
          for (int i = 0; i < 8; ++i) { const int tl = wave * 8 + i; const size_t row = (size_t)b * SL + t0 + tl;
              gt[i] = *(const u32x2*)(P + row * NC + C_GATE + DH + lane * 4);
              v[i] = *(const f32x4*)(CV + tl * 256 + lane * 4); s2[i] = (v[i].x * v[i].x + v[i].y * v[i].y) + (v[i].z * v[i].z + v[i].w * v[i].w); }
          wave_sum_n<8>(s2);
          const f32x4 gv = *(const f32x4*)(gg + lane * 4);
#pragma unroll
          for (int i = 0; i < 8; ++i) { const int tl = wave * 8 + i; const size_t row = (size_t)b * SL + t0 + tl;
              const float rstd = rsqrtf(s2[i] * (1.0f / DC) + EPS);
              const float g0 = __uint_as_float(gt[i].x << 16), g1 = __uint_as_float(gt[i].x & 0xffff0000u), g2 = __uint_as_float(gt[i].y << 16), g3 = __uint_as_float(gt[i].y & 0xffff0000u);
              u32x2 w; w.x = pk2(v[i].x * rstd * gv.x * siluf_(g0), v[i].y * rstd * gv.y * siluf_(g1)); w.y = pk2(v[i].z * rstd * gv.z * siluf_(g2), v[i].w * rstd * gv.w * siluf_(g3));
              *(u32x2*)(Y + row * DM + DH + lane * 4) = w; } }
        lds_barrier();
    }
}

template <bool PASSB>
__device__ __forceinline__ void phase_rglru(const Params& p, int l, unsigned char* lds) {
    float* XRF = (float*)lds;
    bf16_t* XRB = (bf16_t*)(lds + 32768);
    float* AS = (float*)(lds + 32768 + 18432);
    float* BS = AS + 128 * 64;
    float* SEGA = BS + 128 * 64;
    float* SEGB = SEGA + 512;
    float* CARRY = SEGB + 512;
    bf16_t* RAWR = (bf16_t*)(CARRY + 64);
    bf16_t* P = (bf16_t*)(p.ws + WS_P); float* AGG = (float*)(p.ws + WS_AGG);
    const float* cw = p.in[I_RCW] + (size_t)l * 4 * DR; const float* cb = p.in[I_RCB] + l * DR;
    const int tid = threadIdx.x, lane = tid & 63, wave = tid >> 6, fr = lane & 15, fq = lane >> 4;
    const int cc = tid & 63, seg = tid >> 6;
    const int mh = wave >> 2, jq = wave & 3;
    for (int it = blockIdx.x; it < NB * 6 * NCHUNK * 2; it += gridDim.x) {
        const int dir = it & 1, ch = (it >> 1) % NCHUNK, h = ((it >> 1) / NCHUNK) % 6, b = (it >> 1) / (NCHUNK * 6);
        bf16_t* pb = P + (size_t)b * SL * NC;
        bf16x8 Ba[2], Bx[2];
        { const bf16_t* wa = (const bf16_t*)(p.ws + WS_RGWT) + ((size_t)((l * 2 + dir) * 2 + 0) * 6 + h) * 4096;
          const bf16_t* wx = (const bf16_t*)(p.ws + WS_RGWT) + ((size_t)((l * 2 + dir) * 2 + 1) * 6 + h) * 4096;
#pragma unroll
          for (int ks = 0; ks < 2; ++ks) { Ba[ks] = *(const bf16x8*)(wa + (jq * 16 + fr) * 64 + ks * 32 + fq * 8); Bx[ks] = *(const bf16x8*)(wx + (jq * 16 + fr) * 64 + ks * 32 + fq * 8); } }
        const int gch = h * 64 + jq * 16 + fr;
        const float bga = p.in[I_RBA][(l * 2 + dir) * DR + gch], bgx = p.in[I_RBX][(l * 2 + dir) * DR + gch];
        const float lam = p.in[I_RLAM][(l * 2 + dir) * DR + gch];
        const float sp8l2 = 8.0f * 1.4426950408889634f * log1pf(__expf(-lam));
        const int c = h * 64 + cc;
        const float w0 = cw[c], w1 = cw[DR + c], w2 = cw[2 * DR + c], w3 = cw[3 * DR + c], cbias = cb[c];
        if (tid < 64) {
            float cin = 0.f;
            if (PASSB) {
                if (dir == 0) { for (int j = 0; j < ch; ++j) { const float* ag = AGG + ((size_t)((b * NCHUNK + j) * 2 + 0) * 2) * DR + c; cin = ag[0] * cin + ag[DR]; } }
                else { for (int j = NCHUNK - 1; j > ch; --j) { const float* ag = AGG + ((size_t)((b * NCHUNK + j) * 2 + 1) * 2) * DR + c; cin = ag[0] * cin + ag[DR]; } }
            }
            CARRY[tid] = cin;
        }
        float totA = 1.f;
        for (int s = 0; s < 4; ++s) {
            const int st = dir ? 3 - s : s, t0 = ch * CHUNK + st * 128;
#pragma unroll
            for (int k = 0; k < 3; ++k) { const int idx = tid + 512 * k;
                if (idx < 1048) { const int r = idx >> 3, sg = idx & 7, t = t0 - 2 + r;
                    u32x4 v = {0u, 0u, 0u, 0u};
                    if (t >= 0 && t < SL) v = *(const u32x4*)(pb + (size_t)t * NC + C_RG + h * 64 + sg * 8);
                    *(u32x4*)(RAWR + r * 64 + sg * 8) = v; } }
            __syncthreads();
            { const bf16_t* rr = RAWR + (seg * 16) * 64 + cc;
              float pm2 = bf2f(rr[0]), pm1 = bf2f(rr[64]), p0 = bf2f(rr[128]);
#pragma unroll
              for (int i = 0; i < 16; ++i) {
                  const float pp = bf2f(rr[(i + 3) * 64]);
                  const float xr = w0 * pm2 + w1 * pm1 + w2 * p0 + w3 * pp + cbias;
                  const int tl = seg * 16 + i, si = dir ? 127 - tl : tl;
                  XRF[si * 64 + cc] = xr; XRB[si * 72 + cc] = f2bf(xr);
                  pm2 = pm1; pm1 = p0; p0 = pp; } }
            __syncthreads();
#pragma unroll
            for (int m = 0; m < 4; ++m) {
                f32x4 ga = {0.f, 0.f, 0.f, 0.f}, gx = {0.f, 0.f, 0.f, 0.f};
#pragma unroll
                for (int ks = 0; ks < 2; ++ks) { const bf16x8 af = *(const bf16x8*)(XRB + (mh * 64 + m * 16 + fr) * 72 + ks * 32 + fq * 8);
                    ga = __builtin_amdgcn_mfma_f32_16x16x32_bf16(af, Ba[ks], ga, 0, 0, 0); gx = __builtin_amdgcn_mfma_f32_16x16x32_bf16(af, Bx[ks], gx, 0, 0, 0); }
#pragma unroll
                for (int j = 0; j < 4; ++j) { const int si = mh * 64 + m * 16 + fq * 4 + j, col = jq * 16 + fr;
                    const float r = sigmoidf_(ga[j] + bga), ig = sigmoidf_(gx[j] + bgx);
                    const float la2 = -sp8l2 * r; const float a = __builtin_amdgcn_exp2f(la2); const float mult = __builtin_amdgcn_sqrtf(fmaxf(1.0f - a * a, 0.f));
                    AS[si * 64 + col] = a; BS[si * 64 + col] = mult * ig * XRF[si * 64 + col]; }
            }
            __syncthreads();
            float hl[16], ca[16];
            { float hh = 0.f, cum = 1.f;
#pragma unroll
              for (int i = 0; i < 16; ++i) { const float a = AS[(seg * 16 + i) * 64 + cc], bb = BS[(seg * 16 + i) * 64 + cc]; hh = a * hh + bb; cum *= a; hl[i] = hh; ca[i] = cum; }
              SEGA[seg * 64 + cc] = cum; SEGB[seg * 64 + cc] = hh; }
            __syncthreads();
            float cin = CARRY[cc];
            for (int q = 0; q < seg; ++q) cin = SEGA[q * 64 + cc] * cin + SEGB[q * 64 + cc];
            if (PASSB) {
                bf16_t* dst = pb + (dir ? C_V : C_X1) + c;
#pragma unroll
                for (int i = 0; i < 16; ++i) { const int si = seg * 16 + i, tl = dir ? 127 - si : si; dst[(size_t)(t0 + tl) * NC] = f2bf(hl[i] + ca[i] * cin); }
            }
            float ncar = 0.f, prodA = 1.f;
            if (seg == 7) { ncar = hl[15] + ca[15] * cin;
#pragma unroll
                for (int q = 0; q < 8; ++q) prodA *= SEGA[q * 64 + cc]; }
            __syncthreads();
            if (seg == 7) { CARRY[cc] = ncar; totA *= prodA; }
        }
        __syncthreads();
        if (!PASSB && seg == 7) { float* ag = AGG + ((size_t)((b * NCHUNK + ch) * 2 + dir) * 2) * DR + c; ag[0] = totA; ag[DR] = CARRY[cc]; }
        __syncthreads();
    }
}

constexpr int NSUB = SL / 128, NSEQ = NB * 6 * 2;
__device__ __forceinline__ void phase_rglru_chain(const Params& p, int l, unsigned char* lds) {
    float* XRF = (float*)lds;
    bf16_t* XRB = (bf16_t*)(lds + 32768);
    float* AS = (float*)(lds + 32768 + 18432);
    float* BS = AS + 128 * 64;
    float* SEGA = BS + 128 * 64;
    float* SEGB = SEGA + 512;
    float* CARRY = SEGB + 512;
    bf16_t* RAWR = (bf16_t*)(CARRY + 64);
    bf16_t* P = (bf16_t*)(p.ws + WS_P);
    unsigned long long* GR = (unsigned long long*)(p.ws + WS_GRAN) + (size_t)l * NSUB * NSEQ * 64;
    const float* cw = p.in[I_RCW] + (size_t)l * 4 * DR; const float* cb = p.in[I_RCB] + l * DR;
    u32x4 pf[3];
#define RG_PREFETCH(IT) do { const int _sub = (IT) / NSEQ, _sq = (IT) % NSEQ, _dir = _sq & 1, _h = (_sq >> 1) % 6, _b = (_sq >> 1) / 6; \
        const int _t0 = (_dir ? NSUB - 1 - _sub : _sub) * 128; const bf16_t* _pb = P + (size_t)_b * SL * NC; const int _tid = threadIdx.x; \
        _Pragma("unroll") for (int k = 0; k < 3; ++k) { const int idx = _tid + 512 * k, r = idx >> 3, sg = idx & 7, t = _t0 - 2 + r; pf[k] = (u32x4){0u, 0u, 0u, 0u}; \
            if (idx < 1048 && t >= 0 && t < SL) pf[k] = *(const u32x4*)(_pb + (size_t)t * NC + C_RG + _h * 64 + sg * 8); } } while (0)
    if ((int)blockIdx.x < NSUB * NSEQ) { RG_PREFETCH((int)blockIdx.x);
#pragma unroll
        for (int k = 0; k < 3; ++k) { const int idx = (int)threadIdx.x + 512 * k; if (idx < 1048) *(u32x4*)(RAWR + (idx >> 3) * 64 + (idx & 7) * 8) = pf[k]; } }
    lds_barrier();
    for (int it = blockIdx.x; it < NSUB * NSEQ; it += gridDim.x) {
        const int tid = launder_tid(), lane = tid & 63, wave = tid >> 6, fr = lane & 15, fq = lane >> 4;
        const int cc = tid & 63, seg = tid >> 6, mh = wave >> 2, jq = wave & 3;
        const int sub = it / NSEQ, sq = it % NSEQ, dir = sq & 1, h = (sq >> 1) % 6, b = (sq >> 1) / 6;
        const int st = dir ? NSUB - 1 - sub : sub, t0 = st * 128;
        bf16_t* pb = P + (size_t)b * SL * NC;
        unsigned long long gv0 = 0ull;
        if (wave == 0 && sub > 0) gv0 = __hip_atomic_load(GR + ((size_t)(sub - 1) * NSEQ + sq) * 64 + lane, __ATOMIC_RELAXED, __HIP_MEMORY_SCOPE_AGENT);
        bf16x8 Ba[2], Bx[2];
        { const bf16_t* wa = (const bf16_t*)(p.ws + WS_RGWT) + ((size_t)((l * 2 + dir) * 2 + 0) * 6 + h) * 4096;
          const bf16_t* wx = (const bf16_t*)(p.ws + WS_RGWT) + ((size_t)((l * 2 + dir) * 2 + 1) * 6 + h) * 4096;
#pragma unroll
          for (int ks = 0; ks < 2; ++ks) { Ba[ks] = *(const bf16x8*)(wa + (jq * 16 + fr) * 64 + ks * 32 + fq * 8); Bx[ks] = *(const bf16x8*)(wx + (jq * 16 + fr) * 64 + ks * 32 + fq * 8); } }
        const int gch = h * 64 + jq * 16 + fr;
        const float bga = p.in[I_RBA][(l * 2 + dir) * DR + gch], bgx = p.in[I_RBX][(l * 2 + dir) * DR + gch];
        const float lam = p.in[I_RLAM][(l * 2 + dir) * DR + gch];
        const float sp8l2 = 8.0f * 1.4426950408889634f * log1pf(__expf(-lam));
        const int c = h * 64 + cc;
        const float w0 = cw[c], w1 = cw[DR + c], w2 = cw[2 * DR + c], w3 = cw[3 * DR + c], cbias = cb[c];
        const bool has_next = it + (int)gridDim.x < NSUB * NSEQ;
        if (has_next) RG_PREFETCH(it + (int)gridDim.x);
        { const bf16_t* rr = RAWR + (seg * 16) * 64 + cc;
          float pm2 = bf2f(rr[0]), pm1 = bf2f(rr[64]), p0 = bf2f(rr[128]);
#pragma unroll
          for (int i = 0; i < 16; ++i) {
              const float pp = bf2f(rr[(i + 3) * 64]);
              const float xr = w0 * pm2 + w1 * pm1 + w2 * p0 + w3 * pp + cbias;
              const int tl = seg * 16 + i, si = dir ? 127 - tl : tl;
              XRF[si * 64 + cc] = xr; XRB[si * 72 + cc] = f2bf(xr);
              pm2 = pm1; pm1 = p0; p0 = pp; } }
        lds_barrier();
#pragma unroll
        for (int m = 0; m < 4; ++m) {
            f32x4 ga = {0.f, 0.f, 0.f, 0.f}, gx = {0.f, 0.f, 0.f, 0.f};
#pragma unroll
            for (int ks = 0; ks < 2; ++ks) { const bf16x8 af = *(const bf16x8*)(XRB + (mh * 64 + m * 16 + fr) * 72 + ks * 32 + fq * 8);
                ga = __builtin_amdgcn_mfma_f32_16x16x32_bf16(af, Ba[ks], ga, 0, 0, 0); gx = __builtin_amdgcn_mfma_f32_16x16x32_bf16(af, Bx[ks], gx, 0, 0, 0); }
#pragma unroll
            for (int j = 0; j < 4; ++j) { const int si = mh * 64 + m * 16 + fq * 4 + j, col = jq * 16 + fr;
                const float r = sigmoidf_(ga[j] + bga), ig = sigmoidf_(gx[j] + bgx);
                const float la2 = -sp8l2 * r; const float a = __builtin_amdgcn_exp2f(la2); const float mult = __builtin_amdgcn_sqrtf(fmaxf(1.0f - a * a, 0.f));
                AS[si * 64 + col] = a; BS[si * 64 + col] = mult * ig * XRF[si * 64 + col]; }
        }
        lds_barrier();
        float hl[16], ca[16];
        { float hh = 0.f, cum = 1.f;
#pragma unroll
          for (int i = 0; i < 16; ++i) { const float a = AS[(seg * 16 + i) * 64 + cc], bb = BS[(seg * 16 + i) * 64 + cc]; hh = a * hh + bb; cum *= a; hl[i] = hh; ca[i] = cum; }
          SEGA[seg * 64 + cc] = cum; SEGB[seg * 64 + cc] = hh; }
        if (wave == 0) {
            float cin = 0.f;
            if (sub > 0) {
                unsigned long long* g = GR + ((size_t)(sub - 1) * NSEQ + sq) * 64 + lane;
                unsigned long long v = gv0; unsigned sp = 0;
                while ((unsigned)(v >> 32) != 1u) { __builtin_amdgcn_s_sleep(1); if (++sp > (1u << 22)) break; v = __hip_atomic_load(g, __ATOMIC_RELAXED, __HIP_MEMORY_SCOPE_AGENT); }
                cin = __uint_as_float((unsigned)v);
            }
            CARRY[lane] = cin;
        }
        lds_barrier();
        float cin = CARRY[cc];
        for (int q = 0; q < seg; ++q) cin = SEGA[q * 64 + cc] * cin + SEGB[q * 64 + cc];
        if (seg == 7) {
            const float ncar = hl[15] + ca[15] * cin;
            __hip_atomic_store(GR + ((size_t)sub * NSEQ + sq) * 64 + cc, ((unsigned long long)1u << 32) | (unsigned long long)__float_as_uint(ncar), __ATOMIC_RELAXED, __HIP_MEMORY_SCOPE_AGENT);
        }
        { bf16_t* dst = pb + (dir ? C_V : C_X1) + c;
#pragma unroll
          for (int i = 0; i < 16; ++i) { const int si = seg * 16 + i, tl = dir ? 127 - si : si; dst[(size_t)(t0 + tl) * NC] = f2bf(hl[i] + ca[i] * cin); } }
        if (has_next) {
#pragma unroll
            for (int k = 0; k < 3; ++k) { const int idx = tid + 512 * k; if (idx < 1048) *(u32x4*)(RAWR + (idx >> 3) * 64 + (idx & 7) * 8) = pf[k]; } }
        lds_barrier();
    }
#undef RG_PREFETCH
}

__device__ __forceinline__ void unpack6(const U3 v, float (&o)[6]) {
    o[0] = __uint_as_float(v.x << 16); o[1] = __uint_as_float(v.x & 0xffff0000u); o[2] = __uint_as_float(v.y << 16); o[3] = __uint_as_float(v.y & 0xffff0000u);
    o[4] = __uint_as_float(v.z << 16); o[5] = __uint_as_float(v.z & 0xffff0000u);
}
__device__ __forceinline__ void phase_finalize(const Params& p, int l, unsigned char* lds) {
    float* UT = (float*)lds;
    const bf16_t* P = (const bf16_t*)(p.ws + WS_P); bf16_t* Y = (bf16_t*)(p.ws + WS_HY); const bf16_t* U = (const bf16_t*)(p.ws + WS_U);
    const float* cw = p.in[I_HCW] + (size_t)l * 3 * 1152; const float* cb = p.in[I_HCB] + l * 1152; const float* gg = p.in[I_GRPG] + l * DM;
    const int tid = threadIdx.x, lane = tid & 63, wave = tid >> 6;
    float w0[6], w1[6], w2[6], wb[6], ghy[6], grg[6];
#pragma unroll
    for (int q = 0; q < 6; ++q) { const int c = lane * 6 + q; w0[q] = cw[c]; w1[q] = cw[1152 + c]; w2[q] = cw[2304 + c]; wb[q] = cb[c]; ghy[q] = gg[c]; grg[q] = gg[640 + c]; }
    u32x4 pf[6];
#define FIN_PREFETCH(IT) do { const int _b = (IT) / (SL / 64), _t0 = ((IT) % (SL / 64)) * 64; \
        _Pragma("unroll") for (int k = 0; k < 6; ++k) { const int idx = tid + 512 * k, c = idx >> 3, t8 = (idx & 7) * 8; pf[k] = *(const u32x4*)(U + ((size_t)_b * DH + c) * SL + _t0 + t8); } } while (0)
    if ((int)blockIdx.x < NB * (SL / 64)) FIN_PREFETCH((int)blockIdx.x);
    for (int it = blockIdx.x; it < NB * (SL / 64); it += gridDim.x) {
        const int b = it / (SL / 64), t0 = (it % (SL / 64)) * 64;
#pragma unroll
        for (int k = 0; k < 6; ++k) { const int idx = tid + 512 * k, c = idx >> 3, t8 = (idx & 7) * 8;
            const u32x4 v = pf[k];
#pragma unroll
            for (int j = 0; j < 4; ++j) { UT[c * 65 + t8 + 2 * j] = __uint_as_float(v[j] << 16); UT[c * 65 + t8 + 2 * j + 1] = __uint_as_float(v[j] & 0xffff0000u); } }
        lds_barrier();
        if (it + (int)gridDim.x < NB * (SL / 64)) FIN_PREFETCH(it + (int)gridDim.x);
        const bf16_t* pb = P + (size_t)b * SL * NC;
#pragma unroll 4
        for (int i = 0; i < 8; ++i) { const int tl = wave * 8 + i, t = t0 + tl; const size_t row = (size_t)b * SL + t;
            const bf16_t* pq = pb + (size_t)t * NC + lane * 6; const bf16_t* pr = pq + C_X0;
            const int om = (t > 0) ? -NC : 0, op = (t + 1 < SL) ? NC : 0;
            const float fm = (t > 0) ? 1.f : 0.f, fp = (t + 1 < SL) ? 1.f : 0.f;
            const U3 rm = *(const U3*)(pr + om), rc = *(const U3*)pr, rp = *(const U3*)(pr + op), rg = *(const U3*)(pq + C_GATE);
            const U3 rf = *(const U3*)(pq + C_X1), rb = *(const U3*)(pq + C_V), rg2 = *(const U3*)(pq + C_GATE + 640);
            float xm[6], xc[6], xp[6], gt[6], y[6], ss = 0.f;
            unpack6(rm, xm); unpack6(rc, xc); unpack6(rp, xp); unpack6(rg, gt);
#pragma unroll
            for (int q = 0; q < 6; ++q) { const float x0 = w0[q] * (xm[q] * fm) + w1[q] * xc[q] + w2[q] * (xp[q] * fp) + wb[q];
                y[q] = UT[(lane * 6 + q) * 65 + tl] * x0; ss += y[q] * y[q]; }
            float rstd = rsqrtf(wave_sum(ss) * (1.0f / DH) + EPS);
            { U3 o; o.x = pk2(y[0] * rstd * ghy[0] * siluf_(gt[0]), y[1] * rstd * ghy[1] * siluf_(gt[1])); o.y = pk2(y[2] * rstd * ghy[2] * siluf_(gt[2]), y[3] * rstd * ghy[3] * siluf_(gt[3]));
              o.z = pk2(y[4] * rstd * ghy[4] * siluf_(gt[4]), y[5] * rstd * ghy[5] * siluf_(gt[5])); *(U3*)(Y + row * DM + lane * 6) = o; }
            unpack6(rf, xm); unpack6(rb, xc); unpack6(rg2, gt); ss = 0.f;
#pragma unroll
            for (int q = 0; q < 6; ++q) { y[q] = xm[q] + xc[q]; ss += y[q] * y[q]; }
            rstd = rsqrtf(wave_sum(ss) * (1.0f / DR) + EPS);
            { U3 o; o.x = pk2(y[0] * rstd * grg[0] * siluf_(gt[0]), y[1] * rstd * grg[1] * siluf_(gt[1])); o.y = pk2(y[2] * rstd * grg[2] * siluf_(gt[2]), y[3] * rstd * grg[3] * siluf_(gt[3]));
              o.z = pk2(y[4] * rstd * grg[4] * siluf_(gt[4]), y[5] * rstd * grg[5] * siluf_(gt[5])); *(U3*)(Y + row * DM + 640 + lane * 6) = o; }
        }
        lds_barrier();
    }
}

#define XB_TMO      128
#define XB_XCNT(j)  (256  + 64 * (j))
#define XB_XSUB(j)  (1280 + 64 * (j))
#define XB_XGEN(j)  (2304 + 64 * (j))
#define XB_TOP      3328
#define XB_TOPGEN   3392
#define XCD_BAR_WORDS 3456
#define XB_SPIN_CAP (1u << 22)
#define LAS __attribute__((address_space(3)))
__device__ __forceinline__ unsigned xb_ld(unsigned* p)              { return __hip_atomic_load(p, __ATOMIC_RELAXED, __HIP_MEMORY_SCOPE_AGENT); }
__device__ __forceinline__ unsigned xb_add(unsigned* p, unsigned v) { return __hip_atomic_fetch_add(p, v, __ATOMIC_RELAXED, __HIP_MEMORY_SCOPE_AGENT); }
__device__ __forceinline__ unsigned xb_xcc_id() { return (unsigned)__builtin_amdgcn_s_getreg((3 << 11) | 20) & 0xFu; }
#define XB_SPIN(cond, bar) do { unsigned _sp = 0; while (cond) { __builtin_amdgcn_s_sleep(1); \
    if ((++_sp & 255u) == 0u) { if (xb_ld(&(bar)[XB_TMO])) break; if (_sp > XB_SPIN_CAP) { atomicAdd(&(bar)[XB_TMO], 1u); break; } } } } while (0)
struct XcdBarrier { unsigned* bar; unsigned x; volatile LAS unsigned* st; };
__device__ __forceinline__ XcdBarrier xcd_barrier_post(unsigned* bar, volatile LAS unsigned* st) {
    XcdBarrier b; b.bar = bar; b.x = xb_xcc_id(); b.st = st;
    if (threadIdx.x == 0) (void)xb_add(&bar[XB_XCNT(b.x)], 1u);
    return b;
}
__device__ __forceinline__ void xcd_barrier_complete(unsigned* bar, unsigned x, unsigned& nloc, unsigned& nx) {
    const unsigned G = gridDim.x * gridDim.y * gridDim.z;
    unsigned sum, cnt, mine, sp = 0u;
    for (;;) {
        sum = 0u; cnt = 0u; mine = 0u;
#pragma unroll
        for (unsigned j = 0; j < 16; ++j) { const unsigned c = xb_ld(&bar[XB_XCNT(j)]); sum += c; cnt += (c > 0u) ? 1u : 0u; mine = (j == x) ? c : mine; }
        if (sum == G) break;
        __builtin_amdgcn_s_sleep(1);
        if ((++sp & 255u) == 0u) { if (xb_ld(&bar[XB_TMO])) break; if (sp > XB_SPIN_CAP) { atomicAdd(&bar[XB_TMO], 1u); break; } }
    }
    nloc = mine > 0u ? mine : 1u; nx = cnt > 0u ? cnt : 1u;
}
__device__ __forceinline__ void xcd_barrier(const XcdBarrier& b) {
    asm volatile("s_waitcnt vmcnt(0)" ::: "memory");
    __syncthreads();
    if (threadIdx.x == 0) {
        unsigned* bar = b.bar;
        __builtin_amdgcn_s_waitcnt(0);
        unsigned nloc = b.st[0], nx = b.st[1];
        if (nloc == 0u) { xcd_barrier_complete(bar, b.x, nloc, nx); b.st[0] = nloc; b.st[1] = nx; }
        const unsigned old = xb_add(&bar[XB_XSUB(b.x)], 1u);
        const unsigned gen = old / nloc;
        if (old + 1u == (gen + 1u) * nloc) {
            __builtin_amdgcn_fence(__ATOMIC_RELEASE, "agent");
            asm volatile("s_waitcnt vmcnt(0)" ::: "memory");
            const unsigned og = xb_add(&bar[XB_TOP], 1u);
            const unsigned tg = og / nx;
            if (og + 1u == (tg + 1u) * nx) xb_add(&bar[XB_TOPGEN], 1u);
            else XB_SPIN(xb_ld(&bar[XB_TOPGEN]) == tg, bar);
            __builtin_amdgcn_fence(__ATOMIC_ACQUIRE, "agent");
            xb_add(&bar[XB_XGEN(b.x)], 1u);
            asm volatile("s_waitcnt vmcnt(0)" ::: "memory");
        } else {
            XB_SPIN(xb_ld(&bar[XB_XGEN(b.x)]) == gen, bar);
            __builtin_amdgcn_fence(__ATOMIC_ACQUIRE, "agent");
            asm volatile("s_waitcnt vmcnt(0)" ::: "memory");
        }
    }
    __syncthreads();
}

constexpr int NPHASE = 13;
#ifndef MK_DUP
#define MK_DUP 0
#endif
#define DUPN(bit) (((MK_DUP >> (bit)) & 1) ? 2 : 1)
template <int PH>
__device__ __forceinline__ void run_phase(const Params& p, unsigned char* lds, int vc) {
    float* SS = (float*)(p.ws + WS_SS);
    if constexpr (PH == 0) {
        if ((blockIdx.x >> 3) & 1) {
            phase_x0_prep(p.in[I_XP], p.in[I_XS], (bf16_t*)p.out, SS); asm volatile("" ::: "memory");
            phase_prep_weights(p, lds); phase_filters(p, 0, lds);
        } else {
            phase_prep_weights(p, lds); phase_filters(p, 0, lds); asm volatile("" ::: "memory");
            phase_x0_prep(p.in[I_XP], p.in[I_XS], (bf16_t*)p.out, SS);
        }
    } else if constexpr (PH == 12) {
        phase_final_norm((const bf16_t*)(p.ws + WS_P), SS + 2 * T, p.in[I_FING], p.out);
    } else {
        constexpr int l = (PH - 1) / 6, s = (PH - 1) % 6;
        if constexpr (s == 0) {
            pg8::Gemm g; g.A = (const bf16_t*)p.out; g.Bt = (const bf16_t*)(p.ws + WS_WINT) + (size_t)l * NC * DM; g.M = T; g.N = NC; g.K = DM;
            pg8::StaticOrder S; S.init(T, NC, (int)gridDim.x, vc);
            pg8::EpiBf16 E; E.O = (bf16_t*)(p.ws + WS_P); E.ldc = NC; E.ss = SS + l * T; E.invk = 1.0f / DM; E.eps = EPS; E.glu_tiles = 2;
            pg8::gemm_phase<pg8::EpiBf16, pg8::StaticOrder, false>((PG8_LAS unsigned char*)lds, g, S, E, nullptr);
        } else if constexpr (s == 1) {
            phase_kf_fft(p, lds);
            for (int r = 0; r < DUPN(0); ++r) phase_conformer(p, l, lds);
            for (int r = 0; r < DUPN(1); ++r) phase_hyena_prep(p, l, lds);
        } else if constexpr (s == 2) {
            phase_fftconv(p, l, lds);
            for (int r = 0; r < DUPN(3); ++r) phase_rglru_chain(p, l, lds);
        } else if constexpr (s == 3) {
            for (int r = 0; r < DUPN(4); ++r) phase_finalize(p, l, lds);
            if constexpr (l == 0) phase_filters(p, 1, lds);
        } else if constexpr (s == 4) {
            pg8::Gemm g; g.A = (const bf16_t*)(p.ws + WS_HY); g.Bt = (const bf16_t*)(p.ws + WS_WOUTT) + (size_t)l * DM * DM; g.M = T; g.N = DM; g.K = DM;
            pg8::StaticOrder S; S.init(T, DM, (int)gridDim.x, vc);
            pg8::EpiResB E; E.R = (const bf16_t*)p.out; E.O = (l == 0) ? (bf16_t*)p.out : (bf16_t*)(p.ws + WS_P); E.ldc = DM; E.ssq = SS + (l + 1) * T;
            pg8::gemm_phase<pg8::EpiResB, pg8::StaticOrder, false>((PG8_LAS unsigned char*)lds, g, S, E, nullptr);
        }
    }
}
__global__ __launch_bounds__(512, 2) void mega(Params p) {
    extern __shared__ __attribute__((aligned(16))) unsigned char lds[];
    cg::grid_group grid = cg::this_grid();
    volatile LAS unsigned* xst = (volatile LAS unsigned*)(PG8_LAS unsigned char*)(lds + LDS_BYTES);
    if (threadIdx.x == 0) { xst[0] = 0u; xst[1] = 0u; xst[2] = blockIdx.x; xst[3] = 0u; }
    __syncthreads();
    const bool multi = (p.ph_hi - p.ph_lo) > 1;
    XcdBarrier xb; xb.bar = (unsigned*)(p.ws + WS_BAR); xb.x = 0; xb.st = xst;
    unsigned myrank = 0u;
    if (multi) { xb = xcd_barrier_post((unsigned*)(p.ws + WS_BAR), xst);
        if (threadIdx.x == 0) myrank = xb_add(&xb.bar[RK_BASE + 64 * xb.x], 1u); }
#ifndef MK_MASK
#define MK_MASK 0x1fff
#endif
#define RUN_PH(PH) if constexpr ((MK_MASK >> PH) & 1) if (p.ph_lo <= PH && PH < p.ph_hi) { run_phase<PH>(p, lds, (int)xst[2]); asm volatile("" ::: "memory"); if (PH + 1 < p.ph_hi) { if (p.ph_lo > 1000) grid.sync(); else xcd_barrier(xb); } }
    RUN_PH(0)
    if (multi) {
        if (threadIdx.x == 0) { bool ok = (gridDim.x % 8u) == 0u;
            for (unsigned j = 0; j < 16; ++j) { const unsigned cnt = xb_ld(&xb.bar[RK_BASE + 64 * j]); if (cnt != ((j < 8u) ? gridDim.x / 8u : 0u)) ok = false; }
            if (ok && xb.x < 8u && myrank < gridDim.x / 8u) xst[2] = myrank * 8u + xb.x; }
        __syncthreads();
    }
    RUN_PH(1) RUN_PH(2) RUN_PH(3) RUN_PH(4) RUN_PH(5) RUN_PH(7) RUN_PH(8) RUN_PH(9) RUN_PH(10) RUN_PH(11) RUN_PH(12)
#undef RUN_PH
}

#ifndef MK_LAUNCHES
#define MK_LAUNCHES 1
#endif
extern "C" void kernel_launch(void* const* d_in, const int* in_sizes, int n_in, void* d_out, int out_size, void* d_ws, size_t ws_size, hipStream_t stream) {
    static int grid = 0;
    if (grid == 0) {
        if (n_in != 31 || out_size != T * DM || ws_size < WS_END) { fprintf(stderr, "kernel_launch: unexpected shapes (n_in %d out %d ws %zu need %zu)\n", n_in, out_size, ws_size, (size_t)WS_END); grid = -1; return; }
        int dev = 0, cus = 0, per_cu = 0;
        (void)hipGetDevice(&dev); (void)hipDeviceGetAttribute(&cus, hipDeviceAttributeMultiprocessorCount, dev);
        if (hipFuncSetAttribute((const void*)mega, hipFuncAttributeMaxDynamicSharedMemorySize, LDS_BYTES + 16) != hipSuccess) { fprintf(stderr, "kernel_launch: hipFuncSetAttribute failed\n"); grid = -1; return; }
        if (hipOccupancyMaxActiveBlocksPerMultiprocessor(&per_cu, (const void*)mega, 512, LDS_BYTES + 16) != hipSuccess || per_cu < 1) { fprintf(stderr, "kernel_launch: occupancy query gave %d\n", per_cu); per_cu = 1; }
        (void)hipGetLastError();
        grid = cus * per_cu;
    }
    if (grid < 0) return;
    if (hipMemsetAsync((char*)d_ws + WS_BAR, 0, CTL_BYTES, stream) != hipSuccess) { fprintf(stderr, "kernel_launch: memset failed\n"); return; }
    Params p{};
    for (int i = 0; i < 31; ++i) p.in[i] = (const float*)d_in[i];
    p.out = (float*)d_out; p.ws = (unsigned char*)d_ws;
#if MK_LAUNCHES == 1
    p.ph_lo = 0; p.ph_hi = NPHASE;
    void* args[] = {&p};
    hipError_t e = hipLaunchCooperativeKernel((const void*)mega, dim3(grid), dim3(512), args, LDS_BYTES + 16, stream);
    if (e != hipSuccess) fprintf(stderr, "cooperative launch failed: %s (grid %d)\n", hipGetErrorString(e), grid);
#else
    for (int ph = 0; ph < NPHASE; ++ph) { p.ph_lo = ph; p.ph_hi = ph + 1; hipLaunchKernelGGL(mega, dim3(grid), dim3(512), LDS_BYTES + 16, stream, p); }
#endif
}
```

```cpp
#include <hip/hip_runtime.h>
#include <hip/hip_cooperative_groups.h>
#include <cstdio>
#include <cstdint>
namespace cg = cooperative_groups;

namespace pg8 {
#define PG8_LAS __attribute__((address_space(3)))
typedef unsigned short bf16_t;
typedef short bf16x8 __attribute__((ext_vector_type(8)));
typedef float f32x4 __attribute__((ext_vector_type(4)));
typedef unsigned u32x4 __attribute__((ext_vector_type(4)));
constexpr int BM = 256, BK = 64, HALF = 128, HTB = HALF * BK * 2, STAGE_BYTES = 8 * HTB, NXCD = 8, WGM = 8;

__host__ __device__ __forceinline__ int lds_byte(int r, int c) { const int st = (r >> 4) * 2 + (c >> 5), rr = r & 15, cc = c & 31, ob = rr * 64 + cc * 2; return st * 1024 + (ob ^ (((ob >> 9) & 1) << 5)); }
__host__ __device__ __forceinline__ void stage_rc(int b, int& R, int& C) { const int st = b / 1024, sb = b % 1024, swz = sb ^ (((sb >> 9) & 1) << 5); R = (st >> 1) * 16 + swz / 64; C = (st & 1) * 32 + (swz % 64) / 2; }
__host__ __device__ __forceinline__ int perm32(int rho) { const int n = rho >> 4, i = rho & 15; return 8 * (i >> 2) + 4 * n + (i & 3); }

struct Unit { int pm, pn; };
struct Gemm { const bf16_t* A; const bf16_t* Bt; int M, N, K; };

struct StaticOrder {
    int nM, nN, nwg, G, c, wgm;
    __host__ __device__ void init(int M, int N, int G_, int c_, int wgm_ = WGM) { nM = M / BM; nN = N / BM; nwg = nM * nN; G = G_; c = c_; wgm = wgm_; }
    __host__ __device__ bool next(int i, Unit& u) const {
        const long L = (long)i * G + c; if (L >= nwg) return false;
        int wgid = (int)L; { const int q = nwg / NXCD, r = nwg % NXCD, xcd = wgid % NXCD, off = wgid / NXCD; wgid = (xcd < r ? xcd * (q + 1) : r * (q + 1) + (xcd - r) * q) + off; }
        const int nig = wgm * nN, gid = wgid / nig, fm = gid * wgm, gsz = (nM - fm) < wgm ? (nM - fm) : wgm;
        u.pm = fm + ((wgid % nig) % gsz); u.pn = (wgid % nig) / gsz; return true;
    }
    __device__ __forceinline__ void a_ready(const Unit&) const {}
    __device__ __forceinline__ void done(const Unit&) const {}
};

__device__ __forceinline__ unsigned cvt_pk_bf16(float lo, float hi) { unsigned r; asm volatile("v_cvt_pk_bf16_f32 %0, %1, %2" : "=v"(r) : "v"(lo), "v"(hi)); return r; }

struct EpiBf16 {
    static constexpr bool PERM = true, AFTER_DRAIN = false;
    bf16_t* O; int ldc; const float* ss; float invk, eps; int glu_tiles;
    __device__ __forceinline__ void operator()(const f32x4 (&acc)[2][2][4][2], const Unit& u, int wr, int wc, int fr, int fq) const {
        const int row0 = u.pm * BM + wr * 64 + fr; const int col0 = u.pn * BM + wc * 32 + 8 * fq;
        float sv[2][4];
#pragma unroll
        for (int ai = 0; ai < 2; ++ai)
#pragma unroll
            for (int m = 0; m < 4; ++m) sv[ai][m] = ss[row0 + ai * HALF + m * 16];
        asm volatile("s_waitcnt vmcnt(0)" ::: "memory");
        if (u.pn >= glu_tiles) {
#pragma unroll
            for (int ai = 0; ai < 2; ++ai)
#pragma unroll
                for (int m = 0; m < 4; ++m) { const int row = row0 + ai * HALF + m * 16; bf16_t* rowp = O + (size_t)row * ldc + col0;
                    const float rs = __builtin_amdgcn_rsqf(sv[ai][m] * invk + eps);
#pragma unroll
                    for (int bj = 0; bj < 2; ++bj) { const f32x4 v0 = acc[ai][bj][m][0] * rs, v1 = acc[ai][bj][m][1] * rs;
                        u32x4 w; w.x = cvt_pk_bf16(v0[0], v0[1]); w.y = cvt_pk_bf16(v0[2], v0[3]); w.z = cvt_pk_bf16(v1[0], v1[1]); w.w = cvt_pk_bf16(v1[2], v1[3]);
                        __builtin_nontemporal_store(w, (u32x4*)(rowp + bj * HALF)); } }
        } else {
#pragma unroll
            for (int ai = 0; ai < 2; ++ai)
#pragma unroll
                for (int m = 0; m < 4; ++m) { const int row = row0 + ai * HALF + m * 16; bf16_t* rowp = O + (size_t)row * ldc + col0;
                    const float rs = __builtin_amdgcn_rsqf(sv[ai][m] * invk + eps), rg = -1.4426950408889634f * rs;
                    f32x4 v0 = acc[ai][0][m][0] * rs, v1 = acc[ai][0][m][1] * rs; const f32x4 g0 = acc[ai][1][m][0] * rg, g1 = acc[ai][1][m][1] * rg;
#pragma unroll
                    for (int j = 0; j < 4; ++j) { v0[j] *= __builtin_amdgcn_rcpf(1.0f + __builtin_amdgcn_exp2f(g0[j])); v1[j] *= __builtin_amdgcn_rcpf(1.0f + __builtin_amdgcn_exp2f(g1[j])); }
                    u32x4 w; w.x = cvt_pk_bf16(v0[0], v0[1]); w.y = cvt_pk_bf16(v0[2], v0[3]); w.z = cvt_pk_bf16(v1[0], v1[1]); w.w = cvt_pk_bf16(v1[2], v1[3]);
                    __builtin_nontemporal_store(w, (u32x4*)rowp); }
        }
    }
};
struct EpiResB {
    static constexpr bool PERM = true, AFTER_DRAIN = false;
    bf16_t* O; const bf16_t* R; int ldc; float* ssq;
    __device__ __forceinline__ void operator()(const f32x4 (&acc)[2][2][4][2], const Unit& u, int wr, int wc, int fr, int fq) const {
        const int row0 = u.pm * BM + wr * 64 + fr, col0 = u.pn * BM + wc * 32 + 8 * fq;
#pragma unroll
        for (int ai = 0; ai < 2; ++ai) {
            u32x4 rv[4][2];
#pragma unroll
            for (int m = 0; m < 4; ++m)
#pragma unroll
                for (int bj = 0; bj < 2; ++bj) rv[m][bj] = *(const u32x4*)(R + (size_t)(row0 + ai * HALF + m * 16) * ldc + col0 + bj * HALF);
            asm volatile("s_waitcnt vmcnt(0)" ::: "memory");
#pragma unroll
            for (int m = 0; m < 4; ++m) { const int row = row0 + ai * HALF + m * 16; const size_t off = (size_t)row * ldc + col0; float s2 = 0.f;
#pragma unroll
                for (int bj = 0; bj < 2; ++bj) {
                    f32x4 v0 = acc[ai][bj][m][0], v1 = acc[ai][bj][m][1]; const u32x4 r4 = rv[m][bj];
                    v0[0] += __uint_as_float(r4.x << 16); v0[1] += __uint_as_float(r4.x & 0xffff0000u); v0[2] += __uint_as_float(r4.y << 16); v0[3] += __uint_as_float(r4.y & 0xffff0000u);
                    v1[0] += __uint_as_float(r4.z << 16); v1[1] += __uint_as_float(r4.z & 0xffff0000u); v1[2] += __uint_as_float(r4.w << 16); v1[3] += __uint_as_float(r4.w & 0xffff0000u);
                    s2 += v0[0] * v0[0] + v0[1] * v0[1] + v0[2] * v0[2] + v0[3] * v0[3] + v1[0] * v1[0] + v1[1] * v1[1] + v1[2] * v1[2] + v1[3] * v1[3];
                    u32x4 w; w.x = cvt_pk_bf16(v0[0], v0[1]); w.y = cvt_pk_bf16(v0[2], v0[3]); w.z = cvt_pk_bf16(v1[0], v1[1]); w.w = cvt_pk_bf16(v1[2], v1[3]);
                    *(u32x4*)(O + off + bj * HALF) = w; }
                s2 += __shfl_xor(s2, 16); s2 += __shfl_xor(s2, 32);
                if (fq == 0) atomicAdd(ssq + row, s2); }
        }
    }
};

template <class Epi, class Sched, bool STAMP = false>
__device__ __forceinline__ void gemm_phase(PG8_LAS unsigned char* lds, const Gemm g, const Sched& S, const Epi& E, unsigned long long* stamps) {
    const int tid = threadIdx.x, wid = __builtin_amdgcn_readfirstlane(tid >> 6), lane = tid & 63, wr = wid >> 2, wc = wid & 3, fr = lane & 15, fq = lane >> 4;
    const int K = g.K, nt = K / BK;
    int ts_lo = 0, ts_hi = 0, nts = 0; const unsigned long long rt_entry = STAMP ? (unsigned long long)wall_clock64() : 0ull;
#define PG8_STAMP() do { if (STAMP && wid == 0 && nts < 64) { const unsigned long long _c = (unsigned long long)clock64(); \
        ts_lo = (lane == nts) ? (int)(unsigned)_c : ts_lo; ts_hi = (lane == nts) ? (int)(unsigned)(_c >> 32) : ts_hi; ++nts; } } while (0)
    PG8_STAMP();
    unsigned voffA[2], voffB[2];
#pragma unroll
    for (int i = 0; i < 2; ++i) { int R, C; stage_rc(tid * 16 + i * 8192, R, C); const int Rb = Epi::PERM ? ((R & ~31) + perm32(R & 31)) : R;
        voffA[i] = (unsigned)(R * K + C) * 2u; voffB[i] = (unsigned)(Rb * K + C) * 2u; }
    const size_t kstep = (size_t)(BK * 2);
    const size_t hstep = (size_t)HALF * K * 2;
    const size_t tstep = 2 * hstep;
    const unsigned ldsw = (unsigned)wid * 1024u;
    const int aoff = lds_byte(wr * 64 + fr, fq * 8), boff = lds_byte(wc * 32 + fr, fq * 8);
#define PG8_SA(b, h) (((b) * 2 + (h)) * HTB)
#define PG8_SB(b, h) ((4 + (b) * 2 + (h)) * HTB)
#define PG8_STAGE(bufoff, gbase, voff) do { _Pragma("unroll") for (int _i = 0; _i < 2; ++_i) \
        __builtin_amdgcn_global_load_lds((const unsigned*)((const char*)(gbase) + (voff)[_i]), (PG8_LAS unsigned*)(lds + (bufoff) + ldsw + _i * 8192), 16, 0, 0); } while (0)
#define PG8_LDA(dst, b, h) do { _Pragma("unroll") for (int m = 0; m < 4; ++m) _Pragma("unroll") for (int k = 0; k < 2; ++k) dst[m][k] = *(const PG8_LAS bf16x8*)(lds + PG8_SA(b, h) + aoff + m * 2048 + k * 1024); } while (0)
#define PG8_LDB(dst, b, h) do { _Pragma("unroll") for (int n = 0; n < 2; ++n) _Pragma("unroll") for (int k = 0; k < 2; ++k) dst[n][k] = *(const PG8_LAS bf16x8*)(lds + PG8_SB(b, h) + boff + n * 2048 + k * 1024); } while (0)
#define PG8_MMA(ai, bj, At, Bt) do { __builtin_amdgcn_s_setprio(1); _Pragma("unroll") for (int m = 0; m < 4; ++m) _Pragma("unroll") for (int n = 0; n < 2; ++n) _Pragma("unroll") for (int k = 0; k < 2; ++k) \
        acc[ai][bj][m][n] = __builtin_amdgcn_mfma_f32_16x16x32_bf16(Bt[n][k], At[m][k], acc[ai][bj][m][n], 0, 0, 0); __builtin_amdgcn_s_setprio(0); } while (0)
#define PG8_WAIT_V(n) asm volatile("s_waitcnt vmcnt(" #n ")" ::: "memory")
#define PG8_WAIT_L(n) asm volatile("s_waitcnt lgkmcnt(" #n ")" ::: "memory")
#define PG8_BAR __builtin_amdgcn_s_barrier()
#define PG8_SCHED __builtin_amdgcn_sched_barrier(0)
    Unit cur, nxt; int ui = 0;
    if (!S.next(0, cur)) return;
    f32x4 acc[2][2][4][2];
#pragma unroll
    for (int a = 0; a < 2; ++a)
#pragma unroll
        for (int b = 0; b < 2; ++b)
#pragma unroll
            for (int m = 0; m < 4; ++m)
#pragma unroll
                for (int n = 0; n < 2; ++n) acc[a][b][m][n] = (f32x4){0.f, 0.f, 0.f, 0.f};
    bf16x8 At[4][2], B0[2][2], B1[2][2];
    const char* cA = (const char*)g.A + (size_t)cur.pm * tstep; const char* cB = (const char*)g.Bt + (size_t)cur.pn * tstep;
    S.a_ready(cur);
    PG8_STAGE(PG8_SB(0, 0), cB, voffB); PG8_STAGE(PG8_SA(0, 0), cA, voffA); PG8_STAGE(PG8_SB(0, 1), cB + hstep, voffB); PG8_STAGE(PG8_SA(0, 1), cA + hstep, voffA);
    if (wr == 1) PG8_BAR;
    PG8_WAIT_V(4); PG8_BAR;
    PG8_STAGE(PG8_SB(1, 0), cB + kstep, voffB); PG8_STAGE(PG8_SA(1, 0), cA + kstep, voffA); PG8_STAGE(PG8_SB(1, 1), cB + hstep + kstep, voffB);
    PG8_WAIT_V(6); PG8_BAR;
    PG8_STAMP();
    for (;;) {
        const bool has_next = S.next(ui + 1, nxt);
        const char* nA = has_next ? (const char*)g.A + (size_t)nxt.pm * tstep : cA; const char* nB = has_next ? (const char*)g.Bt + (size_t)nxt.pn * tstep : cB;
        for (int t = 0; t < nt; t += 2) {
            const bool last = (t == nt - 2);
            const char* a1 = cA + (size_t)(t + 1) * kstep;
            const char* a2 = last ? nA : cA + (size_t)(t + 2) * kstep; const char* b2 = last ? nB : cB + (size_t)(t + 2) * kstep;
            const char* a3 = a2 + kstep; const char* b3 = b2 + kstep;
            if (last && has_next) S.a_ready(nxt);
            PG8_LDB(B0, 0, 0); PG8_SCHED; PG8_LDA(At, 0, 0); PG8_STAGE(PG8_SA(1, 1), a1 + hstep, voffA);
            PG8_WAIT_L(8); PG8_BAR; PG8_WAIT_L(0); PG8_MMA(0, 0, At, B0); PG8_BAR; PG8_SCHED;
            PG8_LDB(B1, 0, 1); PG8_STAGE(PG8_SB(0, 0), b2, voffB);
            PG8_BAR; PG8_WAIT_L(0); PG8_MMA(0, 1, At, B1); PG8_BAR;
            PG8_LDA(At, 0, 1); PG8_STAGE(PG8_SA(0, 0), a2, voffA);
            PG8_BAR; PG8_WAIT_L(0); PG8_MMA(1, 0, At, B0); PG8_BAR; PG8_SCHED;
            PG8_STAGE(PG8_SB(0, 1), b2 + hstep, voffB);
            PG8_WAIT_V(6); PG8_BAR; PG8_MMA(1, 1, At, B1); PG8_BAR;
            PG8_LDB(B0, 1, 0); PG8_SCHED; PG8_LDA(At, 1, 0); PG8_STAGE(PG8_SA(0, 1), a2 + hstep, voffA);
            PG8_WAIT_L(8); PG8_BAR; PG8_WAIT_L(0); PG8_MMA(0, 0, At, B0); PG8_BAR; PG8_SCHED;
            PG8_LDB(B1, 1, 1); PG8_STAGE(PG8_SB(1, 0), b3, voffB);
            PG8_BAR; PG8_WAIT_L(0); PG8_MMA(0, 1, At, B1); PG8_BAR;
            PG8_LDA(At, 1, 1); PG8_STAGE(PG8_SA(1, 0), a3, voffA);
            PG8_BAR; PG8_WAIT_L(0); PG8_MMA(1, 0, At, B0); PG8_BAR; PG8_SCHED;
            PG8_STAGE(PG8_SB(1, 1), b3 + hstep, voffB);
            PG8_WAIT_V(6); PG8_BAR; PG8_MMA(1, 1, At, B1); PG8_BAR;
        }
        PG8_STAMP();
        if constexpr (!Epi::AFTER_DRAIN) { E(acc, cur, wr, wc, fr, fq); S.done(cur); }
        PG8_STAMP();
        if (!has_next) break;
#pragma unroll
        for (int a = 0; a < 2; ++a)
#pragma unroll
            for (int b = 0; b < 2; ++b)
#pragma unroll
                for (int m = 0; m < 4; ++m)
#pragma unroll
                    for (int n = 0; n < 2; ++n) acc[a][b][m][n] = (f32x4){0.f, 0.f, 0.f, 0.f};
        cur = nxt; cA = nA; cB = nB; ++ui;
    }
    PG8_WAIT_V(0);
    if (wr == 0) PG8_BAR;
    PG8_BAR;
    if constexpr (Epi::AFTER_DRAIN) { E.fused(acc, cur, wr, wc, fr, fq, lds, wid, lane); S.done(cur); }
    PG8_STAMP();
    if (STAMP && wid == 0) { stamps[lane] = lane < nts ? (((unsigned long long)(unsigned)ts_hi << 32) | (unsigned)ts_lo) : 0ull;
        if (lane == 62) stamps[62] = rt_entry; if (lane == 63) stamps[63] = (unsigned long long)wall_clock64(); }
#undef PG8_STAMP
#undef PG8_SA
#undef PG8_SB
#undef PG8_STAGE
#undef PG8_LDA
#undef PG8_LDB
#undef PG8_MMA
#undef PG8_WAIT_V
#undef PG8_WAIT_L
#undef PG8_BAR
#undef PG8_SCHED
}
}

typedef unsigned short bf16_t;
typedef short bf16x8 __attribute__((ext_vector_type(8)));
typedef float f32x4 __attribute__((ext_vector_type(4)));
typedef unsigned u32x4 __attribute__((ext_vector_type(4)));
typedef unsigned u32x2 __attribute__((ext_vector_type(2)));
constexpr int NB = 12, SL = 8192, T = NB * SL, DM = 1024, NC = 3072, NPROMPT = 8 * SL;
constexpr int DH = 384, DC = 256, DR = 384;
constexpr int C_X0 = 512, C_X1 = 896, C_V = 1280, C_RG = 1664, C_GATE = 2048;
__host__ __device__ __forceinline__ int origcol(int n) {
    if (n < 128) return 1152 + n; if (n < 256) return 1408 + (n - 128); if (n < 384) return 1280 + (n - 256); if (n < 512) return 1536 + (n - 384);
    if (n < 896) return n - 512; if (n < 1280) return 384 + (n - 896); if (n < 1664) return 768 + (n - 1280); return n; }
constexpr int NFFT = 16384;
constexpr int LDS_BYTES = (NFFT + NFFT / 16) * 8;
constexpr float EPS = 1e-6f;
constexpr int NCHUNK = 16, CHUNK = 512;
constexpr int XCD_BAR_WORDS_C = 3456;

constexpr size_t WS_P = 0;
constexpr size_t WS_HY = WS_P + (size_t)T * NC * 2;
constexpr size_t WS_U = WS_HY + (size_t)T * DM * 2;
constexpr size_t WS_KF = WS_U + (size_t)NB * DH * SL * 2;
constexpr size_t WS_WINT = WS_KF + (size_t)DH * NFFT * 8;
constexpr size_t WS_WOUTT = WS_WINT + (size_t)2 * NC * DM * 2;
constexpr size_t WS_PWT = WS_WOUTT + (size_t)2 * DM * DM * 2;
constexpr size_t WS_RGWT = WS_PWT + (size_t)2 * DC * DC * 2;
constexpr size_t WS_AGG = WS_RGWT + (size_t)2 * 2 * 2 * 6 * 64 * 64 * 2;
constexpr size_t WS_BAR = WS_AGG + (size_t)NB * NCHUNK * 2 * 2 * DR * 4;
constexpr int RK_BASE = XCD_BAR_WORDS_C;
constexpr size_t CTL_BYTES = (size_t)(XCD_BAR_WORDS_C + 16 * 64) * 4;
constexpr size_t WS_GRAN = WS_BAR + CTL_BYTES;
constexpr size_t GRAN_BYTES = (size_t)2 * 64 * 144 * 64 * 8;
constexpr size_t WS_SS = WS_GRAN + GRAN_BYTES;
constexpr size_t WS_END = WS_SS + (size_t)3 * T * 4;

struct Params {
    const float* in[31];
    float* out;
    unsigned char* ws;
    int ph_lo, ph_hi;
};
enum { I_XP = 0, I_XS, I_NORMG, I_WIN, I_HCW, I_HCB, I_HW1, I_HB1, I_HW2, I_HB2, I_HW3, I_HB3, I_HW4, I_HFREQ, I_HD, I_CDW, I_CDB, I_CLG, I_CLB, I_CPW, I_CPB,
       I_RCW, I_RCB, I_RWA, I_RBA, I_RWX, I_RBX, I_RLAM, I_GRPG, I_WOUT, I_FING };

__device__ __forceinline__ float bf2f(bf16_t b) { return __uint_as_float(((unsigned)b) << 16); }
__device__ __forceinline__ unsigned pk2(float lo, float hi) { unsigned r; asm("v_cvt_pk_bf16_f32 %0, %1, %2" : "=v"(r) : "v"(lo), "v"(hi)); return r; }
__device__ __forceinline__ bf16_t f2bf(float f) { return (bf16_t)(pk2(f, f) & 0xffffu); }
__device__ __forceinline__ float wave_sum(float v) {
#pragma unroll
    for (int o = 32; o >= 1; o >>= 1) v += __shfl_xor(v, o);
    return v;
}
template <int N>
__device__ __forceinline__ void wave_sum_n(float (&v)[N]) {
#pragma unroll
    for (int o = 32; o >= 1; o >>= 1) {
#pragma unroll
        for (int i = 0; i < N; ++i) v[i] += __shfl_xor(v[i], o); }
}
__device__ __forceinline__ void lds_barrier() { asm volatile("s_waitcnt lgkmcnt(0)" ::: "memory"); __builtin_amdgcn_s_barrier(); asm volatile("" ::: "memory"); }
__device__ __forceinline__ int launder_tid() { int t = threadIdx.x; asm volatile("" : "+v"(t)); return t; }
__device__ __forceinline__ float sigmoidf_(float x) { return __builtin_amdgcn_rcpf(1.0f + __builtin_amdgcn_exp2f(-1.4426950408889634f * x)); }
__device__ __forceinline__ float siluf_(float x) { return x * sigmoidf_(x); }
struct __attribute__((packed, aligned(4))) U3 { unsigned x, y, z; };

__device__ __forceinline__ void transpose_tile(const float* src, int src_ld, bf16_t* dst, int dst_ld, int k0, int n0, float* tile  , const float* kscale = nullptr, int n0src = -1) {
    if (n0src < 0) n0src = n0;
    const int tid = threadIdx.x, lo = tid & 63, hi = tid >> 6;
#pragma unroll
    for (int i = 0; i < 8; ++i) { const int kk = i * 8 + hi; tile[kk * 65 + lo] = src[(size_t)(k0 + kk) * src_ld + n0src + lo] * (kscale ? kscale[k0 + kk] : 1.0f); }
    __syncthreads();
#pragma unroll
    for (int i = 0; i < 8; ++i) { const int nn = i * 8 + hi; dst[(size_t)(n0 + nn) * dst_ld + k0 + lo] = f2bf(tile[lo * 65 + nn]); }
    __syncthreads();
}
__device__ __forceinline__ void phase_prep_weights(const Params& p, unsigned char* lds) {
    float* tile = (float*)lds;
    { u32x4* g = (u32x4*)(p.ws + WS_GRAN); const u32x4 z = {0u, 0u, 0u, 0u};
      for (size_t i = (size_t)blockIdx.x * 512 + threadIdx.x; i < GRAN_BYTES / 16; i += (size_t)gridDim.x * 512) g[i] = z; }
    constexpr int N_WIN = 16 * 48, N_WOUT = 16 * 16, N_PW = 16, N_RG = 24;
    constexpr int PER_LAYER = N_WIN + N_WOUT + N_PW + 2 * N_RG;
    for (int it = blockIdx.x; it < 2 * PER_LAYER; it += gridDim.x) {
        const int l = it / PER_LAYER; int r = it % PER_LAYER;
        if (r < N_WIN) { transpose_tile(p.in[I_WIN] + (size_t)l * DM * NC, NC, (bf16_t*)(p.ws + WS_WINT) + (size_t)l * NC * DM, DM, (r / 48) * 64, (r % 48) * 64, tile, p.in[I_NORMG] + l * DM, origcol((r % 48) * 64)); continue; }
        r -= N_WIN;
        if (r < N_WOUT) { transpose_tile(p.in[I_WOUT] + (size_t)l * DM * DM, DM, (bf16_t*)(p.ws + WS_WOUTT) + (size_t)l * DM * DM, DM, (r / 16) * 64, (r % 16) * 64, tile); continue; }
        r -= N_WOUT;
        if (r < N_PW) { transpose_tile(p.in[I_CPW] + (size_t)l * DC * DC, DC, (bf16_t*)(p.ws + WS_PWT) + (size_t)l * DC * DC, DC, (r / 4) * 64, (r % 4) * 64, tile); continue; }
        r -= N_PW;
        const int gate = r / N_RG, dh = r % N_RG, dir = dh / 6, h = dh % 6;
        const float* src = p.in[gate ? I_RWX : I_RWA] + ((size_t)(l * 2 + dir) * 6 + h) * 4096;
        bf16_t* dst = (bf16_t*)(p.ws + WS_RGWT) + ((size_t)((l * 2 + dir) * 2 + gate) * 6 + h) * 4096;
        transpose_tile(src, 64, dst, 64, 0, 0, tile);
    }
}

__device__ __forceinline__ void phase_x0_prep(const float* xa, const float* xb, bf16_t* H, float* ss) {
    const int lane = threadIdx.x & 63, wave = threadIdx.x >> 6;
    for (int i = blockIdx.x * 512 + threadIdx.x; i < 2 * T; i += gridDim.x * 512) ss[T + i] = 0.f;
    const int NW = gridDim.x * 8;
    for (int row0 = blockIdx.x * 8 + wave; row0 < T; row0 += 4 * NW) {
        f32x4 v[4][4];
#pragma unroll
        for (int r = 0; r < 4; ++r) { const int row = row0 + r * NW;
            if (row < T) { const float* xr = (row < NPROMPT) ? xa + (size_t)row * DM : xb + (size_t)(row - NPROMPT) * DM;
#pragma unroll
                for (int j = 0; j < 4; ++j) v[r][j] = *(const f32x4*)(xr + lane * 4 + 256 * j); } }
#pragma unroll
        for (int r = 0; r < 4; ++r) { const int row = row0 + r * NW;
            if (row < T) { float s2 = 0.f;
#pragma unroll
                for (int j = 0; j < 4; ++j) { s2 += v[r][j].x * v[r][j].x + v[r][j].y * v[r][j].y + v[r][j].z * v[r][j].z + v[r][j].w * v[r][j].w;
                    u32x2 w; w.x = pk2(v[r][j].x, v[r][j].y); w.y = pk2(v[r][j].z, v[r][j].w); *(u32x2*)(H + (size_t)row * DM + lane * 4 + 256 * j) = w; }
                s2 = wave_sum(s2); if (lane == 0) ss[row] = s2; } }
    }
}
__device__ __forceinline__ void phase_final_norm(const bf16_t* x2, const float* ss, const float* g, float* out) {
    const int lane = threadIdx.x & 63, wave = threadIdx.x >> 6;
    f32x4 gv[4];
#pragma unroll
    for (int j = 0; j < 4; ++j) gv[j] = *(const f32x4*)(g + lane * 4 + 256 * j);
    const int NW = gridDim.x * 8;
    for (int row0 = blockIdx.x * 8 + wave; row0 < T; row0 += 4 * NW) {
        u32x2 v[4][4]; float rs[4];
#pragma unroll
        for (int r = 0; r < 4; ++r) { const int row = row0 + r * NW; rs[r] = 0.f;
            if (row < T) { rs[r] = rsqrtf(ss[row] * (1.0f / DM) + EPS);
#pragma unroll
                for (int j = 0; j < 4; ++j) v[r][j] = *(const u32x2*)(x2 + (size_t)row * DM + lane * 4 + 256 * j); } }
#pragma unroll
        for (int r = 0; r < 4; ++r) { const int row = row0 + r * NW;
            if (row < T) {
#pragma unroll
                for (int j = 0; j < 4; ++j) { f32x4 x; x.x = __uint_as_float(v[r][j].x << 16); x.y = __uint_as_float(v[r][j].x & 0xffff0000u); x.z = __uint_as_float(v[r][j].y << 16); x.w = __uint_as_float(v[r][j].y & 0xffff0000u);
                    *(f32x4*)(out + (size_t)row * DM + lane * 4 + 256 * j) = x * rs[r] * gv[j]; } } }
    }
}

__device__ __forceinline__ void phase_filters(const Params& p, int l, unsigned char* lds) {
    float* Z = (float*)lds;
    float* H1 = Z + 32 * 33;
    float* H2 = H1 + 32 * 65;
    float* OT = H2 + 32 * 65;
    const float* w1 = p.in[I_HW1] + (size_t)l * 33 * 64; const float* b1 = p.in[I_HB1] + l * 64;
    const float* w2 = p.in[I_HW2] + (size_t)l * 64 * 64; const float* b2 = p.in[I_HB2] + l * 64;
    const float* w3 = p.in[I_HW3] + (size_t)l * 64 * 64; const float* b3 = p.in[I_HB3] + l * 64;
    const float* w4 = p.in[I_HW4] + (size_t)l * 64 * 768; const float* fr = p.in[I_HFREQ] + l * 64;
    float2* KF = (float2*)(p.ws + WS_KF);
    for (int it = blockIdx.x; it < SL / 32; it += gridDim.x) {
        const int t0 = it * 32; const int tid = launder_tid();
        for (int idx = tid; idx < 32 * 33; idx += 512) {
            const int tl = idx / 33, f = idx % 33; const float t = (float)(t0 + tl);
            float z;
            if (f == 0) z = t / (float)(SL - 1);
            else { const int j = (f - 1) & 15; const float fj = 1e-4f + (float)j * ((15.0f - 1e-4f) / 15.0f); const float ang = 2.0f * fj * t * (1.0f / SL);
                   z = (f <= 16) ? cospif(ang) : -sinpif(ang); }
            Z[tl * 33 + f] = z;
        }
        __syncthreads();
        { const int o = tid & 63; const float frq = fr[o], bb = b1[o];
#pragma unroll
          for (int i = 0; i < 4; ++i) { const int tl = (tid >> 6) + 8 * i; float a = bb;
_Pragma("unroll 3") for (int f = 0; f < 33; ++f) a += Z[tl * 33 + f] * w1[f * 64 + o]; H1[tl * 65 + o] = sinf(frq * a); } }
        __syncthreads();
        { const int o = tid & 63; const float frq = fr[o], bb = b2[o];
#pragma unroll
          for (int i = 0; i < 4; ++i) { const int tl = (tid >> 6) + 8 * i; float a = bb;
_Pragma("unroll 4") for (int f = 0; f < 64; ++f) a += H1[tl * 65 + f] * w2[f * 64 + o]; H2[tl * 65 + o] = sinf(frq * a); } }
        __syncthreads();
        { const int o = tid & 63; const float frq = fr[o], bb = b3[o];
#pragma unroll
          for (int i = 0; i < 4; ++i) { const int tl = (tid >> 6) + 8 * i; float a = bb;
_Pragma("unroll 4") for (int f = 0; f < 64; ++f) a += H2[tl * 65 + f] * w3[f * 64 + o]; H1[tl * 65 + o] = sinf(frq * a); } }
        __syncthreads();
#pragma unroll 1
        for (int cr = tid; cr < 2 * 768; cr += 512) {
            const int c = cr % 768, rnd = cr / 768;
            float acc[16];
#pragma unroll
            for (int tl = 0; tl < 16; ++tl) acc[tl] = 0.f;
#pragma unroll 2
            for (int k = 0; k < 64; ++k) { const float w = w4[k * 768 + c];
#pragma unroll
                for (int tl = 0; tl < 16; ++tl) acc[tl] += H1[(rnd * 16 + tl) * 65 + k] * w; }
#pragma unroll
            for (int tl = 0; tl < 16; ++tl) OT[c * 33 + rnd * 16 + tl] = acc[tl];
        }
        __syncthreads();
        for (int idx = tid; idx < 768 * 32; idx += 512) {
            const int c768 = idx >> 5, tl = idx & 31, t = t0 + tl, c = c768 % DH;
            const float minD = -3.0701134573253944f, maxD = -15.350567286626972f;
            const float delta = fabsf(minD + (maxD - minD) * ((float)c / (float)(DH - 1)));
            const float val = OT[c768 * 33 + tl] * __expf(-((float)t / (float)(SL - 1)) * delta) * (1.0f / NFFT);
            if (c768 < DH) KF[(size_t)c * NFFT + t] = make_float2(val, 0.f);
            else if (t > 0) KF[(size_t)c * NFFT + (NFFT - t)] = make_float2(val, 0.f);
            else KF[(size_t)c * NFFT + SL] = make_float2(0.f, 0.f);
        }
        __syncthreads();
    }
}

__device__ __forceinline__ int PH(int i) { return i + (i >> 4); }
__device__ __forceinline__ float2 opq(float2 v) { asm("" : "+v"(v.x), "+v"(v.y)); return v; }
__device__ __forceinline__ float2 cmul(float2 a, float2 b) { return make_float2(a.x * b.x - a.y * b.y, a.x * b.y + a.y * b.x); }
__device__ __forceinline__ float2 tw16(int m, bool inv) {
    const float cs[8] = {1.0f, 0.92387953251128674f, 0.70710678118654752f, 0.38268343236508977f, 0.0f, -0.38268343236508977f, -0.70710678118654752f, -0.92387953251128674f};
    const float sn[8] = {0.0f, 0.38268343236508977f, 0.70710678118654752f, 0.92387953251128674f, 1.0f, 0.92387953251128674f, 0.70710678118654752f, 0.38268343236508977f};
    return make_float2(cs[m], inv ? sn[m] : -sn[m]);
}
template <int LR, bool INV, bool ZEROJ>
__device__ __forceinline__ void bfly(float2 (&x)[1 << LR], float ang0) {
    constexpr int R = 1 << LR;
    float2 w[LR];
    if (!ZEROJ) {
        const float s0 = __builtin_amdgcn_sinf(ang0), c0 = __builtin_amdgcn_cosf(ang0);
        w[0] = make_float2(c0, INV ? s0 : -s0);
#pragma unroll
        for (int t = 1; t < LR; ++t) w[t] = cmul(w[t - 1], w[t - 1]);
    }
#pragma unroll
    for (int tt = 0; tt < LR; ++tt) {
        const int t = INV ? (LR - 1 - tt) : tt;
        const int half = R >> (t + 1);
#pragma unroll
        for (int q = 0; q < R; ++q) {
            if (q & half) continue;
            const int ql = q & (half - 1);
            const int m = (ql << t) * (16 / R);
            float2 tw;
            if (ZEROJ) tw = tw16(m, INV);
            else if (m == 0) tw = w[t];
            else tw = cmul(w[t], tw16(m, INV));
            const bool triv = ZEROJ && (m == 0);
            if (!INV) {
                const float2 a = x[q], b = x[q + half];
                x[q] = make_float2(a.x + b.x, a.y + b.y);
                const float2 d = make_float2(a.x - b.x, a.y - b.y);
                x[q + half] = triv ? d : cmul(d, tw);
            } else {
                const float2 a = x[q]; const float2 b = triv ? x[q + half] : cmul(x[q + half], tw);
                x[q] = make_float2(a.x + b.x, a.y + b.y);
                x[q + half] = make_float2(a.x - b.x, a.y - b.y);
            }
        }
    }
}
template <int LR, bool INV>
__device__ __forceinline__ void fft_pass(float2* X, int Blog) {
    constexpr int R = 1 << LR;
    const int Slog = Blog - LR;
    const int tid0 = launder_tid();
#pragma unroll 1
    for (int id = tid0; id < (NFFT >> LR); id += 512) {
        const int blk = id >> Slog, j = id & ((1 << Slog) - 1);
        const int base = (blk << Blog) + j;
        float2 x[R];
#pragma unroll
        for (int q = 0; q < R; ++q) x[q] = X[PH(base + (q << Slog))];
        bfly<LR, INV, false>(x, (float)j * (1.0f / (float)(1 << Blog)));
#pragma unroll
        for (int q = 0; q < R; ++q) X[PH(base + (q << Slog))] = opq(x[q]);
    }
    lds_barrier();
}
template <bool CONV>
__device__ __forceinline__ void fft_mid(float2* X, const float2* kf, float2* gout, bool do_store) {
    const int tid0 = launder_tid();
#pragma unroll 1
    for (int id = tid0; id < (NFFT >> 4); id += 512) {
        float2 x[16];
#pragma unroll
        for (int q = 0; q < 16; ++q) x[q] = X[17 * id + q];
        bfly<4, false, true>(x, 0.f);
        if (CONV) {
#pragma unroll
            for (int q = 0; q < 16; ++q) { const float2 k1 = kf[q * 1024 + id]; x[q] = cmul(x[q], k1); }
            bfly<4, true, true>(x, 0.f);
#pragma unroll
            for (int q = 0; q < 16; ++q) X[17 * id + q] = opq(x[q]);
        } else if (do_store) {
#pragma unroll
            for (int q = 0; q < 16; ++q) gout[q * 1024 + id] = opq(x[q]);
        }
    }
    lds_barrier();
}
__device__ __forceinline__ void phase_kf_fft(const Params& p, unsigned char* lds, bool do_store = true) {
    float2* X = (float2*)lds; float2* KF = (float2*)(p.ws + WS_KF);
    for (int c = blockIdx.x; c < DH; c += gridDim.x) {
        float2* kc = KF + (size_t)c * NFFT;
        const int tid0 = launder_tid();
#pragma unroll 1
        for (int id = tid0; id < 4096; id += 512) {
            float2 x[4];
#pragma unroll
            for (int q = 0; q < 4; ++q) x[q] = kc[id + q * 4096];
            bfly<2, false, false>(x, (float)id * (1.0f / 16384.0f));
#pragma unroll
            for (int q = 0; q < 4; ++q) X[PH(id + q * 4096)] = opq(x[q]);
        }
        lds_barrier();
        fft_pass<4, false>(X, 12); fft_pass<4, false>(X, 8); fft_mid<false>(X, nullptr, kc, do_store);
    }
}
__device__ __forceinline__ void phase_fftconv(const Params& p, int l, unsigned char* lds, bool do_store = true) {
    float2* X = (float2*)lds; const float2* KF = (const float2*)(p.ws + WS_KF); bf16_t* U = (bf16_t*)(p.ws + WS_U);
    const float* dsk = p.in[I_HD] + l * DH;
    for (int it = blockIdx.x; it < DH * (NB / 2); it += gridDim.x) {
        const int xq = it & 7, xr = it >> 3, c = xq * (DH / 8) + xr / (NB / 2), pr = xr % (NB / 2);
        unsigned* u1 = (unsigned*)(U + ((size_t)(2 * pr) * DH + c) * SL); unsigned* u2 = (unsigned*)(U + ((size_t)(2 * pr + 1) * DH + c) * SL);
        const int tid0 = launder_tid();
#pragma unroll 1
        for (int i = 0; i < 4; ++i) { const int k = tid0 + 512 * i;
            const unsigned a0 = u1[k], a1 = u1[k + 2048], b0 = u2[k], b1 = u2[k + 2048];
#pragma unroll
            for (int e = 0; e < 2; ++e) { const int id = 2 * k + e;
                float2 x[4];
                x[0] = make_float2(e ? __uint_as_float(a0 & 0xffff0000u) : __uint_as_float(a0 << 16), e ? __uint_as_float(b0 & 0xffff0000u) : __uint_as_float(b0 << 16));
                x[1] = make_float2(e ? __uint_as_float(a1 & 0xffff0000u) : __uint_as_float(a1 << 16), e ? __uint_as_float(b1 & 0xffff0000u) : __uint_as_float(b1 << 16));
                x[2] = make_float2(0.f, 0.f); x[3] = make_float2(0.f, 0.f);
                bfly<2, false, false>(x, (float)id * (1.0f / 16384.0f));
#pragma unroll
                for (int q = 0; q < 4; ++q) X[PH(id + q * 4096)] = opq(x[q]); } }
        lds_barrier();
        fft_pass<4, false>(X, 12); fft_pass<4, false>(X, 8);
        fft_mid<true>(X, KF + (size_t)c * NFFT, nullptr, false);
        fft_pass<4, true>(X, 8); fft_pass<4, true>(X, 12);
        const float d = dsk[c];
#pragma unroll 1
        for (int i = 0; i < 4; ++i) { const int k = tid0 + 512 * i;
            const unsigned a0 = u1[k], a1 = u1[k + 2048], b0 = u2[k], b1 = u2[k + 2048];
            float2 y0[2], y1[2];
#pragma unroll
            for (int e = 0; e < 2; ++e) { const int id = 2 * k + e;
                float2 x[4];
#pragma unroll
                for (int q = 0; q < 4; ++q) x[q] = X[PH(id + q * 4096)];
                bfly<2, true, false>(x, (float)id * (1.0f / 16384.0f));
                y0[e] = opq(x[0]); y1[e] = opq(x[1]); }
            if (do_store) {
                u1[k] = pk2(y0[0].x + d * __uint_as_float(a0 << 16), y0[1].x + d * __uint_as_float(a0 & 0xffff0000u));
                u1[k + 2048] = pk2(y1[0].x + d * __uint_as_float(a1 << 16), y1[1].x + d * __uint_as_float(a1 & 0xffff0000u));
                u2[k] = pk2(y0[0].y + d * __uint_as_float(b0 << 16), y0[1].y + d * __uint_as_float(b0 & 0xffff0000u));
                u2[k + 2048] = pk2(y1[0].y + d * __uint_as_float(b1 << 16), y1[1].y + d * __uint_as_float(b1 & 0xffff0000u)); } }
        lds_barrier();
    }
}

__device__ __forceinline__ void phase_hyena_prep(const Params& p, int l, unsigned char* lds) {
    bf16_t* RAW = (bf16_t*)lds;
    float* tile = (float*)(lds + 2 * 130 * 64 * 2);
    const bf16_t* P = (const bf16_t*)(p.ws + WS_P); bf16_t* U = (bf16_t*)(p.ws + WS_U);
    const float* cw = p.in[I_HCW] + (size_t)l * 3 * 1152; const float* cb = p.in[I_HCB] + l * 1152;
    u32x4 pf[5];
#define HP_PREFETCH(IT) do { const int _cg = (IT) % 6, _tt = ((IT) / 6) % 64, _b = (IT) / 384, _t0 = _tt * 128; const bf16_t* _pb = P + (size_t)_b * SL * NC; const int _tid = threadIdx.x; \
        _Pragma("unroll") for (int k = 0; k < 5; ++k) { const int idx = _tid + 512 * k, arr = idx / 1040, rem = idx % 1040, r = rem >> 3, sg = rem & 7, t = _t0 - 1 + r; pf[k] = (u32x4){0u, 0u, 0u, 0u}; \
            if (idx < 2080 && t >= 0 && t < SL) pf[k] = *(const u32x4*)(_pb + (size_t)t * NC + (arr ? C_V : C_X1) + _cg * 64 + sg * 8); } } while (0)
    if ((int)blockIdx.x < NB * 64 * 6) { HP_PREFETCH((int)blockIdx.x);
#pragma unroll
        for (int k = 0; k < 5; ++k) { const int idx = (int)threadIdx.x + 512 * k;
            if (idx < 2080) { const int arr = idx / 1040, rem = idx % 1040, r = rem >> 3, sg = rem & 7; *(u32x4*)(RAW + (arr * 130 + r) * 64 + sg * 8) = pf[k]; } } }
    lds_barrier();
    for (int it = blockIdx.x; it < NB * 64 * 6; it += gridDim.x) {
        const int tid = launder_tid(), cc = tid & 63, tq = tid >> 6;
        const int cgp = it % 6, tt = (it / 6) % 64, b = it / 384;
        const int c = cgp * 64 + cc, t0 = tt * 128;
        const float wx0 = cw[384 + c], wx1 = cw[1152 + 384 + c], wx2 = cw[2304 + 384 + c], bx = cb[384 + c];
        const float wv0 = cw[768 + c], wv1 = cw[1152 + 768 + c], wv2 = cw[2304 + 768 + c], bv = cb[768 + c];
        const bool has_next = it + (int)gridDim.x < NB * 64 * 6;
        if (has_next) HP_PREFETCH(it + (int)gridDim.x);
        { const bf16_t* rx = RAW + (tq * 16) * 64 + cc; const bf16_t* rv = rx + 130 * 64;
          float xm = bf2f(rx[0]), x0 = bf2f(rx[64]), vm = bf2f(rv[0]), v0 = bf2f(rv[64]);
#pragma unroll
          for (int i = 0; i < 16; ++i) {
              const float xp = bf2f(rx[(i + 2) * 64]), vp = bf2f(rv[(i + 2) * 64]);
              const float cx = wx0 * xm + wx1 * x0 + wx2 * xp + bx, cv = wv0 * vm + wv1 * v0 + wv2 * vp + bv;
              tile[cc * 129 + tq * 16 + i] = cx * cv;
              xm = x0; x0 = xp; vm = v0; v0 = vp; } }
        lds_barrier();
#pragma unroll
        for (int i = 0; i < 8; ++i) { const int idx = tid + 512 * i, c2 = idx >> 6, tl = (idx & 63) * 2;
            *(unsigned*)(U + ((size_t)b * DH + cgp * 64 + c2) * SL + t0 + tl) = pk2(tile[c2 * 129 + tl], tile[c2 * 129 + tl + 1]); }
        if (has_next) {
#pragma unroll
            for (int k = 0; k < 5; ++k) { const int idx = tid + 512 * k;
                if (idx < 2080) { const int arr = idx / 1040, rem = idx % 1040, r = rem >> 3, sg = rem & 7; *(u32x4*)(RAW + (arr * 130 + r) * 64 + sg * 8) = pf[k]; } } }
        lds_barrier();
    }
#undef HP_PREFETCH
}

__device__ __forceinline__ void phase_conformer(const Params& p, int l, unsigned char* lds) {
    bf16_t* G = (bf16_t*)lds;
    bf16_t* A = (bf16_t*)lds;
    float* CV = (float*)(lds + 49152);
    const bf16_t* P = (const bf16_t*)(p.ws + WS_P); bf16_t* Y = (bf16_t*)(p.ws + WS_HY);
    const bf16_t* PwT = (const bf16_t*)(p.ws + WS_PWT) + (size_t)l * DC * DC;
    const float* dww = p.in[I_CDW] + (size_t)l * 31 * DC; const float* dwb = p.in[I_CDB] + l * DC;
    const float* lng = p.in[I_CLG] + l * DC; const float* lnb = p.in[I_CLB] + l * DC; const float* pwb = p.in[I_CPB] + l * DC;
    const float* gg = p.in[I_GRPG] + l * DM + DH;
    float w[31];
#pragma unroll
    for (int k = 0; k < 31; ++k) w[k] = dww[k * DC + (threadIdx.x & 255)];
    const float bias = dwb[threadIdx.x & 255];
    u32x4 av[6];
#define CF_TILE(IT) ((((IT) & 7) * (NB * (SL / 64) / 8)) + ((IT) >> 3))
#define CF_PREFETCH(IT) do { const int _tile = CF_TILE(IT), _b = _tile / (SL / 64), _t0 = (_tile % (SL / 64)) * 64; const bf16_t* _pb = P + (size_t)_b * SL * NC; const int _tid = threadIdx.x; \
        _Pragma("unroll") for (int k = 0; k < 6; ++k) { const int idx = _tid + 512 * k, i = idx >> 5, c8 = (idx & 31) * 8, t = _t0 - 15 + i; \
            av[k] = (u32x4){0u, 0u, 0u, 0u}; \
            if (idx < 94 * 32 && t >= 0 && t < SL) av[k] = *(const u32x4*)(_pb + (size_t)t * NC + c8 + ((c8 >= 128) ? 128 : 0)); } } while (0)
    if ((int)blockIdx.x < NB * (SL / 64)) CF_PREFETCH((int)blockIdx.x);
    for (int it = blockIdx.x; it < NB * (SL / 64); it += gridDim.x) {
        const int tid = launder_tid(), lane = tid & 63, wave = tid >> 6, fr = lane & 15, fq = lane >> 4;
        const int tile = CF_TILE(it), b = tile / (SL / 64), t0 = (tile % (SL / 64)) * 64;
        const bf16_t* pb = P + (size_t)b * SL * NC;
#pragma unroll
        for (int k = 0; k < 6; ++k) { const int idx = tid + 512 * k, i = idx >> 5, c8 = (idx & 31) * 8;
            if (idx < 94 * 32) *(u32x4*)(G + i * 256 + c8) = av[k]; }
        lds_barrier();
        if (it + (int)gridDim.x < NB * (SL / 64)) CF_PREFETCH(it + (int)gridDim.x);
        { const int c = tid & 255, hf = tid >> 8;
#pragma unroll 1
          for (int rnd = 0; rnd < 2; ++rnd) {
              const int r0 = hf * 32 + rnd * 16;
              float acc[16];
#pragma unroll
              for (int o = 0; o < 16; ++o) acc[o] = bias;
#pragma unroll
              for (int r = 0; r < 46; ++r) { const float v = bf2f(G[(r0 + r) * 256 + c]);
#pragma unroll
                  for (int o = 0; o < 16; ++o) { if (r - o >= 0 && r - o < 31) acc[o] += w[r - o] * v; } }
#pragma unroll
              for (int o = 0; o < 16; ++o) CV[(r0 + o) * 256 + c] = acc[o];
          } }
        lds_barrier();
        { f32x4 v[8]; float s1[8], s2[8];
#pragma unroll
          for (int i = 0; i < 8; ++i) { v[i] = *(const f32x4*)(CV + (wave * 8 + i) * 256 + lane * 4); s1[i] = (v[i].x + v[i].y) + (v[i].z + v[i].w); }
          wave_sum_n<8>(s1);
#pragma unroll
          for (int i = 0; i < 8; ++i) { v[i] = v[i] - s1[i] * (1.0f / DC); s2[i] = (v[i].x * v[i].x + v[i].y * v[i].y) + (v[i].z * v[i].z + v[i].w * v[i].w); }
          wave_sum_n<8>(s2);
          const f32x4 gv = *(const f32x4*)(lng + lane * 4), bv = *(const f32x4*)(lnb + lane * 4);
#pragma unroll
          for (int i = 0; i < 8; ++i) { const float rstd = rsqrtf(s2[i] * (1.0f / DC) + EPS);
              const f32x4 y = v[i] * rstd * gv + bv;
              u32x2 w; w.x = pk2(siluf_(y.x), siluf_(y.y)); w.y = pk2(siluf_(y.z), siluf_(y.w));
              *(u32x2*)(A + (wave * 8 + i) * 264 + lane * 4) = w; } }
        lds_barrier();
        { f32x4 acc[4][2];
#pragma unroll
          for (int m = 0; m < 4; ++m) { acc[m][0] = (f32x4){0.f, 0.f, 0.f, 0.f}; acc[m][1] = (f32x4){0.f, 0.f, 0.f, 0.f}; }
          const int n0 = wave * 32;
#pragma unroll
          for (int ks = 0; ks < 8; ++ks) {
              bf16x8 bf[2], af[4];
#pragma unroll
              for (int n = 0; n < 2; ++n) bf[n] = *(const bf16x8*)(PwT + (size_t)(n0 + n * 16 + fr) * DC + ks * 32 + fq * 8);
#pragma unroll
              for (int m = 0; m < 4; ++m) af[m] = *(const bf16x8*)(A + (m * 16 + fr) * 264 + ks * 32 + fq * 8);
#pragma unroll
              for (int m = 0; m < 4; ++m)
#pragma unroll
                  for (int n = 0; n < 2; ++n) acc[m][n] = __builtin_amdgcn_mfma_f32_16x16x32_bf16(af[m], bf[n], acc[m][n], 0, 0, 0);
          }
#pragma unroll
          for (int n = 0; n < 2; ++n) { const int col = n0 + n * 16 + fr; const float bb = pwb[col];
#pragma unroll
              for (int m = 0; m < 4; ++m)
#pragma unroll
                  for (int j = 0; j < 4; ++j) CV[(m * 16 + fq * 4 + j) * 256 + col] = acc[m][n][j] + bb; } }
        lds_barrier();
        { f32x4 v[8]; float s2[8]; u32x2 gt[8];
#pragma unroll
          for (int i = 0; i < 8; ++i) { const int tl = wave * 8 + i; const size_t row = (size_t)b * SL + t0 + tl;
              gt[i] = *(const u32x2*)(P + row * NC + C_GATE + DH + lane * 4);
              v[i] = *(const f32x4*)(CV + tl * 256 + lane * 4); s2[i] = (v[i].x * v[i].x + v[i].y * v[i].y) + (v[i].z * v[i].z + v[i].w * v[i].w); }
          wave_sum_n<8>(s2);
          const f32x4 gv = *(const f32x4*)(gg + lane * 4);
#pragma unroll
          for (int i = 0; i < 8; ++i) { const int tl = wave * 8 + i; const size_t row = (size_t)b * SL + t0 + tl;
              const float rstd = rsqrtf(s2[i] * (1.0f / DC) + EPS);
              const float g0 = __uint_as_float(gt[i].x << 16), g1 = __uint_as_float(gt[i].x & 0xffff0000u), g2 = __uint_as_float(gt[i].y << 16), g3 = __uint_as_float(gt[i].y & 0xffff0000u);
              u32x2 w; w.x = pk2(v[i].x * rstd * gv.x * siluf_(g0), v[i].y * rstd * gv.y * siluf_(g1)); w.y = pk2(v[i].z * rstd * gv.z * siluf_(g2), v[i].w * rstd * gv.w * siluf_(g3));
              *(u32x2*)(Y + row * DM + DH + lane * 4) = w; } }
        lds_barrier();
    }
}

template <bool PASSB>
__device__ __forceinline__ void phase_rglru(const Params& p, int l, unsigned char* lds) {
    float* XRF = (float*)lds;
    bf16_t* XRB = (bf16_t*)(lds + 32768);
    float* AS = (float*)(lds + 32768 + 18432);
    float* BS = AS + 128 * 64;
    float* SEGA = BS + 128 * 64;
    float* SEGB = SEGA + 512;
    float* CARRY = SEGB + 512;
    bf16_t* RAWR = (bf16_t*)(CARRY + 64);
    bf16_t* P = (bf16_t*)(p.ws + WS_P); float* AGG = (float*)(p.ws + WS_AGG);
    const float* cw = p.in[I_RCW] + (size_t)l * 4 * DR; const float* cb = p.in[I_RCB] + l * DR;
    const int tid = threadIdx.x, lane = tid & 63, wave = tid >> 6, fr = lane & 15, fq = lane >> 4;
    const int cc = tid & 63, seg = tid >> 6;
    const int mh = wave >> 2, jq = wave & 3;
    for (int it = blockIdx.x; it < NB * 6 * NCHUNK * 2; it += gridDim.x) {
        const int dir = it & 1, ch = (it >> 1) % NCHUNK, h = ((it >> 1) / NCHUNK) % 6, b = (it >> 1) / (NCHUNK * 6);
        bf16_t* pb = P + (size_t)b * SL * NC;
        bf16x8 Ba[2], Bx[2];
        { const bf16_t* wa = (const bf16_t*)(p.ws + WS_RGWT) + ((size_t)((l * 2 + dir) * 2 + 0) * 6 + h) * 4096;
          const bf16_t* wx = (const bf16_t*)(p.ws + WS_RGWT) + ((size_t)((l * 2 + dir) * 2 + 1) * 6 + h) * 4096;
#pragma unroll
          for (int ks = 0; ks < 2; ++ks) { Ba[ks] = *(const bf16x8*)(wa + (jq * 16 + fr) * 64 + ks * 32 + fq * 8); Bx[ks] = *(const bf16x8*)(wx + (jq * 16 + fr) * 64 + ks * 32 + fq * 8); } }
        const int gch = h * 64 + jq * 16 + fr;
        const float bga = p.in[I_RBA][(l * 2 + dir) * DR + gch], bgx = p.in[I_RBX][(l * 2 + dir) * DR + gch];
        const float lam = p.in[I_RLAM][(l * 2 + dir) * DR + gch];
        const float sp8l2 = 8.0f * 1.4426950408889634f * log1pf(__expf(-lam));
        const int c = h * 64 + cc;
        const float w0 = cw[c], w1 = cw[DR + c], w2 = cw[2 * DR + c], w3 = cw[3 * DR + c], cbias = cb[c];
        if (tid < 64) {
            float cin = 0.f;
            if (PASSB) {
                if (dir == 0) { for (int j = 0; j < ch; ++j) { const float* ag = AGG + ((size_t)((b * NCHUNK + j) * 2 + 0) * 2) * DR + c; cin = ag[0] * cin + ag[DR]; } }
                else { for (int j = NCHUNK - 1; j > ch; --j) { const float* ag = AGG + ((size_t)((b * NCHUNK + j) * 2 + 1) * 2) * DR + c; cin = ag[0] * cin + ag[DR]; } }
            }
            CARRY[tid] = cin;
        }
        float totA = 1.f;
        for (int s = 0; s < 4; ++s) {
            const int st = dir ? 3 - s : s, t0 = ch * CHUNK + st * 128;
#pragma unroll
            for (int k = 0; k < 3; ++k) { const int idx = tid + 512 * k;
                if (idx < 1048) { const int r = idx >> 3, sg = idx & 7, t = t0 - 2 + r;
                    u32x4 v = {0u, 0u, 0u, 0u};
                    if (t >= 0 && t < SL) v = *(const u32x4*)(pb + (size_t)t * NC + C_RG + h * 64 + sg * 8);
                    *(u32x4*)(RAWR + r * 64 + sg * 8) = v; } }
            __syncthreads();
            { const bf16_t* rr = RAWR + (seg * 16) * 64 + cc;
              float pm2 = bf2f(rr[0]), pm1 = bf2f(rr[64]), p0 = bf2f(rr[128]);
#pragma unroll
              for (int i = 0; i < 16; ++i) {
                  const float pp = bf2f(rr[(i + 3) * 64]);
                  const float xr = w0 * pm2 + w1 * pm1 + w2 * p0 + w3 * pp + cbias;
                  const int tl = seg * 16 + i, si = dir ? 127 - tl : tl;
                  XRF[si * 64 + cc] = xr; XRB[si * 72 + cc] = f2bf(xr);
                  pm2 = pm1; pm1 = p0; p0 = pp; } }
            __syncthreads();
#pragma unroll
            for (int m = 0; m < 4; ++m) {
                f32x4 ga = {0.f, 0.f, 0.f, 0.f}, gx = {0.f, 0.f, 0.f, 0.f};
#pragma unroll
                for (int ks = 0; ks < 2; ++ks) { const bf16x8 af = *(const bf16x8*)(XRB + (mh * 64 + m * 16 + fr) * 72 + ks * 32 + fq * 8);
                    ga = __builtin_amdgcn_mfma_f32_16x16x32_bf16(af, Ba[ks], ga, 0, 0, 0); gx = __builtin_amdgcn_mfma_f32_16x16x32_bf16(af, Bx[ks], gx, 0, 0, 0); }
#pragma unroll
                for (int j = 0; j < 4; ++j) { const int si = mh * 64 + m * 16 + fq * 4 + j, col = jq * 16 + fr;
                    const float r = sigmoidf_(ga[j] + bga), ig = sigmoidf_(gx[j] + bgx);
                    const float la2 = -sp8l2 * r; const float a = __builtin_amdgcn_exp2f(la2); const float mult = __builtin_amdgcn_sqrtf(fmaxf(1.0f - a * a, 0.f));
                    AS[si * 64 + col] = a; BS[si * 64 + col] = mult * ig * XRF[si * 64 + col]; }
            }
            __syncthreads();
            float hl[16], ca[16];
            { float hh = 0.f, cum = 1.f;
#pragma unroll
              for (int i = 0; i < 16; ++i) { const float a = AS[(seg * 16 + i) * 64 + cc], bb = BS[(seg * 16 + i) * 64 + cc]; hh = a * hh + bb; cum *= a; hl[i] = hh; ca[i] = cum; }
              SEGA[seg * 64 + cc] = cum; SEGB[seg * 64 + cc] = hh; }
            __syncthreads();
            float cin = CARRY[cc];
            for (int q = 0; q < seg; ++q) cin = SEGA[q * 64 + cc] * cin + SEGB[q * 64 + cc];
            if (PASSB) {
                bf16_t* dst = pb + (dir ? C_V : C_X1) + c;
#pragma unroll
                for (int i = 0; i < 16; ++i) { const int si = seg * 16 + i, tl = dir ? 127 - si : si; dst[(size_t)(t0 + tl) * NC] = f2bf(hl[i] + ca[i] * cin); }
            }
            float ncar = 0.f, prodA = 1.f;
            if (seg == 7) { ncar = hl[15] + ca[15] * cin;
#pragma unroll
                for (int q = 0; q < 8; ++q) prodA *= SEGA[q * 64 + cc]; }
            __syncthreads();
            if (seg == 7) { CARRY[cc] = ncar; totA *= prodA; }
        }
        __syncthreads();
        if (!PASSB && seg == 7) { float* ag = AGG + ((size_t)((b * NCHUNK + ch) * 2 + dir) * 2) * DR + c; ag[0] = totA; ag[DR] = CARRY[cc]; }
        __syncthreads();
    }
}

constexpr int NSUB = SL / 128, NSEQ = NB * 6 * 2;
__device__ __forceinline__ void phase_rglru_chain(const Params& p, int l, unsigned char* lds) {
    float* XRF = (float*)lds;
    bf16_t* XRB = (bf16_t*)(lds + 32768);
    float* AS = (float*)(lds + 32768 + 18432);
    float* BS = AS + 128 * 64;
    float* SEGA = BS + 128 * 64;
    float* SEGB = SEGA + 512;
    float* CARRY = SEGB + 512;
    bf16_t* RAWR = (bf16_t*)(CARRY + 64);
    bf16_t* P = (bf16_t*)(p.ws + WS_P);
    unsigned long long* GR = (unsigned long long*)(p.ws + WS_GRAN) + (size_t)l * NSUB * NSEQ * 64;
    const float* cw = p.in[I_RCW] + (size_t)l * 4 * DR; const float* cb = p.in[I_RCB] + l * DR;
    u32x4 pf[3];
#define RG_PREFETCH(IT) do { const int _sub = (IT) / NSEQ, _sq = (IT) % NSEQ, _dir = _sq & 1, _h = (_sq >> 1) % 6, _b = (_sq >> 1) / 6; \
        const int _t0 = (_dir ? NSUB - 1 - _sub : _sub) * 128; const bf16_t* _pb = P + (size_t)_b * SL * NC; const int _tid = threadIdx.x; \
        _Pragma("unroll") for (int k = 0; k < 3; ++k) { const int idx = _tid + 512 * k, r = idx >> 3, sg = idx & 7, t = _t0 - 2 + r; pf[k] = (u32x4){0u, 0u, 0u, 0u}; \
            if (idx < 1048 && t >= 0 && t < SL) pf[k] = *(const u32x4*)(_pb + (size_t)t * NC + C_RG + _h * 64 + sg * 8); } } while (0)
    if ((int)blockIdx.x < NSUB * NSEQ) { RG_PREFETCH((int)blockIdx.x);
#pragma unroll
        for (int k = 0; k < 3; ++k) { const int idx = (int)threadIdx.x + 512 * k; if (idx < 1048) *(u32x4*)(RAWR + (idx >> 3) * 64 + (idx & 7) * 8) = pf[k]; } }
    lds_barrier();
    for (int it = blockIdx.x; it < NSUB * NSEQ; it += gridDim.x) {
        const int tid = launder_tid(), lane = tid & 63, wave = tid >> 6, fr = lane & 15, fq = lane >> 4;
        const int cc = tid & 63, seg = tid >> 6, mh = wave >> 2, jq = wave & 3;
        const int sub = it / NSEQ, sq = it % NSEQ, dir = sq & 1, h = (sq >> 1) % 6, b = (sq >> 1) / 6;
        const int st = dir ? NSUB - 1 - sub : sub, t0 = st * 128;
        bf16_t* pb = P + (size_t)b * SL * NC;
        unsigned long long gv0 = 0ull;
        if (wave == 0 && sub > 0) gv0 = __hip_atomic_load(GR + ((size_t)(sub - 1) * NSEQ + sq) * 64 + lane, __ATOMIC_RELAXED, __HIP_MEMORY_SCOPE_AGENT);
        bf16x8 Ba[2], Bx[2];
        { const bf16_t* wa = (const bf16_t*)(p.ws + WS_RGWT) + ((size_t)((l * 2 + dir) * 2 + 0) * 6 + h) * 4096;
          const bf16_t* wx = (const bf16_t*)(p.ws + WS_RGWT) + ((size_t)((l * 2 + dir) * 2 + 1) * 6 + h) * 4096;
#pragma unroll
          for (int ks = 0; ks < 2; ++ks) { Ba[ks] = *(const bf16x8*)(wa + (jq * 16 + fr) * 64 + ks * 32 + fq * 8); Bx[ks] = *(const bf16x8*)(wx + (jq * 16 + fr) * 64 + ks * 32 + fq * 8); } }
        const int gch = h * 64 + jq * 16 + fr;
        const float bga = p.in[I_RBA][(l * 2 + dir) * DR + gch], bgx = p.in[I_RBX][(l * 2 + dir) * DR + gch];
        const float lam = p.in[I_RLAM][(l * 2 + dir) * DR + gch];
        const float sp8l2 = 8.0f * 1.4426950408889634f * log1pf(__expf(-lam));
        const int c = h * 64 + cc;
        const float w0 = cw[c], w1 = cw[DR + c], w2 = cw[2 * DR + c], w3 = cw[3 * DR + c], cbias = cb[c];
        const bool has_next = it + (int)gridDim.x < NSUB * NSEQ;
        if (has_next) RG_PREFETCH(it + (int)gridDim.x);
        { const bf16_t* rr = RAWR + (seg * 16) * 64 + cc;
          float pm2 = bf2f(rr[0]), pm1 = bf2f(rr[64]), p0 = bf2f(rr[128]);
#pragma unroll
          for (int i = 0; i < 16; ++i) {
              const float pp = bf2f(rr[(i + 3) * 64]);
              const float xr = w0 * pm2 + w1 * pm1 + w2 * p0 + w3 * pp + cbias;
              const int tl = seg * 16 + i, si = dir ? 127 - tl : tl;
              XRF[si * 64 + cc] = xr; XRB[si * 72 + cc] = f2bf(xr);
              pm2 = pm1; pm1 = p0; p0 = pp; } }
        lds_barrier();
#pragma unroll
        for (int m = 0; m < 4; ++m) {
            f32x4 ga = {0.f, 0.f, 0.f, 0.f}, gx = {0.f, 0.f, 0.f, 0.f};
#pragma unroll
            for (int ks = 0; ks < 2; ++ks) { const bf16x8 af = *(const bf16x8*)(XRB + (mh * 64 + m * 16 + fr) * 72 + ks * 32 + fq * 8);
                ga = __builtin_amdgcn_mfma_f32_16x16x32_bf16(af, Ba[ks], ga, 0, 0, 0); gx = __builtin_amdgcn_mfma_f32_16x16x32_bf16(af, Bx[ks], gx, 0, 0, 0); }
#pragma unroll
            for (int j = 0; j < 4; ++j) { const int si = mh * 64 + m * 16 + fq * 4 + j, col = jq * 16 + fr;
                const float r = sigmoidf_(ga[j] + bga), ig = sigmoidf_(gx[j] + bgx);
                const float la2 = -sp8l2 * r; const float a = __builtin_amdgcn_exp2f(la2); const float mult = __builtin_amdgcn_sqrtf(fmaxf(1.0f - a * a, 0.f));
                AS[si * 64 + col] = a; BS[si * 64 + col] = mult * ig * XRF[si * 64 + col]; }
        }
        lds_barrier();
        float hl[16], ca[16];
        { float hh = 0.f, cum = 1.f;
#pragma unroll
          for (int i = 0; i < 16; ++i) { const float a = AS[(seg * 16 + i) * 64 + cc], bb = BS[(seg * 16 + i) * 64 + cc]; hh = a * hh + bb; cum *= a; hl[i] = hh; ca[i] = cum; }
          SEGA[seg * 64 + cc] = cum; SEGB[seg * 64 + cc] = hh; }
        if (wave == 0) {
            float cin = 0.f;
            if (sub > 0) {
                unsigned long long* g = GR + ((size_t)(sub - 1) * NSEQ + sq) * 64 + lane;
                unsigned long long v = gv0; unsigned sp = 0;
                while ((unsigned)(v >> 32) != 1u) { __builtin_amdgcn_s_sleep(1); if (++sp > (1u << 22)) break; v = __hip_atomic_load(g, __ATOMIC_RELAXED, __HIP_MEMORY_SCOPE_AGENT); }
                cin = __uint_as_float((unsigned)v);
            }
            CARRY[lane] = cin;
        }
        lds_barrier();
        float cin = CARRY[cc];
        for (int q = 0; q < seg; ++q) cin = SEGA[q * 64 + cc] * cin + SEGB[q * 64 + cc];
        if (seg == 7) {
            const float ncar = hl[15] + ca[15] * cin;
            __hip_atomic_store(GR + ((size_t)sub * NSEQ + sq) * 64 + cc, ((unsigned long long)1u << 32) | (unsigned long long)__float_as_uint(ncar), __ATOMIC_RELAXED, __HIP_MEMORY_SCOPE_AGENT);
        }
        { bf16_t* dst = pb + (dir ? C_V : C_X1) + c;
#pragma unroll
          for (int i = 0; i < 16; ++i) { const int si = seg * 16 + i, tl = dir ? 127 - si : si; dst[(size_t)(t0 + tl) * NC] = f2bf(hl[i] + ca[i] * cin); } }
        if (has_next) {
#pragma unroll
            for (int k = 0; k < 3; ++k) { const int idx = tid + 512 * k; if (idx < 1048) *(u32x4*)(RAWR + (idx >> 3) * 64 + (idx & 7) * 8) = pf[k]; } }
        lds_barrier();
    }
#undef RG_PREFETCH
}

__device__ __forceinline__ void unpack6(const U3 v, float (&o)[6]) {
    o[0] = __uint_as_float(v.x << 16); o[1] = __uint_as_float(v.x & 0xffff0000u); o[2] = __uint_as_float(v.y << 16); o[3] = __uint_as_float(v.y & 0xffff0000u);
    o[4] = __uint_as_float(v.z << 16); o[5] = __uint_as_float(v.z & 0xffff0000u);
}
__device__ __forceinline__ void phase_finalize(const Params& p, int l, unsigned char* lds) {
    float* UT = (float*)lds;
    const bf16_t* P = (const bf16_t*)(p.ws + WS_P); bf16_t* Y = (bf16_t*)(p.ws + WS_HY); const bf16_t* U = (const bf16_t*)(p.ws + WS_U);
    const float* cw = p.in[I_HCW] + (size_t)l * 3 * 1152; const float* cb = p.in[I_HCB] + l * 1152; const float* gg = p.in[I_GRPG] + l * DM;
    const int tid = threadIdx.x, lane = tid & 63, wave = tid >> 6;
    float w0[6], w1[6], w2[6], wb[6], ghy[6], grg[6];
#pragma unroll
    for (int q = 0; q < 6; ++q) { const int c = lane * 6 + q; w0[q] = cw[c]; w1[q] = cw[1152 + c]; w2[q] = cw[2304 + c]; wb[q] = cb[c]; ghy[q] = gg[c]; grg[q] = gg[640 + c]; }
    u32x4 pf[6];
#define FIN_PREFETCH(IT) do { const int _b = (IT) / (SL / 64), _t0 = ((IT) % (SL / 64)) * 64; \
        _Pragma("unroll") for (int k = 0; k < 6; ++k) { const int idx = tid + 512 * k, c = idx >> 3, t8 = (idx & 7) * 8; pf[k] = *(const u32x4*)(U + ((size_t)_b * DH + c) * SL + _t0 + t8); } } while (0)
    if ((int)blockIdx.x < NB * (SL / 64)) FIN_PREFETCH((int)blockIdx.x);
    for (int it = blockIdx.x; it < NB * (SL / 64); it += gridDim.x) {
        const int b = it / (SL / 64), t0 = (it % (SL / 64)) * 64;
#pragma unroll
        for (int k = 0; k < 6; ++k) { const int idx = tid + 512 * k, c = idx >> 3, t8 = (idx & 7) * 8;
            const u32x4 v = pf[k];
#pragma unroll
            for (int j = 0; j < 4; ++j) { UT[c * 65 + t8 + 2 * j] = __uint_as_float(v[j] << 16); UT[c * 65 + t8 + 2 * j + 1] = __uint_as_float(v[j] & 0xffff0000u); } }
        lds_barrier();
        if (it + (int)gridDim.x < NB * (SL / 64)) FIN_PREFETCH(it + (int)gridDim.x);
        const bf16_t* pb = P + (size_t)b * SL * NC;
#pragma unroll 4
        for (int i = 0; i < 8; ++i) { const int tl = wave * 8 + i, t = t0 + tl; const size_t row = (size_t)b * SL + t;
            const bf16_t* pq = pb + (size_t)t * NC + lane * 6; const bf16_t* pr = pq + C_X0;
            const int om = (t > 0) ? -NC : 0, op = (t + 1 < SL) ? NC : 0;
            const float fm = (t > 0) ? 1.f : 0.f, fp = (t + 1 < SL) ? 1.f : 0.f;
            const U3 rm = *(const U3*)(pr + om), rc = *(const U3*)pr, rp = *(const U3*)(pr + op), rg = *(const U3*)(pq + C_GATE);
            const U3 rf = *(const U3*)(pq + C_X1), rb = *(const U3*)(pq + C_V), rg2 = *(const U3*)(pq + C_GATE + 640);
            float xm[6], xc[6], xp[6], gt[6], y[6], ss = 0.f;
            unpack6(rm, xm); unpack6(rc, xc); unpack6(rp, xp); unpack6(rg, gt);
#pragma unroll
            for (int q = 0; q < 6; ++q) { const float x0 = w0[q] * (xm[q] * fm) + w1[q] * xc[q] + w2[q] * (xp[q] * fp) + wb[q];
                y[q] = UT[(lane * 6 + q) * 65 + tl] * x0; ss += y[q] * y[q]; }
            float rstd = rsqrtf(wave_sum(ss) * (1.0f / DH) + EPS);
            { U3 o; o.x = pk2(y[0] * rstd * ghy[0] * siluf_(gt[0]), y[1] * rstd * ghy[1] * siluf_(gt[1])); o.y = pk2(y[2] * rstd * ghy[2] * siluf_(gt[2]), y[3] * rstd * ghy[3] * siluf_(gt[3]));
              o.z = pk2(y[4] * rstd * ghy[4] * siluf_(gt[4]), y[5] * rstd * ghy[5] * siluf_(gt[5])); *(U3*)(Y + row * DM + lane * 6) = o; }
            unpack6(rf, xm); unpack6(rb, xc); unpack6(rg2, gt); ss = 0.f;
#pragma unroll
            for (int q = 0; q < 6; ++q) { y[q] = xm[q] + xc[q]; ss += y[q] * y[q]; }
            rstd = rsqrtf(wave_sum(ss) * (1.0f / DR) + EPS);
            { U3 o; o.x = pk2(y[0] * rstd * grg[0] * siluf_(gt[0]), y[1] * rstd * grg[1] * siluf_(gt[1])); o.y = pk2(y[2] * rstd * grg[2] * siluf_(gt[2]), y[3] * rstd * grg[3] * siluf_(gt[3]));
              o.z = pk2(y[4] * rstd * grg[4] * siluf_(gt[4]), y[5] * rstd * grg[5] * siluf_(gt[5])); *(U3*)(Y + row * DM + 640 + lane * 6) = o; }
        }
        lds_barrier();
    }
}

#define XB_TMO      128
#define XB_XCNT(j)  (256  + 64 * (j))
#define XB_XSUB(j)  (1280 + 64 * (j))
#define XB_XGEN(j)  (2304 + 64 * (j))
#define XB_TOP      3328
#define XB_TOPGEN   3392
#define XCD_BAR_WORDS 3456
#define XB_SPIN_CAP (1u << 22)
#define LAS __attribute__((address_space(3)))
__device__ __forceinline__ unsigned xb_ld(unsigned* p)              { return __hip_atomic_load(p, __ATOMIC_RELAXED, __HIP_MEMORY_SCOPE_AGENT); }
__device__ __forceinline__ unsigned xb_add(unsigned* p, unsigned v) { return __hip_atomic_fetch_add(p, v, __ATOMIC_RELAXED, __HIP_MEMORY_SCOPE_AGENT); }
__device__ __forceinline__ unsigned xb_xcc_id() { return (unsigned)__builtin_amdgcn_s_getreg((3 << 11) | 20) & 0xFu; }
#define XB_SPIN(cond, bar) do { unsigned _sp = 0; while (cond) { __builtin_amdgcn_s_sleep(1); \
    if ((++_sp & 255u) == 0u) { if (xb_ld(&(bar)[XB_TMO])) break; if (_sp > XB_SPIN_CAP) { atomicAdd(&(bar)[XB_TMO], 1u); break; } } } } while (0)
struct XcdBarrier { unsigned* bar; unsigned x; volatile LAS unsigned* st; };
__device__ __forceinline__ XcdBarrier xcd_barrier_post(unsigned* bar, volatile LAS unsigned* st) {
    XcdBarrier b; b.bar = bar; b.x = xb_xcc_id(); b.st = st;
    if (threadIdx.x == 0) (void)xb_add(&bar[XB_XCNT(b.x)], 1u);
    return b;
}
__device__ __forceinline__ void xcd_barrier_complete(unsigned* bar, unsigned x, unsigned& nloc, unsigned& nx) {
    const unsigned G = gridDim.x * gridDim.y * gridDim.z;
    unsigned sum, cnt, mine, sp = 0u;
    for (;;) {
        sum = 0u; cnt = 0u; mine = 0u;
#pragma unroll
        for (unsigned j = 0; j < 16; ++j) { const unsigned c = xb_ld(&bar[XB_XCNT(j)]); sum += c; cnt += (c > 0u) ? 1u : 0u; mine = (j == x) ? c : mine; }
        if (sum == G) break;
        __builtin_amdgcn_s_sleep(1);
        if ((++sp & 255u) == 0u) { if (xb_ld(&bar[XB_TMO])) break; if (sp > XB_SPIN_CAP) { atomicAdd(&bar[XB_TMO], 1u); break; } }
    }
    nloc = mine > 0u ? mine : 1u; nx = cnt > 0u ? cnt : 1u;
}
__device__ __forceinline__ void xcd_barrier(const XcdBarrier& b) {
    asm volatile("s_waitcnt vmcnt(0)" ::: "memory");
    __syncthreads();
    if (threadIdx.x == 0) {
        unsigned* bar = b.bar;
        __builtin_amdgcn_s_waitcnt(0);
        unsigned nloc = b.st[0], nx = b.st[1];
        if (nloc == 0u) { xcd_barrier_complete(bar, b.x, nloc, nx); b.st[0] = nloc; b.st[1] = nx; }
        const unsigned old = xb_add(&bar[XB_XSUB(b.x)], 1u);
        const unsigned gen = old / nloc;
        if (old + 1u == (gen + 1u) * nloc) {
            __builtin_amdgcn_fence(__ATOMIC_RELEASE, "agent");
            asm volatile("s_waitcnt vmcnt(0)" ::: "memory");
            const unsigned og = xb_add(&bar[XB_TOP], 1u);
            const unsigned tg = og / nx;
            if (og + 1u == (tg + 1u) * nx) xb_add(&bar[XB_TOPGEN], 1u);
            else XB_SPIN(xb_ld(&bar[XB_TOPGEN]) == tg, bar);
            __builtin_amdgcn_fence(__ATOMIC_ACQUIRE, "agent");
            xb_add(&bar[XB_XGEN(b.x)], 1u);
            asm volatile("s_waitcnt vmcnt(0)" ::: "memory");
        } else {
            XB_SPIN(xb_ld(&bar[XB_XGEN(b.x)]) == gen, bar);
            __builtin_amdgcn_fence(__ATOMIC_ACQUIRE, "agent");
            asm volatile("s_waitcnt vmcnt(0)" ::: "memory");
        }
    }
    __syncthreads();
}

constexpr int NPHASE = 13;
#ifndef MK_DUP
#define MK_DUP 0
#endif
#define DUPN(bit) (((MK_DUP >> (bit)) & 1) ? 2 : 1)
template <int PH>
__device__ __forceinline__ void run_phase(const Params& p, unsigned char* lds, int vc) {
    float* SS = (float*)(p.ws + WS_SS);
    if constexpr (PH == 0) {
        phase_prep_weights(p, lds);
        phase_filters(p, 0, lds);
        phase_x0_prep(p.in[I_XP], p.in[I_XS], (bf16_t*)p.out, SS);
    } else if constexpr (PH == 12) {
        phase_final_norm((const bf16_t*)(p.ws + WS_P), SS + 2 * T, p.in[I_FING], p.out);
    } else {
        constexpr int l = (PH - 1) / 6, s = (PH - 1) % 6;
        if constexpr (s == 0) {
            pg8::Gemm g; g.A = (const bf16_t*)p.out; g.Bt = (const bf16_t*)(p.ws + WS_WINT) + (size_t)l * NC * DM; g.M = T; g.N = NC; g.K = DM;
            pg8::StaticOrder S; S.init(T, NC, (int)gridDim.x, vc);
            pg8::EpiBf16 E; E.O = (bf16_t*)(p.ws + WS_P); E.ldc = NC; E.ss = SS + l * T; E.invk = 1.0f / DM; E.eps = EPS; E.glu_tiles = 2;
            pg8::gemm_phase<pg8::EpiBf16, pg8::StaticOrder, false>((PG8_LAS unsigned char*)lds, g, S, E, nullptr);
        } else if constexpr (s == 1) {
            phase_kf_fft(p, lds);
            for (int r = 0; r < DUPN(0); ++r) phase_conformer(p, l, lds);
            for (int r = 0; r < DUPN(1); ++r) phase_hyena_prep(p, l, lds);
        } else if constexpr (s == 2) {
            phase_fftconv(p, l, lds);
            for (int r = 0; r < DUPN(3); ++r) phase_rglru_chain(p, l, lds);
        } else if constexpr (s == 3) {
            for (int r = 0; r < DUPN(4); ++r) phase_finalize(p, l, lds);
            if constexpr (l == 0) phase_filters(p, 1, lds);
        } else if constexpr (s == 4) {
            pg8::Gemm g; g.A = (const bf16_t*)(p.ws + WS_HY); g.Bt = (const bf16_t*)(p.ws + WS_WOUTT) + (size_t)l * DM * DM; g.M = T; g.N = DM; g.K = DM;
            pg8::StaticOrder S; S.init(T, DM, (int)gridDim.x, vc);
            pg8::EpiResB E; E.R = (const bf16_t*)p.out; E.O = (l == 0) ? (bf16_t*)p.out : (bf16_t*)(p.ws + WS_P); E.ldc = DM; E.ssq = SS + (l + 1) * T;
            pg8::gemm_phase<pg8::EpiResB, pg8::StaticOrder, false>((PG8_LAS unsigned char*)lds, g, S, E, nullptr);
        }
    }
}
__global__ __launch_bounds__(512, 2) void mega(Params p) {
    extern __shared__ __attribute__((aligned(16))) unsigned char lds[];
    cg::grid_group grid = cg::this_grid();
    volatile LAS unsigned* xst = (volatile LAS unsigned*)(PG8_LAS unsigned char*)(lds + LDS_BYTES);
    if (threadIdx.x == 0) { xst[0] = 0u; xst[1] = 0u; xst[2] = blockIdx.x; xst[3] = 0u; }
    __syncthreads();
    const bool multi = (p.ph_hi - p.ph_lo) > 1;
    XcdBarrier xb; xb.bar = (unsigned*)(p.ws + WS_BAR); xb.x = 0; xb.st = xst;
    unsigned myrank = 0u;
    if (multi) { xb = xcd_barrier_post((unsigned*)(p.ws + WS_BAR), xst);
        if (threadIdx.x == 0) myrank = xb_add(&xb.bar[RK_BASE + 64 * xb.x], 1u); }
#ifndef MK_MASK
#define MK_MASK 0x1fff
#endif
#define RUN_PH(PH) if constexpr ((MK_MASK >> PH) & 1) if (p.ph_lo <= PH && PH < p.ph_hi) { run_phase<PH>(p, lds, (int)xst[2]); asm volatile("" ::: "memory"); if (PH + 1 < p.ph_hi) { if (p.ph_lo > 1000) grid.sync(); else xcd_barrier(xb); } }
    RUN_PH(0)
    if (multi) {
        if (threadIdx.x == 0) { bool ok = (gridDim.x % 8u) == 0u;
            for (unsigned j = 0; j < 16; ++j) { const unsigned cnt = xb_ld(&xb.bar[RK_BASE + 64 * j]); if (cnt != ((j < 8u) ? gridDim.x / 8u : 0u)) ok = false; }
            if (ok && xb.x < 8u && myrank < gridDim.x / 8u) xst[2] = myrank * 8u + xb.x; }
        __syncthreads();
    }
    RUN_PH(1) RUN_PH(2) RUN_PH(3) RUN_PH(4) RUN_PH(5) RUN_PH(7) RUN_PH(8) RUN_PH(9) RUN_PH(10) RUN_PH(11) RUN_PH(12)
#undef RUN_PH
}

#ifndef MK_LAUNCHES
#define MK_LAUNCHES 1
#endif
extern "C" void kernel_launch(void* const* d_in, const int* in_sizes, int n_in, void* d_out, int out_size, void* d_ws, size_t ws_size, hipStream_t stream) {
    static int grid = 0;
    if (grid == 0) {
        if (n_in != 31 || out_size != T * DM || ws_size < WS_END) { fprintf(stderr, "kernel_launch: unexpected shapes (n_in %d out %d ws %zu need %zu)\n", n_in, out_size, ws_size, (size_t)WS_END); grid = -1; return; }
        int dev = 0, cus = 0, per_cu = 0;
        (void)hipGetDevice(&dev); (void)hipDeviceGetAttribute(&cus, hipDeviceAttributeMultiprocessorCount, dev);
        if (hipFuncSetAttribute((const void*)mega, hipFuncAttributeMaxDynamicSharedMemorySize, LDS_BYTES + 16) != hipSuccess) { fprintf(stderr, "kernel_launch: hipFuncSetAttribute failed\n"); grid = -1; return; }
        if (hipOccupancyMaxActiveBlocksPerMultiprocessor(&per_cu, (const void*)mega, 512, LDS_BYTES + 16) != hipSuccess || per_cu < 1) { fprintf(stderr, "kernel_launch: occupancy query gave %d\n", per_cu); per_cu = 1; }
        (void)hipGetLastError();
        grid = cus * per_cu;
    }
    if (grid < 0) return;
    if (hipMemsetAsync((char*)d_ws + WS_BAR, 0, CTL_BYTES, stream) != hipSuccess) { fprintf(stderr, "kernel_launch: memset failed\n"); return; }
    Params p{};
    for (int i = 0; i < 31; ++i) p.in[i] = (const float*)d_in[i];
    p.out = (float*)d_out; p.ws = (unsigned char*)d_ws;
#if MK_LAUNCHES == 1
    p.ph_lo = 0; p.ph_hi = NPHASE;
    void* args[] = {&p};
    hipError_t e = hipLaunchCooperativeKernel((const void*)mega, dim3(grid), dim3(512), args, LDS_BYTES + 16, stream);
    if (e != hipSuccess) fprintf(stderr, "cooperative launch failed: %s (grid %d)\n", hipGetErrorString(e), grid);
#else
    for (int ph = 0; ph < NPHASE; ++ph) { p.ph_lo = ph; p.ph_hi = ph + 1; hipLaunchKernelGGL(mega, dim3(grid), dim3(512), LDS_BYTES + 16, stream, p); }
#endif
}
```

```cpp
#include <hip/hip_runtime.h>
#include <hip/hip_cooperative_groups.h>
#include <cstdio>
#include <cstdint>
namespace cg = cooperative_groups;

namespace pg8 {
#define PG8_LAS __attribute__((address_space(3)))
typedef unsigned short bf16_t;
typedef short bf16x8 __attribute__((ext_vector_type(8)));
typedef float f32x4 __attribute__((ext_vector_type(4)));
typedef unsigned u32x4 __attribute__((ext_vector_type(4)));
constexpr int BM = 256, BK = 64, HALF = 128, HTB = HALF * BK * 2, STAGE_BYTES = 8 * HTB, NXCD = 8, WGM = 8;

__host__ __device__ __forceinline__ int lds_byte(int r, int c) { const int st = (r >> 4) * 2 + (c >> 5), rr = r & 15, cc = c & 31, ob = rr * 64 + cc * 2; return st * 1024 + (ob ^ (((ob >> 9) & 1) << 5)); }
__host__ __device__ __forceinline__ void stage_rc(int b, int& R, int& C) { const int st = b / 1024, sb = b % 1024, swz = sb ^ (((sb >> 9) & 1) << 5); R = (st >> 1) * 16 + swz / 64; C = (st & 1) * 32 + (swz % 64) / 2; }
__host__ __device__ __forceinline__ int perm32(int rho) { const int n = rho >> 4, i = rho & 15; return 8 * (i >> 2) + 4 * n + (i & 3); }

struct Unit { int pm, pn; };
struct Gemm { const bf16_t* A; const bf16_t* Bt; int M, N, K; };

struct StaticOrder {
    int nM, nN, nwg, G, c, wgm;
    __host__ __device__ void init(int M, int N, int G_, int c_, int wgm_ = WGM) { nM = M / BM; nN = N / BM; nwg = nM * nN; G = G_; c = c_; wgm = wgm_; }
    __host__ __device__ bool next(int i, Unit& u) const {
        const long L = (long)i * G + c; if (L >= nwg) return false;
        int wgid = (int)L; { const int q = nwg / NXCD, r = nwg % NXCD, xcd = wgid % NXCD, off = wgid / NXCD; wgid = (xcd < r ? xcd * (q + 1) : r * (q + 1) + (xcd - r) * q) + off; }
        const int nig = wgm * nN, gid = wgid / nig, fm = gid * wgm, gsz = (nM - fm) < wgm ? (nM - fm) : wgm;
        u.pm = fm + ((wgid % nig) % gsz); u.pn = (wgid % nig) / gsz; return true;
    }
    __device__ __forceinline__ void a_ready(const Unit&) const {}
    __device__ __forceinline__ void done(const Unit&) const {}
};

__device__ __forceinline__ unsigned cvt_pk_bf16(float lo, float hi) { unsigned r; asm volatile("v_cvt_pk_bf16_f32 %0, %1, %2" : "=v"(r) : "v"(lo), "v"(hi)); return r; }

struct EpiBf16 {
    static constexpr bool PERM = true, AFTER_DRAIN = false;
    bf16_t* O; int ldc; const float* ss; float invk, eps; int glu_tiles;
    __device__ __forceinline__ void operator()(const f32x4 (&acc)[2][2][4][2], const Unit& u, int wr, int wc, int fr, int fq) const {
        const int row0 = u.pm * BM + wr * 64 + fr; const int col0 = u.pn * BM + wc * 32 + 8 * fq;
        float sv[2][4];
#pragma unroll
        for (int ai = 0; ai < 2; ++ai)
#pragma unroll
            for (int m = 0; m < 4; ++m) sv[ai][m] = ss[row0 + ai * HALF + m * 16];
        asm volatile("s_waitcnt vmcnt(0)" ::: "memory");
        if (u.pn >= glu_tiles) {
#pragma unroll
            for (int ai = 0; ai < 2; ++ai)
#pragma unroll
                for (int m = 0; m < 4; ++m) { const int row = row0 + ai * HALF + m * 16; bf16_t* rowp = O + (size_t)row * ldc + col0;
                    const float rs = __builtin_amdgcn_rsqf(sv[ai][m] * invk + eps);
#pragma unroll
                    for (int bj = 0; bj < 2; ++bj) { const f32x4 v0 = acc[ai][bj][m][0] * rs, v1 = acc[ai][bj][m][1] * rs;
                        u32x4 w; w.x = cvt_pk_bf16(v0[0], v0[1]); w.y = cvt_pk_bf16(v0[2], v0[3]); w.z = cvt_pk_bf16(v1[0], v1[1]); w.w = cvt_pk_bf16(v1[2], v1[3]);
                        __builtin_nontemporal_store(w, (u32x4*)(rowp + bj * HALF)); } }
        } else {
#pragma unroll
            for (int ai = 0; ai < 2; ++ai)
#pragma unroll
                for (int m = 0; m < 4; ++m) { const int row = row0 + ai * HALF + m * 16; bf16_t* rowp = O + (size_t)row * ldc + col0;
                    const float rs = __builtin_amdgcn_rsqf(sv[ai][m] * invk + eps), rg = -1.4426950408889634f * rs;
                    f32x4 v0 = acc[ai][0][m][0] * rs, v1 = acc[ai][0][m][1] * rs; const f32x4 g0 = acc[ai][1][m][0] * rg, g1 = acc[ai][1][m][1] * rg;
#pragma unroll
                    for (int j = 0; j < 4; ++j) { v0[j] *= __builtin_amdgcn_rcpf(1.0f + __builtin_amdgcn_exp2f(g0[j])); v1[j] *= __builtin_amdgcn_rcpf(1.0f + __builtin_amdgcn_exp2f(g1[j])); }
                    u32x4 w; w.x = cvt_pk_bf16(v0[0], v0[1]); w.y = cvt_pk_bf16(v0[2], v0[3]); w.z = cvt_pk_bf16(v1[0], v1[1]); w.w = cvt_pk_bf16(v1[2], v1[3]);
                    __builtin_nontemporal_store(w, (u32x4*)rowp); }
        }
    }
};
struct EpiResB {
    static constexpr bool PERM = true, AFTER_DRAIN = false;
    bf16_t* O; const bf16_t* R; int ldc; float* ssq;
    __device__ __forceinline__ void operator()(const f32x4 (&acc)[2][2][4][2], const Unit& u, int wr, int wc, int fr, int fq) const {
        const int row0 = u.pm * BM + wr * 64 + fr, col0 = u.pn * BM + wc * 32 + 8 * fq;
#pragma unroll
        for (int ai = 0; ai < 2; ++ai) {
            u32x4 rv[4][2];
#pragma unroll
            for (int m = 0; m < 4; ++m)
#pragma unroll
                for (int bj = 0; bj < 2; ++bj) rv[m][bj] = *(const u32x4*)(R + (size_t)(row0 + ai * HALF + m * 16) * ldc + col0 + bj * HALF);
            asm volatile("s_waitcnt vmcnt(0)" ::: "memory");
#pragma unroll
            for (int m = 0; m < 4; ++m) { const int row = row0 + ai * HALF + m * 16; const size_t off = (size_t)row * ldc + col0; float s2 = 0.f;
#pragma unroll
                for (int bj = 0; bj < 2; ++bj) {
                    f32x4 v0 = acc[ai][bj][m][0], v1 = acc[ai][bj][m][1]; const u32x4 r4 = rv[m][bj];
                    v0[0] += __uint_as_float(r4.x << 16); v0[1] += __uint_as_float(r4.x & 0xffff0000u); v0[2] += __uint_as_float(r4.y << 16); v0[3] += __uint_as_float(r4.y & 0xffff0000u);
                    v1[0] += __uint_as_float(r4.z << 16); v1[1] += __uint_as_float(r4.z & 0xffff0000u); v1[2] += __uint_as_float(r4.w << 16); v1[3] += __uint_as_float(r4.w & 0xffff0000u);
                    s2 += v0[0] * v0[0] + v0[1] * v0[1] + v0[2] * v0[2] + v0[3] * v0[3] + v1[0] * v1[0] + v1[1] * v1[1] + v1[2] * v1[2] + v1[3] * v1[3];
                    u32x4 w; w.x = cvt_pk_bf16(v0[0], v0[1]); w.y = cvt_pk_bf16(v0[2], v0[3]); w.z = cvt_pk_bf16(v1[0], v1[1]); w.w = cvt_pk_bf16(v1[2], v1[3]);
                    *(u32x4*)(O + off + bj * HALF) = w; }
                s2 += __shfl_xor(s2, 16); s2 += __shfl_xor(s2, 32);
                if (fq == 0) atomicAdd(ssq + row, s2); }
        }
    }
};

template <class Epi, class Sched, bool STAMP = false>
__device__ __forceinline__ void gemm_phase(PG8_LAS unsigned char* lds, const Gemm g, const Sched& S, const Epi& E, unsigned long long* stamps) {
    const int tid = threadIdx.x, wid = __builtin_amdgcn_readfirstlane(tid >> 6), lane = tid & 63, wr = wid >> 2, wc = wid & 3, fr = lane & 15, fq = lane >> 4;
    const int K = g.K, nt = K / BK;
    int ts_lo = 0, ts_hi = 0, nts = 0; const unsigned long long rt_entry = STAMP ? (unsigned long long)wall_clock64() : 0ull;
#define PG8_STAMP() do { if (STAMP && wid == 0 && nts < 64) { const unsigned long long _c = (unsigned long long)clock64(); \
        ts_lo = (lane == nts) ? (int)(unsigned)_c : ts_lo; ts_hi = (lane == nts) ? (int)(unsigned)(_c >> 32) : ts_hi; ++nts; } } while (0)
    PG8_STAMP();
    unsigned voffA[2], voffB[2];
#pragma unroll
    for (int i = 0; i < 2; ++i) { int R, C; stage_rc(tid * 16 + i * 8192, R, C); const int Rb = Epi::PERM ? ((R & ~31) + perm32(R & 31)) : R;
        voffA[i] = (unsigned)(R * K + C) * 2u; voffB[i] = (unsigned)(Rb * K + C) * 2u; }
    const size_t kstep = (size_t)(BK * 2);
    const size_t hstep = (size_t)HALF * K * 2;
    const size_t tstep = 2 * hstep;
    const unsigned ldsw = (unsigned)wid * 1024u;
    const int aoff = lds_byte(wr * 64 + fr, fq * 8), boff = lds_byte(wc * 32 + fr, fq * 8);
#define PG8_SA(b, h) (((b) * 2 + (h)) * HTB)
#define PG8_SB(b, h) ((4 + (b) * 2 + (h)) * HTB)
#define PG8_STAGE(bufoff, gbase, voff) do { _Pragma("unroll") for (int _i = 0; _i < 2; ++_i) \
        __builtin_amdgcn_global_load_lds((const unsigned*)((const char*)(gbase) + (voff)[_i]), (PG8_LAS unsigned*)(lds + (bufoff) + ldsw + _i * 8192), 16, 0, 0); } while (0)
#define PG8_LDA(dst, b, h) do { _Pragma("unroll") for (int m = 0; m < 4; ++m) _Pragma("unroll") for (int k = 0; k < 2; ++k) dst[m][k] = *(const PG8_LAS bf16x8*)(lds + PG8_SA(b, h) + aoff + m * 2048 + k * 1024); } while (0)
#define PG8_LDB(dst, b, h) do { _Pragma("unroll") for (int n = 0; n < 2; ++n) _Pragma("unroll") for (int k = 0; k < 2; ++k) dst[n][k] = *(const PG8_LAS bf16x8*)(lds + PG8_SB(b, h) + boff + n * 2048 + k * 1024); } while (0)
#define PG8_MMA(ai, bj, At, Bt) do { __builtin_amdgcn_s_setprio(1); _Pragma("unroll") for (int m = 0; m < 4; ++m) _Pragma("unroll") for (int n = 0; n < 2; ++n) _Pragma("unroll") for (int k = 0; k < 2; ++k) \
        acc[ai][bj][m][n] = __builtin_amdgcn_mfma_f32_16x16x32_bf16(Bt[n][k], At[m][k], acc[ai][bj][m][n], 0, 0, 0); __builtin_amdgcn_s_setprio(0); } while (0)
#define PG8_WAIT_V(n) asm volatile("s_waitcnt vmcnt(" #n ")" ::: "memory")
#define PG8_WAIT_L(n) asm volatile("s_waitcnt lgkmcnt(" #n ")" ::: "memory")
#define PG8_BAR __builtin_amdgcn_s_barrier()
#define PG8_SCHED __builtin_amdgcn_sched_barrier(0)
    Unit cur, nxt; int ui = 0;
    if (!S.next(0, cur)) return;
    f32x4 acc[2][2][4][2];
#pragma unroll
    for (int a = 0; a < 2; ++a)
#pragma unroll
        for (int b = 0; b < 2; ++b)
#pragma unroll
            for (int m = 0; m < 4; ++m)
#pragma unroll
                for (int n = 0; n < 2; ++n) acc[a][b][m][n] = (f32x4){0.f, 0.f, 0.f, 0.f};
    bf16x8 At[4][2], B0[2][2], B1[2][2];
    const char* cA = (const char*)g.A + (size_t)cur.pm * tstep; const char* cB = (const char*)g.Bt + (size_t)cur.pn * tstep;
    S.a_ready(cur);
    PG8_STAGE(PG8_SB(0, 0), cB, voffB); PG8_STAGE(PG8_SA(0, 0), cA, voffA); PG8_STAGE(PG8_SB(0, 1), cB + hstep, voffB); PG8_STAGE(PG8_SA(0, 1), cA + hstep, voffA);
    if (wr == 1) PG8_BAR;
    PG8_WAIT_V(4); PG8_BAR;
    PG8_STAGE(PG8_SB(1, 0), cB + kstep, voffB); PG8_STAGE(PG8_SA(1, 0), cA + kstep, voffA); PG8_STAGE(PG8_SB(1, 1), cB + hstep + kstep, voffB);
    PG8_WAIT_V(6); PG8_BAR;
    PG8_STAMP();
    for (;;) {
        const bool has_next = S.next(ui + 1, nxt);
        const char* nA = has_next ? (const char*)g.A + (size_t)nxt.pm * tstep : cA; const char* nB = has_next ? (const char*)g.Bt + (size_t)nxt.pn * tstep : cB;
        for (int t = 0; t < nt; t += 2) {
            const bool last = (t == nt - 2);
            const char* a1 = cA + (size_t)(t + 1) * kstep;
            const char* a2 = last ? nA : cA + (size_t)(t + 2) * kstep; const char* b2 = last ? nB : cB + (size_t)(t + 2) * kstep;
            const char* a3 = a2 + kstep; const char* b3 = b2 + kstep;
            if (last && has_next) S.a_ready(nxt);
            PG8_LDB(B0, 0, 0); PG8_SCHED; PG8_LDA(At, 0, 0); PG8_STAGE(PG8_SA(1, 1), a1 + hstep, voffA);
            PG8_WAIT_L(8); PG8_BAR; PG8_WAIT_L(0); PG8_MMA(0, 0, At, B0); PG8_BAR; PG8_SCHED;
            PG8_LDB(B1, 0, 1); PG8_STAGE(PG8_SB(0, 0), b2, voffB);
            PG8_BAR; PG8_WAIT_L(0); PG8_MMA(0, 1, At, B1); PG8_BAR;
            PG8_LDA(At, 0, 1); PG8_STAGE(PG8_SA(0, 0), a2, voffA);
            PG8_BAR; PG8_WAIT_L(0); PG8_MMA(1, 0, At, B0); PG8_BAR; PG8_SCHED;
            PG8_STAGE(PG8_SB(0, 1), b2 + hstep, voffB);
            PG8_WAIT_V(6); PG8_BAR; PG8_MMA(1, 1, At, B1); PG8_BAR;
            PG8_LDB(B0, 1, 0); PG8_SCHED; PG8_LDA(At, 1, 0); PG8_STAGE(PG8_SA(0, 1), a2 + hstep, voffA);
            PG8_WAIT_L(8); PG8_BAR; PG8_WAIT_L(0); PG8_MMA(0, 0, At, B0); PG8_BAR; PG8_SCHED;
            PG8_LDB(B1, 1, 1); PG8_STAGE(PG8_SB(1, 0), b3, voffB);
            PG8_BAR; PG8_WAIT_L(0); PG8_MMA(0, 1, At, B1); PG8_BAR;
            PG8_LDA(At, 1, 1); PG8_STAGE(PG8_SA(1, 0), a3, voffA);
            PG8_BAR; PG8_WAIT_L(0); PG8_MMA(1, 0, At, B0); PG8_BAR; PG8_SCHED;
            PG8_STAGE(PG8_SB(1, 1), b3 + hstep, voffB);
            PG8_WAIT_V(6); PG8_BAR; PG8_MMA(1, 1, At, B1); PG8_BAR;
        }
        PG8_STAMP();
        if constexpr (!Epi::AFTER_DRAIN) { E(acc, cur, wr, wc, fr, fq); S.done(cur); }
        PG8_STAMP();
        if (!has_next) break;
#pragma unroll
        for (int a = 0; a < 2; ++a)
#pragma unroll
            for (int b = 0; b < 2; ++b)
#pragma unroll
                for (int m = 0; m < 4; ++m)
#pragma unroll
                    for (int n = 0; n < 2; ++n) acc[a][b][m][n] = (f32x4){0.f, 0.f, 0.f, 0.f};
        cur = nxt; cA = nA; cB = nB; ++ui;
    }
    PG8_WAIT_V(0);
    if (wr == 0) PG8_BAR;
    PG8_BAR;
    if constexpr (Epi::AFTER_DRAIN) { E.fused(acc, cur, wr, wc, fr, fq, lds, wid, lane); S.done(cur); }
    PG8_STAMP();
    if (STAMP && wid == 0) { stamps[lane] = lane < nts ? (((unsigned long long)(unsigned)ts_hi << 32) | (unsigned)ts_lo) : 0ull;
        if (lane == 62) stamps[62] = rt_entry; if (lane == 63) stamps[63] = (unsigned long long)wall_clock64(); }
#undef PG8_STAMP
#undef PG8_SA
#undef PG8_SB
#undef PG8_STAGE
#undef PG8_LDA
#undef PG8_LDB
#undef PG8_MMA
#undef PG8_WAIT_V
#undef PG8_WAIT_L
#undef PG8_BAR
#undef PG8_SCHED
}
}

typedef unsigned short bf16_t;
typedef short bf16x8 __attribute__((ext_vector_type(8)));
typedef float f32x4 __attribute__((ext_vector_type(4)));
typedef unsigned u32x4 __attribute__((ext_vector_type(4)));
typedef unsigned u32x2 __attribute__((ext_vector_type(2)));
constexpr int NB = 12, SL = 8192, T = NB * SL, DM = 1024, NC = 3072, NPROMPT = 8 * SL;
constexpr int DH = 384, DC = 256, DR = 384;
constexpr int C_X0 = 512, C_X1 = 896, C_V = 1280, C_RG = 1664, C_GATE = 2048;
__host__ __device__ __forceinline__ int origcol(int n) {
    if (n < 128) return 1152 + n; if (n < 256) return 1408 + (n - 128); if (n < 384) return 1280 + (n - 256); if (n < 512) return 1536 + (n - 384);
    if (n < 896) return n - 512; if (n < 1280) return 384 + (n - 896); if (n < 1664) return 768 + (n - 1280); return n; }
constexpr int NFFT = 16384;
constexpr int LDS_BYTES = (NFFT + NFFT / 16) * 8;
constexpr float EPS = 1e-6f;
constexpr int NCHUNK = 16, CHUNK = 512;
constexpr int XCD_BAR_WORDS_C = 3456;

constexpr size_t WS_P = 0;
constexpr size_t WS_HY = WS_P + (size_t)T * NC * 2;
constexpr size_t WS_U = WS_HY + (size_t)T * DM * 2;
constexpr size_t WS_KF = WS_U + (size_t)NB * DH * SL * 2;
constexpr size_t WS_WINT = WS_KF + (size_t)DH * NFFT * 8;
constexpr size_t WS_WOUTT = WS_WINT + (size_t)2 * NC * DM * 2;
constexpr size_t WS_PWT = WS_WOUTT + (size_t)2 * DM * DM * 2;
constexpr size_t WS_RGWT = WS_PWT + (size_t)2 * DC * DC * 2;
constexpr size_t WS_AGG = WS_RGWT + (size_t)2 * 2 * 2 * 6 * 64 * 64 * 2;
constexpr size_t WS_BAR = WS_AGG + (size_t)NB * NCHUNK * 2 * 2 * DR * 4;
constexpr int RK_BASE = XCD_BAR_WORDS_C;
constexpr size_t CTL_BYTES = (size_t)(XCD_BAR_WORDS_C + 16 * 64) * 4;
constexpr size_t WS_GRAN = WS_BAR + CTL_BYTES;
constexpr size_t GRAN_BYTES = (size_t)2 * 64 * 144 * 64 * 8;
constexpr size_t WS_SS = WS_GRAN + GRAN_BYTES;
constexpr size_t WS_END = WS_SS + (size_t)3 * T * 4;

struct Params {
    const float* in[31];
    float* out;
    unsigned char* ws;
    int ph_lo, ph_hi;
};
enum { I_XP = 0, I_XS, I_NORMG, I_WIN, I_HCW, I_HCB, I_HW1, I_HB1, I_HW2, I_HB2, I_HW3, I_HB3, I_HW4, I_HFREQ, I_HD, I_CDW, I_CDB, I_CLG, I_CLB, I_CPW, I_CPB,
       I_RCW, I_RCB, I_RWA, I_RBA, I_RWX, I_RBX, I_RLAM, I_GRPG, I_WOUT, I_FING };

__device__ __forceinline__ float bf2f(bf16_t b) { return __uint_as_float(((unsigned)b) << 16); }
__device__ __forceinline__ unsigned pk2(float lo, float hi) { unsigned r; asm("v_cvt_pk_bf16_f32 %0, %1, %2" : "=v"(r) : "v"(lo), "v"(hi)); return r; }
__device__ __forceinline__ bf16_t f2bf(float f) { return (bf16_t)(pk2(f, f) & 0xffffu); }
__device__ __forceinline__ float wave_sum(float v) {
#pragma unroll
    for (int o = 32; o >= 1; o >>= 1) v += __shfl_xor(v, o);
    return v;
}
template <int N>
__device__ __forceinline__ void wave_sum_n(float (&v)[N]) {
#pragma unroll
    for (int o = 32; o >= 1; o >>= 1) {
#pragma unroll
        for (int i = 0; i < N; ++i) v[i] += __shfl_xor(v[i], o); }
}
__device__ __forceinline__ void lds_barrier() { asm volatile("s_waitcnt lgkmcnt(0)" ::: "memory"); __builtin_amdgcn_s_barrier(); asm volatile("" ::: "memory"); }
__device__ __forceinline__ int launder_tid() { int t = threadIdx.x; asm volatile("" : "+v"(t)); return t; }
__device__ __forceinline__ float sigmoidf_(float x) { return __builtin_amdgcn_rcpf(1.0f + __builtin_amdgcn_exp2f(-1.4426950408889634f * x)); }
__device__ __forceinline__ float siluf_(float x) { return x * sigmoidf_(x); }
struct __attribute__((packed, aligned(4))) U3 { unsigned x, y, z; };

__device__ __forceinline__ void transpose_tile(const float* src, int src_ld, bf16_t* dst, int dst_ld, int k0, int n0, float* tile  , const float* kscale = nullptr, int n0src = -1) {
    if (n0src < 0) n0src = n0;
    const int tid = threadIdx.x, lo = tid & 63, hi = tid >> 6;
#pragma unroll
    for (int i = 0; i < 8; ++i) { const int kk = i * 8 + hi; tile[kk * 65 + lo] = src[(size_t)(k0 + kk) * src_ld + n0src + lo] * (kscale ? kscale[k0 + kk] : 1.0f); }
    __syncthreads();
#pragma unroll
    for (int i = 0; i < 8; ++i) { const int nn = i * 8 + hi; dst[(size_t)(n0 + nn) * dst_ld + k0 + lo] = f2bf(tile[lo * 65 + nn]); }
    __syncthreads();
}
__device__ __forceinline__ void phase_prep_weights(const Params& p, unsigned char* lds) {
    float* tile = (float*)lds;
    { u32x4* g = (u32x4*)(p.ws + WS_GRAN); const u32x4 z = {0u, 0u, 0u, 0u};
      for (size_t i = (size_t)blockIdx.x * 512 + threadIdx.x; i < GRAN_BYTES / 16; i += (size_t)gridDim.x * 512) g[i] = z; }
    constexpr int N_WIN = 16 * 48, N_WOUT = 16 * 16, N_PW = 16, N_RG = 24;
    constexpr int PER_LAYER = N_WIN + N_WOUT + N_PW + 2 * N_RG;
    for (int it = blockIdx.x; it < 2 * PER_LAYER; it += gridDim.x) {
        const int l = it / PER_LAYER; int r = it % PER_LAYER;
        if (r < N_WIN) { transpose_tile(p.in[I_WIN] + (size_t)l * DM * NC, NC, (bf16_t*)(p.ws + WS_WINT) + (size_t)l * NC * DM, DM, (r / 48) * 64, (r % 48) * 64, tile, p.in[I_NORMG] + l * DM, origcol((r % 48) * 64)); continue; }
        r -= N_WIN;
        if (r < N_WOUT) { transpose_tile(p.in[I_WOUT] + (size_t)l * DM * DM, DM, (bf16_t*)(p.ws + WS_WOUTT) + (size_t)l * DM * DM, DM, (r / 16) * 64, (r % 16) * 64, tile); continue; }
        r -= N_WOUT;
        if (r < N_PW) { transpose_tile(p.in[I_CPW] + (size_t)l * DC * DC, DC, (bf16_t*)(p.ws + WS_PWT) + (size_t)l * DC * DC, DC, (r / 4) * 64, (r % 4) * 64, tile); continue; }
        r -= N_PW;
        const int gate = r / N_RG, dh = r % N_RG, dir = dh / 6, h = dh % 6;
        const float* src = p.in[gate ? I_RWX : I_RWA] + ((size_t)(l * 2 + dir) * 6 + h) * 4096;
        bf16_t* dst = (bf16_t*)(p.ws + WS_RGWT) + ((size_t)((l * 2 + dir) * 2 + gate) * 6 + h) * 4096;
        transpose_tile(src, 64, dst, 64, 0, 0, tile);
    }
}

__device__ __forceinline__ void phase_x0_prep(const float* xa, const float* xb, bf16_t* H, float* ss) {
    const int lane = threadIdx.x & 63, wave = threadIdx.x >> 6;
    for (int i = blockIdx.x * 512 + threadIdx.x; i < 2 * T; i += gridDim.x * 512) ss[T + i] = 0.f;
    const int NW = gridDim.x * 8;
    for (int row0 = blockIdx.x * 8 + wave; row0 < T; row0 += 4 * NW) {
        f32x4 v[4][4];
#pragma unroll
        for (int r = 0; r < 4; ++r) { const int row = row0 + r * NW;
            if (row < T) { const float* xr = (row < NPROMPT) ? xa + (size_t)row * DM : xb + (size_t)(row - NPROMPT) * DM;
#pragma unroll
                for (int j = 0; j < 4; ++j) v[r][j] = *(const f32x4*)(xr + lane * 4 + 256 * j); } }
#pragma unroll
        for (int r = 0; r < 4; ++r) { const int row = row0 + r * NW;
            if (row < T) { float s2 = 0.f;
#pragma unroll
                for (int j = 0; j < 4; ++j) { s2 += v[r][j].x * v[r][j].x + v[r][j].y * v[r][j].y + v[r][j].z * v[r][j].z + v[r][j].w * v[r][j].w;
                    u32x2 w; w.x = pk2(v[r][j].x, v[r][j].y); w.y = pk2(v[r][j].z, v[r][j].w); *(u32x2*)(H + (size_t)row * DM + lane * 4 + 256 * j) = w; }
                s2 = wave_sum(s2); if (lane == 0) ss[row] = s2; } }
    }
}
__device__ __forceinline__ void phase_final_norm(const bf16_t* x2, const float* ss, const float* g, float* out) {
    const int lane = threadIdx.x & 63, wave = threadIdx.x >> 6;
    f32x4 gv[4];
#pragma unroll
    for (int j = 0; j < 4; ++j) gv[j] = *(const f32x4*)(g + lane * 4 + 256 * j);
    const int NW = gridDim.x * 8;
    for (int row0 = blockIdx.x * 8 + wave; row0 < T; row0 += 4 * NW) {
        u32x2 v[4][4]; float rs[4];
#pragma unroll
        for (int r = 0; r < 4; ++r) { const int row = row0 + r * NW; rs[r] = 0.f;
            if (row < T) { rs[r] = rsqrtf(ss[row] * (1.0f / DM) + EPS);
#pragma unroll
                for (int j = 0; j < 4; ++j) v[r][j] = *(const u32x2*)(x2 + (size_t)row * DM + lane * 4 + 256 * j); } }
#pragma unroll
        for (int r = 0; r < 4; ++r) { const int row = row0 + r * NW;
            if (row < T) {
#pragma unroll
                for (int j = 0; j < 4; ++j) { f32x4 x; x.x = __uint_as_float(v[r][j].x << 16); x.y = __uint_as_float(v[r][j].x & 0xffff0000u); x.z = __uint_as_float(v[r][j].y << 16); x.w = __uint_as_float(v[r][j].y & 0xffff0000u);
                    *(f32x4*)(out + (size_t)row * DM + lane * 4 + 256 * j) = x * rs[r] * gv[j]; } } }
    }
}

__device__ __forceinline__ void phase_filters(const Params& p, int l, unsigned char* lds) {
    float* Z = (float*)lds;
    float* H1 = Z + 32 * 33;
    float* H2 = H1 + 32 * 65;
    float* OT = H2 + 32 * 65;
    const float* w1 = p.in[I_HW1] + (size_t)l * 33 * 64; const float* b1 = p.in[I_HB1] + l * 64;
    const float* w2 = p.in[I_HW2] + (size_t)l * 64 * 64; const float* b2 = p.in[I_HB2] + l * 64;
    const float* w3 = p.in[I_HW3] + (size_t)l * 64 * 64; const float* b3 = p.in[I_HB3] + l * 64;
    const float* w4 = p.in[I_HW4] + (size_t)l * 64 * 768; const float* fr = p.in[I_HFREQ] + l * 64;
    float2* KF = (float2*)(p.ws + WS_KF);
    for (int it = blockIdx.x; it < SL / 32; it += gridDim.x) {
        const int t0 = it * 32; const int tid = launder_tid();
        for (int idx = tid; idx < 32 * 33; idx += 512) {
            const int tl = idx / 33, f = idx % 33; const float t = (float)(t0 + tl);
            float z;
            if (f == 0) z = t / (float)(SL - 1);
            else { const int j = (f - 1) & 15; const float fj = 1e-4f + (float)j * ((15.0f - 1e-4f) / 15.0f); const float ang = 2.0f * fj * t * (1.0f / SL);
                   z = (f <= 16) ? cospif(ang) : -sinpif(ang); }
            Z[tl * 33 + f] = z;
        }
        __syncthreads();
        { const int o = tid & 63; const float frq = fr[o], bb = b1[o];
#pragma unroll
          for (int i = 0; i < 4; ++i) { const int tl = (tid >> 6) + 8 * i; float a = bb;
_Pragma("unroll 3") for (int f = 0; f < 33; ++f) a += Z[tl * 33 + f] * w1[f * 64 + o]; H1[tl * 65 + o] = sinf(frq * a); } }
        __syncthreads();
        { const int o = tid & 63; const float frq = fr[o], bb = b2[o];
#pragma unroll
          for (int i = 0; i < 4; ++i) { const int tl = (tid >> 6) + 8 * i; float a = bb;
_Pragma("unroll 4") for (int f = 0; f < 64; ++f) a += H1[tl * 65 + f] * w2[f * 64 + o]; H2[tl * 65 + o] = sinf(frq * a); } }
        __syncthreads();
        { const int o = tid & 63; const float frq = fr[o], bb = b3[o];
#pragma unroll
          for (int i = 0; i < 4; ++i) { const int tl = (tid >> 6) + 8 * i; float a = bb;
_Pragma("unroll 4") for (int f = 0; f < 64; ++f) a += H2[tl * 65 + f] * w3[f * 64 + o]; H1[tl * 65 + o] = sinf(frq * a); } }
        __syncthreads();
#pragma unroll 1
        for (int cr = tid; cr < 2 * 768; cr += 512) {
            const int c = cr % 768, rnd = cr / 768;
            float acc[16];
#pragma unroll
            for (int tl = 0; tl < 16; ++tl) acc[tl] = 0.f;
#pragma unroll 2
            for (int k = 0; k < 64; ++k) { const float w = w4[k * 768 + c];
#pragma unroll
                for (int tl = 0; tl < 16; ++tl) acc[tl] += H1[(rnd * 16 + tl) * 65 + k] * w; }
#pragma unroll
            for (int tl = 0; tl < 16; ++tl) OT[c * 33 + rnd * 16 + tl] = acc[tl];
        }
        __syncthreads();
        for (int idx = tid; idx < 768 * 32; idx += 512) {
            const int c768 = idx >> 5, tl = idx & 31, t = t0 + tl, c = c768 % DH;
            const float minD = -3.0701134573253944f, maxD = -15.350567286626972f;
            const float delta = fabsf(minD + (maxD - minD) * ((float)c / (float)(DH - 1)));
            const float val = OT[c768 * 33 + tl] * __expf(-((float)t / (float)(SL - 1)) * delta) * (1.0f / NFFT);
            if (c768 < DH) KF[(size_t)c * NFFT + t] = make_float2(val, 0.f);
            else if (t > 0) KF[(size_t)c * NFFT + (NFFT - t)] = make_float2(val, 0.f);
            else KF[(size_t)c * NFFT + SL] = make_float2(0.f, 0.f);
        }
        __syncthreads();
    }
}

__device__ __forceinline__ int PH(int i) { return i + (i >> 4); }
__device__ __forceinline__ float2 opq(float2 v) { asm("" : "+v"(v.x), "+v"(v.y)); return v; }
__device__ __forceinline__ float2 cmul(float2 a, float2 b) { return make_float2(a.x * b.x - a.y * b.y, a.x * b.y + a.y * b.x); }
__device__ __forceinline__ float2 tw16(int m, bool inv) {
    const float cs[8] = {1.0f, 0.92387953251128674f, 0.70710678118654752f, 0.38268343236508977f, 0.0f, -0.38268343236508977f, -0.70710678118654752f, -0.92387953251128674f};
    const float sn[8] = {0.0f, 0.38268343236508977f, 0.70710678118654752f, 0.92387953251128674f, 1.0f, 0.92387953251128674f, 0.70710678118654752f, 0.38268343236508977f};
    return make_float2(cs[m], inv ? sn[m] : -sn[m]);
}
template <int LR, bool INV, bool ZEROJ>
__device__ __forceinline__ void bfly(float2 (&x)[1 << LR], float ang0) {
    constexpr int R = 1 << LR;
    float2 w[LR];
    if (!ZEROJ) {
        const float s0 = __builtin_amdgcn_sinf(ang0), c0 = __builtin_amdgcn_cosf(ang0);
        w[0] = make_float2(c0, INV ? s0 : -s0);
#pragma unroll
        for (int t = 1; t < LR; ++t) w[t] = cmul(w[t - 1], w[t - 1]);
    }
#pragma unroll
    for (int tt = 0; tt < LR; ++tt) {
        const int t = INV ? (LR - 1 - tt) : tt;
        const int half = R >> (t + 1);
#pragma unroll
        for (int q = 0; q < R; ++q) {
            if (q & half) continue;
            const int ql = q & (half - 1);
            const int m = (ql << t) * (16 / R);
            float2 tw;
            if (ZEROJ) tw = tw16(m, INV);
            else if (m == 0) tw = w[t];
            else tw = cmul(w[t], tw16(m, INV));
            const bool triv = ZEROJ && (m == 0);
            if (!INV) {
                const float2 a = x[q], b = x[q + half];
                x[q] = make_float2(a.x + b.x, a.y + b.y);
                const float2 d = make_float2(a.x - b.x, a.y - b.y);
                x[q + half] = triv ? d : cmul(d, tw);
            } else {
                const float2 a = x[q]; const float2 b = triv ? x[q + half] : cmul(x[q + half], tw);
                x[q] = make_float2(a.x + b.x, a.y + b.y);
                x[q + half] = make_float2(a.x - b.x, a.y - b.y);
            }
        }
    }
}
template <int LR, bool INV>
__device__ __forceinline__ void fft_pass(float2* X, int Blog) {
    constexpr int R = 1 << LR;
    const int Slog = Blog - LR;
    const int tid0 = launder_tid();
#pragma unroll 1
    for (int id = tid0; id < (NFFT >> LR); id += 512) {
        const int blk = id >> Slog, j = id & ((1 << Slog) - 1);
        const int base = (blk << Blog) + j;
        float2 x[R];
#pragma unroll
        for (int q = 0; q < R; ++q) x[q] = X[PH(base + (q << Slog))];
        bfly<LR, INV, false>(x, (float)j * (1.0f / (float)(1 << Blog)));
#pragma unroll
        for (int q = 0; q < R; ++q) X[PH(base + (q << Slog))] = opq(x[q]);
    }
    lds_barrier();
}
template <bool CONV>
__device__ __forceinline__ void fft_mid(float2* X, const float2* kf, float2* gout, bool do_store) {
    const int tid0 = launder_tid();
#pragma unroll 1
    for (int id = tid0; id < (NFFT >> 4); id += 512) {
        float2 x[16];
#pragma unroll
        for (int q = 0; q < 16; ++q) x[q] = X[17 * id + q];
        bfly<4, false, true>(x, 0.f);
        if (CONV) {
#pragma unroll
            for (int q = 0; q < 16; ++q) { const float2 k1 = kf[q * 1024 + id]; x[q] = cmul(x[q], k1); }
            bfly<4, true, true>(x, 0.f);
#pragma unroll
            for (int q = 0; q < 16; ++q) X[17 * id + q] = opq(x[q]);
        } else if (do_store) {
#pragma unroll
            for (int q = 0; q < 16; ++q) gout[q * 1024 + id] = opq(x[q]);
        }
    }
    lds_barrier();
}
__device__ __forceinline__ void phase_kf_fft(const Params& p, unsigned char* lds, bool do_store = true) {
    float2* X = (float2*)lds; float2* KF = (float2*)(p.ws + WS_KF);
    for (int c = blockIdx.x; c < DH; c += gridDim.x) {
        float2* kc = KF + (size_t)c * NFFT;
        const int tid0 = launder_tid();
#pragma unroll 1
        for (int id = tid0; id < 4096; id += 512) {
            float2 x[4];
#pragma unroll
            for (int q = 0; q < 4; ++q) x[q] = kc[id + q * 4096];
            bfly<2, false, false>(x, (float)id * (1.0f / 16384.0f));
#pragma unroll
            for (int q = 0; q < 4; ++q) X[PH(id + q * 4096)] = opq(x[q]);
        }
        lds_barrier();
        fft_pass<4, false>(X, 12); fft_pass<4, false>(X, 8); fft_mid<false>(X, nullptr, kc, do_store);
    }
}
__device__ __forceinline__ void phase_fftconv(const Params& p, int l, unsigned char* lds, bool do_store = true) {
    float2* X = (float2*)lds; const float2* KF = (const float2*)(p.ws + WS_KF); bf16_t* U = (bf16_t*)(p.ws + WS_U);
    const float* dsk = p.in[I_HD] + l * DH;
    for (int it = blockIdx.x; it < DH * (NB / 2); it += gridDim.x) {
        const int xq = it & 7, xr = it >> 3, c = xq * (DH / 8) + xr / (NB / 2), pr = xr % (NB / 2);
        unsigned* u1 = (unsigned*)(U + ((size_t)(2 * pr) * DH + c) * SL); unsigned* u2 = (unsigned*)(U + ((size_t)(2 * pr + 1) * DH + c) * SL);
        const int tid0 = launder_tid();
#pragma unroll 1
        for (int i = 0; i < 4; ++i) { const int k = tid0 + 512 * i;
            const unsigned a0 = u1[k], a1 = u1[k + 2048], b0 = u2[k], b1 = u2[k + 2048];
#pragma unroll
            for (int e = 0; e < 2; ++e) { const int id = 2 * k + e;
                float2 x[4];
                x[0] = make_float2(e ? __uint_as_float(a0 & 0xffff0000u) : __uint_as_float(a0 << 16), e ? __uint_as_float(b0 & 0xffff0000u) : __uint_as_float(b0 << 16));
                x[1] = make_float2(e ? __uint_as_float(a1 & 0xffff0000u) : __uint_as_float(a1 << 16), e ? __uint_as_float(b1 & 0xffff0000u) : __uint_as_float(b1 << 16));
                x[2] = make_float2(0.f, 0.f); x[3] = make_float2(0.f, 0.f);
                bfly<2, false, false>(x, (float)id * (1.0f / 16384.0f));
#pragma unroll
                for (int q = 0; q < 4; ++q) X[PH(id + q * 4096)] = opq(x[q]); } }
        lds_barrier();
        fft_pass<4, false>(X, 12); fft_pass<4, false>(X, 8);
        fft_mid<true>(X, KF + (size_t)c * NFFT, nullptr, false);
        fft_pass<4, true>(X, 8); fft_pass<4, true>(X, 12);
        const float d = dsk[c];
#pragma unroll 1
        for (int i = 0; i < 4; ++i) { const int k = tid0 + 512 * i;
            const unsigned a0 = u1[k], a1 = u1[k + 2048], b0 = u2[k], b1 = u2[k + 2048];
            float2 y0[2], y1[2];
#pragma unroll
            for (int e = 0; e < 2; ++e) { const int id = 2 * k + e;
                float2 x[4];
#pragma unroll
                for (int q = 0; q < 4; ++q) x[q] = X[PH(id + q * 4096)];
                bfly<2, true, false>(x, (float)id * (1.0f / 16384.0f));
                y0[e] = opq(x[0]); y1[e] = opq(x[1]); }
            if (do_store) {
                u1[k] = pk2(y0[0].x + d * __uint_as_float(a0 << 16), y0[1].x + d * __uint_as_float(a0 & 0xffff0000u));
                u1[k + 2048] = pk2(y1[0].x + d * __uint_as_float(a1 << 16), y1[1].x + d * __uint_as_float(a1 & 0xffff0000u));
                u2[k] = pk2(y0[0].y + d * __uint_as_float(b0 << 16), y0[1].y + d * __uint_as_float(b0 & 0xffff0000u));
                u2[k + 2048] = pk2(y1[0].y + d * __uint_as_float(b1 << 16), y1[1].y + d * __uint_as_float(b1 & 0xffff0000u)); } }
        lds_barrier();
    }
}

__device__ __forceinline__ void phase_hyena_prep(const Params& p, int l, unsigned char* lds) {
    bf16_t* RAW = (bf16_t*)lds;
    float* tile = (float*)(lds + 2 * 130 * 64 * 2);
    const bf16_t* P = (const bf16_t*)(p.ws + WS_P); bf16_t* U = (bf16_t*)(p.ws + WS_U);
    const float* cw = p.in[I_HCW] + (size_t)l * 3 * 1152; const float* cb = p.in[I_HCB] + l * 1152;
    u32x4 pf[5];
#define HP_PREFETCH(IT) do { const int _cg = (IT) % 6, _tt = ((IT) / 6) % 64, _b = (IT) / 384, _t0 = _tt * 128; const bf16_t* _pb = P + (size_t)_b * SL * NC; const int _tid = threadIdx.x; \
        _Pragma("unroll") for (int k = 0; k < 5; ++k) { const int idx = _tid + 512 * k, arr = idx / 1040, rem = idx % 1040, r = rem >> 3, sg = rem & 7, t = _t0 - 1 + r; pf[k] = (u32x4){0u, 0u, 0u, 0u}; \
            if (idx < 2080 && t >= 0 && t < SL) pf[k] = *(const u32x4*)(_pb + (size_t)t * NC + (arr ? C_V : C_X1) + _cg * 64 + sg * 8); } } while (0)
    if ((int)blockIdx.x < NB * 64 * 6) { HP_PREFETCH((int)blockIdx.x);
#pragma unroll
        for (int k = 0; k < 5; ++k) { const int idx = (int)threadIdx.x + 512 * k;
            if (idx < 2080) { const int arr = idx / 1040, rem = idx % 1040, r = rem >> 3, sg = rem & 7; *(u32x4*)(RAW + (arr * 130 + r) * 64 + sg * 8) = pf[k]; } } }
    lds_barrier();
    for (int it = blockIdx.x; it < NB * 64 * 6; it += gridDim.x) {
        const int tid = launder_tid(), cc = tid & 63, tq = tid >> 6;
        const int cgp = it % 6, tt = (it / 6) % 64, b = it / 384;
        const int c = cgp * 64 + cc, t0 = tt * 128;
        const float wx0 = cw[384 + c], wx1 = cw[1152 + 384 + c], wx2 = cw[2304 + 384 + c], bx = cb[384 + c];
        const float wv0 = cw[768 + c], wv1 = cw[1152 + 768 + c], wv2 = cw[2304 + 768 + c], bv = cb[768 + c];
        const bool has_next = it + (int)gridDim.x < NB * 64 * 6;
        if (has_next) HP_PREFETCH(it + (int)gridDim.x);
        { const bf16_t* rx = RAW + (tq * 16) * 64 + cc; const bf16_t* rv = rx + 130 * 64;
          float xm = bf2f(rx[0]), x0 = bf2f(rx[64]), vm = bf2f(rv[0]), v0 = bf2f(rv[64]);
#pragma unroll
          for (int i = 0; i < 16; ++i) {
              const float xp = bf2f(rx[(i + 2) * 64]), vp = bf2f(rv[(i + 2) * 64]);
              const float cx = wx0 * xm + wx1 * x0 + wx2 * xp + bx, cv = wv0 * vm + wv1 * v0 + wv2 * vp + bv;
              tile[cc * 129 + tq * 16 + i] = cx * cv;
              xm = x0; x0 = xp; vm = v0; v0 = vp; } }
        lds_barrier();
#pragma unroll
        for (int i = 0; i < 8; ++i) { const int idx = tid + 512 * i, c2 = idx >> 6, tl = (idx & 63) * 2;
            *(unsigned*)(U + ((size_t)b * DH + cgp * 64 + c2) * SL + t0 + tl) = pk2(tile[c2 * 129 + tl], tile[c2 * 129 + tl + 1]); }
        if (has_next) {
#pragma unroll
            for (int k = 0; k < 5; ++k) { const int idx = tid + 512 * k;
                if (idx < 2080) { const int arr = idx / 1040, rem = idx % 1040, r = rem >> 3, sg = rem & 7; *(u32x4*)(RAW + (arr * 130 + r) * 64 + sg * 8) = pf[k]; } } }
        lds_barrier();
    }
#undef HP_PREFETCH
}

__device__ __forceinline__ void phase_conformer(const Params& p, int l, unsigned char* lds) {
    bf16_t* G = (bf16_t*)lds;
    bf16_t* A = (bf16_t*)lds;
    float* CV = (float*)(lds + 49152);
    const bf16_t* P = (const bf16_t*)(p.ws + WS_P); bf16_t* Y = (bf16_t*)(p.ws + WS_HY);
    const bf16_t* PwT = (const bf16_t*)(p.ws + WS_PWT) + (size_t)l * DC * DC;
    const float* dww = p.in[I_CDW] + (size_t)l * 31 * DC; const float* dwb = p.in[I_CDB] + l * DC;
    const float* lng = p.in[I_CLG] + l * DC; const float* lnb = p.in[I_CLB] + l * DC; const float* pwb = p.in[I_CPB] + l * DC;
    const float* gg = p.in[I_GRPG] + l * DM + DH;
    float w[31];
#pragma unroll
    for (int k = 0; k < 31; ++k) w[k] = dww[k * DC + (threadIdx.x & 255)];
    const float bias = dwb[threadIdx.x & 255];
    u32x4 av[6];
#define CF_TILE(IT) ((((IT) & 7) * (NB * (SL / 64) / 8)) + ((IT) >> 3))
#define CF_PREFETCH(IT) do { const int _tile = CF_TILE(IT), _b = _tile / (SL / 64), _t0 = (_tile % (SL / 64)) * 64; const bf16_t* _pb = P + (size_t)_b * SL * NC; const int _tid = threadIdx.x; \
        _Pragma("unroll") for (int k = 0; k < 6; ++k) { const int idx = _tid + 512 * k, i = idx >> 5, c8 = (idx & 31) * 8, t = _t0 - 15 + i; \
            av[k] = (u32x4){0u, 0u, 0u, 0u}; \
            if (idx < 94 * 32 && t >= 0 && t < SL) av[k] = *(const u32x4*)(_pb + (size_t)t * NC + c8 + ((c8 >= 128) ? 128 : 0)); } } while (0)
    if ((int)blockIdx.x < NB * (SL / 64)) CF_PREFETCH((int)blockIdx.x);
    for (int it = blockIdx.x; it < NB * (SL / 64); it += gridDim.x) {
        const int tid = launder_tid(), lane = tid & 63, wave = tid >> 6, fr = lane & 15, fq = lane >> 4;
        const int tile = CF_TILE(it), b = tile / (SL / 64), t0 = (tile % (SL / 64)) * 64;
        const bf16_t* pb = P + (size_t)b * SL * NC;
#pragma unroll
        for (int k = 0; k < 6; ++k) { const int idx = tid + 512 * k, i = idx >> 5, c8 = (idx & 31) * 8;
            if (idx < 94 * 32) *(u32x4*)(G + i * 256 + c8) = av[k]; }
        lds_barrier();
        if (it + (int)gridDim.x < NB * (SL / 64)) CF_PREFETCH(it + (int)gridDim.x);
        { const int c = tid & 255, hf = tid >> 8;
#pragma unroll 1
          for (int rnd = 0; rnd < 2; ++rnd) {
              const int r0 = hf * 32 + rnd * 16;
              float acc[16];
#pragma unroll
              for (int o = 0; o < 16; ++o) acc[o] = bias;
#pragma unroll
              for (int r = 0; r < 46; ++r) { const float v = bf2f(G[(r0 + r) * 256 + c]);
#pragma unroll
                  for (int o = 0; o < 16; ++o) { if (r - o >= 0 && r - o < 31) acc[o] += w[r - o] * v; } }
#pragma unroll
              for (int o = 0; o < 16; ++o) CV[(r0 + o) * 256 + c] = acc[o];
          } }
        lds_barrier();
        { f32x4 v[8]; float s1[8], s2[8];
#pragma unroll
          for (int i = 0; i < 8; ++i) { v[i] = *(const f32x4*)(CV + (wave * 8 + i) * 256 + lane * 4); s1[i] = (v[i].x + v[i].y) + (v[i].z + v[i].w); }
          wave_sum_n<8>(s1);
#pragma unroll
          for (int i = 0; i < 8; ++i) { v[i] = v[i] - s1[i] * (1.0f / DC); s2[i] = (v[i].x * v[i].x + v[i].y * v[i].y) + (v[i].z * v[i].z + v[i].w * v[i].w); }
          wave_sum_n<8>(s2);
          const f32x4 gv = *(const f32x4*)(lng + lane * 4), bv = *(const f32x4*)(lnb + lane * 4);
#pragma unroll
          for (int i = 0; i < 8; ++i) { const float rstd = rsqrtf(s2[i] * (1.0f / DC) + EPS);
              const f32x4 y = v[i] * rstd * gv + bv;
              u32x2 w; w.x = pk2(siluf_(y.x), siluf_(y.y)); w.y = pk2(siluf_(y.z), siluf_(y.w));
              *(u32x2*)(A + (wave * 8 + i) * 264 + lane * 4) = w; } }
        lds_barrier();
        { f32x4 acc[4][2];
#pragma unroll
          for (int m = 0; m < 4; ++m) { acc[m][0] = (f32x4){0.f, 0.f, 0.f, 0.f}; acc[m][1] = (f32x4){0.f, 0.f, 0.f, 0.f}; }
          const int n0 = wave * 32;
#pragma unroll
          for (int ks = 0; ks < 8; ++ks) {
              bf16x8 bf[2], af[4];
#pragma unroll
              for (int n = 0; n < 2; ++n) bf[n] = *(const bf16x8*)(PwT + (size_t)(n0 + n * 16 + fr) * DC + ks * 32 + fq * 8);
#pragma unroll
              for (int m = 0; m < 4; ++m) af[m] = *(const bf16x8*)(A + (m * 16 + fr) * 264 + ks * 32 + fq * 8);
#pragma unroll
              for (int m = 0; m < 4; ++m)
#pragma unroll
                  for (int n = 0; n < 2; ++n) acc[m][n] = __builtin_amdgcn_mfma_f32_16x16x32_bf16(af[m], bf[n], acc[m][n], 0, 0, 0);
          }
#pragma unroll
          for (int n = 0; n < 2; ++n) { const int col = n0 + n * 16 + fr; const float bb = pwb[col];
#pragma unroll
              for (int m = 0; m < 4; ++m)
#pragma unroll
                  for (int j = 0; j < 4; ++j) CV[(m * 16 + fq * 4 + j) * 256 + col] = acc[m][n][j] + bb; } }
        lds_barrier();
        { f32x4 v[8]; float s2[8]; u32x2 gt[8];
#pragma unroll
          for (int i = 0; i < 8; ++i) { const int tl = wave * 8 + i; const size_t row = (size_t)b * SL + t0 + tl;
              gt[i] = *(const u32x2*)(P + row * NC + C_GATE + DH + lane * 4);
              v[i] = *(const f32x4*)(CV + tl * 256 + lane * 4); s2[i] = (v[i].x * v[i].x + v[i].y * v[i].y) + (v[i].z * v[i].z + v[i].w * v[i].w); }
          wave_sum_n<8>(s2);
          const f32x4 gv = *(const f32x4*)(gg + lane * 4);
#pragma unroll
          for (int i = 0; i < 8; ++i) { const int tl = wave * 8 + i; const size_t row = (size_t)b * SL + t0 + tl;
              const float rstd = rsqrtf(s2[i] * (1.0f / DC) + EPS);
              const float g0 = __uint_as_float(gt[i].x << 16), g1 = __uint_as_float(gt[i].x & 0xffff0000u), g2 = __uint_as_float(gt[i].y << 16), g3 = __uint_as_float(gt[i].y & 0xffff0000u);
              u32x2 w; w.x = pk2(v[i].x * rstd * gv.x * siluf_(g0), v[i].y * rstd * gv.y * siluf_(g1)); w.y = pk2(v[i].z * rstd * gv.z * siluf_(g2), v[i].w * rstd * gv.w * siluf_(g3));
              *(u32x2*)(Y + row * DM + DH + lane * 4) = w; } }
        lds_barrier();
    }
}

template <bool PASSB>
__device__ __forceinline__ void phase_rglru(const Params& p, int l, unsigned char* lds) {
    float* XRF = (float*)lds;
    bf16_t* XRB = (bf16_t*)(lds + 32768);
    float* AS = (float*)(lds + 32768 + 18432);
    float* BS = AS + 128 * 64;
    float* SEGA = BS + 128 * 64;
    float* SEGB = SEGA + 512;
    float* CARRY = SEGB + 512;
    bf16_t* RAWR = (bf16_t*)(CARRY + 64);
    bf16_t* P = (bf16_t*)(p.ws + WS_P); float* AGG = (float*)(p.ws + WS_AGG);
    const float* cw = p.in[I_RCW] + (size_t)l * 4 * DR; const float* cb = p.in[I_RCB] + l * DR;
    const int tid = threadIdx.x, lane = tid & 63, wave = tid >> 6, fr = lane & 15, fq = lane >> 4;
    const int cc = tid & 63, seg = tid >> 6;
    const int mh = wave >> 2, jq = wave & 3;
    for (int it = blockIdx.x; it < NB * 6 * NCHUNK * 2; it += gridDim.x) {
        const int dir = it & 1, ch = (it >> 1) % NCHUNK, h = ((it >> 1) / NCHUNK) % 6, b = (it >> 1) / (NCHUNK * 6);
        bf16_t* pb = P + (size_t)b * SL * NC;
        bf16x8 Ba[2], Bx[2];
        { const bf16_t* wa = (const bf16_t*)(p.ws + WS_RGWT) + ((size_t)((l * 2 + dir) * 2 + 0) * 6 + h) * 4096;
          const bf16_t* wx = (const bf16_t*)(p.ws + WS_RGWT) + ((size_t)((l * 2 + dir) * 2 + 1) * 6 + h) * 4096;
#pragma unroll
          for (int ks = 0; ks < 2; ++ks) { Ba[ks] = *(const bf16x8*)(wa + (jq * 16 + fr) * 64 + ks * 32 + fq * 8); Bx[ks] = *(const bf16x8*)(wx + (jq * 16 + fr) * 64 + ks * 32 + fq * 8); } }
        const int gch = h * 64 + jq * 16 + fr;
        const float bga = p.in[I_RBA][(l * 2 + dir) * DR + gch], bgx = p.in[I_RBX][(l * 2 + dir) * DR + gch];
        const float lam = p.in[I_RLAM][(l * 2 + dir) * DR + gch];
        const float sp8l2 = 8.0f * 1.4426950408889634f * log1pf(__expf(-lam));
        const int c = h * 64 + cc;
        const float w0 = cw[c], w1 = cw[DR + c], w2 = cw[2 * DR + c], w3 = cw[3 * DR + c], cbias = cb[c];
        if (tid < 64) {
            float cin = 0.f;
            if (PASSB) {
                if (dir == 0) { for (int j = 0; j < ch; ++j) { const float* ag = AGG + ((size_t)((b * NCHUNK + j) * 2 + 0) * 2) * DR + c; cin = ag[0] * cin + ag[DR]; } }
                else { for (int j = NCHUNK - 1; j > ch; --j) { const float* ag = AGG + ((size_t)((b * NCHUNK + j) * 2 + 1) * 2) * DR + c; cin = ag[0] * cin + ag[DR]; } }
            }
            CARRY[tid] = cin;
        }
        float totA = 1.f;
        for (int s = 0; s < 4; ++s) {
            const int st = dir ? 3 - s : s, t0 = ch * CHUNK + st * 128;
#pragma unroll
            for (int k = 0; k < 3; ++k) { const int idx = tid + 512 * k;
                if (idx < 1048) { const int r = idx >> 3, sg = idx & 7, t = t0 - 2 + r;
                    u32x4 v = {0u, 0u, 0u, 0u};
                    if (t >= 0 && t < SL) v = *(const u32x4*)(pb + (size_t)t * NC + C_RG + h * 64 + sg * 8);
                    *(u32x4*)(RAWR + r * 64 + sg * 8) = v; } }
            __syncthreads();
            { const bf16_t* rr = RAWR + (seg * 16) * 64 + cc;
              float pm2 = bf2f(rr[0]), pm1 = bf2f(rr[64]), p0 = bf2f(rr[128]);
#pragma unroll
              for (int i = 0; i < 16; ++i) {
                  const float pp = bf2f(rr[(i + 3) * 64]);
                  const float xr = w0 * pm2 + w1 * pm1 + w2 * p0 + w3 * pp + cbias;
                  const int tl = seg * 16 + i, si = dir ? 127 - tl : tl;
                  XRF[si * 64 + cc] = xr; XRB[si * 72 + cc] = f2bf(xr);
                  pm2 = pm1; pm1 = p0; p0 = pp; } }
            __syncthreads();
#pragma unroll
            for (int m = 0; m < 4; ++m) {
                f32x4 ga = {0.f, 0.f, 0.f, 0.f}, gx = {0.f, 0.f, 0.f, 0.f};
#pragma unroll
                for (int ks = 0; ks < 2; ++ks) { const bf16x8 af = *(const bf16x8*)(XRB + (mh * 64 + m * 16 + fr) * 72 + ks * 32 + fq * 8);
                    ga = __builtin_amdgcn_mfma_f32_16x16x32_bf16(af, Ba[ks], ga, 0, 0, 0); gx = __builtin_amdgcn_mfma_f32_16x16x32_bf16(af, Bx[ks], gx, 0, 0, 0); }
#pragma unroll
                for (int j = 0; j < 4; ++j) { const int si = mh * 64 + m * 16 + fq * 4 + j, col = jq * 16 + fr;
                    const float r = sigmoidf_(ga[j] + bga), ig = sigmoidf_(gx[j] + bgx);
                    const float la2 = -sp8l2 * r; const float a = __builtin_amdgcn_exp2f(la2); const float mult = __builtin_amdgcn_sqrtf(fmaxf(1.0f - a * a, 0.f));
                    AS[si * 64 + col] = a; BS[si * 64 + col] = mult * ig * XRF[si * 64 + col]; }
            }
            __syncthreads();
            float hl[16], ca[16];
            { float hh = 0.f, cum = 1.f;
#pragma unroll
              for (int i = 0; i < 16; ++i) { const float a = AS[(seg * 16 + i) * 64 + cc], bb = BS[(seg * 16 + i) * 64 + cc]; hh = a * hh + bb; cum *= a; hl[i] = hh; ca[i] = cum; }
              SEGA[seg * 64 + cc] = cum; SEGB[seg * 64 + cc] = hh; }
            __syncthreads();
            float cin = CARRY[cc];
            for (int q = 0; q < seg; ++q) cin = SEGA[q * 64 + cc] * cin + SEGB[q * 64 + cc];
            if (PASSB) {
                bf16_t* dst = pb + (dir ? C_V : C_X1) + c;
#pragma unroll
                for (int i = 0; i < 16; ++i) { const int si = seg * 16 + i, tl = dir ? 127 - si : si; dst[(size_t)(t0 + tl) * NC] = f2bf(hl[i] + ca[i] * cin); }
            }
            float ncar = 0.f, prodA = 1.f;
            if (seg == 7) { ncar = hl[15] + ca[15] * cin;
#pragma unroll
                for (int q = 0; q < 8; ++q) prodA *= SEGA[q * 64 + cc]; }
            __syncthreads();
            if (seg == 7) { CARRY[cc] = ncar; totA *= prodA; }
        }
        __syncthreads();
        if (!PASSB && seg == 7) { float* ag = AGG + ((size_t)((b * NCHUNK + ch) * 2 + dir) * 2) * DR + c; ag[0] = totA; ag[DR] = CARRY[cc]; }
        __syncthreads();
    }
}

constexpr int NSUB = SL / 128, NSEQ = NB * 6 * 2;
__device__ __forceinline__ void phase_rglru_chain(const Params& p, int l, unsigned char* lds) {
    float* XRF = (float*)lds;
    bf16_t* XRB = (bf16_t*)(lds + 32768);
    float* AS = (float*)(lds + 32768 + 18432);
    float* BS = AS + 128 * 64;
    float* SEGA = BS + 128 * 64;
    float* SEGB = SEGA + 512;
    float* CARRY = SEGB + 512;
    bf16_t* RAWR = (bf16_t*)(CARRY + 64);
    bf16_t* P = (bf16_t*)(p.ws + WS_P);
    unsigned long long* GR = (unsigned long long*)(p.ws + WS_GRAN) + (size_t)l * NSUB * NSEQ * 64;
    const float* cw = p.in[I_RCW] + (size_t)l * 4 * DR; const float* cb = p.in[I_RCB] + l * DR;
    u32x4 pf[3];
#define RG_PREFETCH(IT) do { const int _sub = (IT) / NSEQ, _sq = (IT) % NSEQ, _dir = _sq & 1, _h = (_sq >> 1) % 6, _b = (_sq >> 1) / 6; \
        const int _t0 = (_dir ? NSUB - 1 - _sub : _sub) * 128; const bf16_t* _pb = P + (size_t)_b * SL * NC; const int _tid = threadIdx.x; \
        _Pragma("unroll") for (int k = 0; k < 3; ++k) { const int idx = _tid + 512 * k, r = idx >> 3, sg = idx & 7, t = _t0 - 2 + r; pf[k] = (u32x4){0u, 0u, 0u, 0u}; \
            if (idx < 1048 && t >= 0 && t < SL) pf[k] = *(const u32x4*)(_pb + (size_t)t * NC + C_RG + _h * 64 + sg * 8); } } while (0)
    if ((int)blockIdx.x < NSUB * NSEQ) { RG_PREFETCH((int)blockIdx.x);
#pragma unroll
        for (int k = 0; k < 3; ++k) { const int idx = (int)threadIdx.x + 512 * k; if (idx < 1048) *(u32x4*)(RAWR + (idx >> 3) * 64 + (idx & 7) * 8) = pf[k]; } }
    lds_barrier();
    for (int it = blockIdx.x; it < NSUB * NSEQ; it += gridDim.x) {
        const int tid = launder_tid(), lane = tid & 63, wave = tid >> 6, fr = lane & 15, fq = lane >> 4;
        const int cc = tid & 63, seg = tid >> 6, mh = wave >> 2, jq = wave & 3;
        const int sub = it / NSEQ, sq = it % NSEQ, dir = sq & 1, h = (sq >> 1) % 6, b = (sq >> 1) / 6;
        const int st = dir ? NSUB - 1 - sub : sub, t0 = st * 128;
        bf16_t* pb = P + (size_t)b * SL * NC;
        unsigned long long gv0 = 0ull;
        if (wave == 0 && sub > 0) gv0 = __hip_atomic_load(GR + ((size_t)(sub - 1) * NSEQ + sq) * 64 + lane, __ATOMIC_RELAXED, __HIP_MEMORY_SCOPE_AGENT);
        bf16x8 Ba[2], Bx[2];
        { const bf16_t* wa = (const bf16_t*)(p.ws + WS_RGWT) + ((size_t)((l * 2 + dir) * 2 + 0) * 6 + h) * 4096;
          const bf16_t* wx = (const bf16_t*)(p.ws + WS_RGWT) + ((size_t)((l * 2 + dir) * 2 + 1) * 6 + h) * 4096;
#pragma unroll
          for (int ks = 0; ks < 2; ++ks) { Ba[ks] = *(const bf16x8*)(wa + (jq * 16 + fr) * 64 + ks * 32 + fq * 8); Bx[ks] = *(const bf16x8*)(wx + (jq * 16 + fr) * 64 + ks * 32 + fq * 8); } }
        const int gch = h * 64 + jq * 16 + fr;
        const float bga = p.in[I_RBA][(l * 2 + dir) * DR + gch], bgx = p.in[I_RBX][(l * 2 + dir) * DR + gch];
        const float lam = p.in[I_RLAM][(l * 2 + dir) * DR + gch];
        const float sp8l2 = 8.0f * 1.4426950408889634f * log1pf(__expf(-lam));
        const int c = h * 64 + cc;
        const float w0 = cw[c], w1 = cw[DR + c], w2 = cw[2 * DR + c], w3 = cw[3 * DR + c], cbias = cb[c];
        const bool has_next = it + (int)gridDim.x < NSUB * NSEQ;
        if (has_next) RG_PREFETCH(it + (int)gridDim.x);
        { const bf16_t* rr = RAWR + (seg * 16) * 64 + cc;
          float pm2 = bf2f(rr[0]), pm1 = bf2f(rr[64]), p0 = bf2f(rr[128]);
#pragma unroll
          for (int i = 0; i < 16; ++i) {
              const float pp = bf2f(rr[(i + 3) * 64]);
              const float xr = w0 * pm2 + w1 * pm1 + w2 * p0 + w3 * pp + cbias;
              const int tl = seg * 16 + i, si = dir ? 127 - tl : tl;
              XRF[si * 64 + cc] = xr; XRB[si * 72 + cc] = f2bf(xr);
              pm2 = pm1; pm1 = p0; p0 = pp; } }
        lds_barrier();
#pragma unroll
        for (int m = 0; m < 4; ++m) {
            f32x4 ga = {0.f, 0.f, 0.f, 0.f}, gx = {0.f, 0.f, 0.f, 0.f};
#pragma unroll
            for (int ks = 0; ks < 2; ++ks) { const bf16x8 af = *(const bf16x8*)(XRB + (mh * 64 + m * 16 + fr) * 72 + ks * 32 + fq * 8);
                ga = __builtin_amdgcn_mfma_f32_16x16x32_bf16(af, Ba[ks], ga, 0, 0, 0); gx = __builtin_amdgcn_mfma_f32_16x16x32_bf16(af, Bx[ks], gx, 0, 0, 0); }
#pragma unroll
            for (int j = 0; j < 4; ++j) { const int si = mh * 64 + m * 16 + fq * 4 + j, col = jq * 16 + fr;
                const float r = sigmoidf_(ga[j] + bga), ig = sigmoidf_(gx[j] + bgx);
                const float la2 = -sp8l2 * r; const float a = __builtin_amdgcn_exp2f(la2); const float mult = __builtin_amdgcn_sqrtf(fmaxf(1.0f - a * a, 0.f));
                AS[si * 64 + col] = a; BS[si * 64 + col] = mult * ig * XRF[si * 64 + col]; }
        }
        lds_barrier();
        float hl[16], ca[16];
        { float hh = 0.f, cum = 1.f;
#pragma unroll
          for (int i = 0; i < 16; ++i) { const float a = AS[(seg * 16 + i) * 64 + cc], bb = BS[(seg * 16 + i) * 64 + cc]; hh = a * hh + bb; cum *= a; hl[i] = hh; ca[i] = cum; }
          SEGA[seg * 64 + cc] = cum; SEGB[seg * 64 + cc] = hh; }
        if (wave == 0) {
            float cin = 0.f;
            if (sub > 0) {
                unsigned long long* g = GR + ((size_t)(sub - 1) * NSEQ + sq) * 64 + lane;
                unsigned long long v = gv0; unsigned sp = 0;
                while ((unsigned)(v >> 32) != 1u) { __builtin_amdgcn_s_sleep(1); if (++sp > (1u << 22)) break; v = __hip_atomic_load(g, __ATOMIC_RELAXED, __HIP_MEMORY_SCOPE_AGENT); }
                cin = __uint_as_float((unsigned)v);
            }
            CARRY[lane] = cin;
        }
        lds_barrier();
        float cin = CARRY[cc];
        for (int q = 0; q < seg; ++q) cin = SEGA[q * 64 + cc] * cin + SEGB[q * 64 + cc];
        if (seg == 7) {
            const float ncar = hl[15] + ca[15] * cin;
            __hip_atomic_store(GR + ((size_t)sub * NSEQ + sq) * 64 + cc, ((unsigned long long)1u << 32) | (unsigned long long)__float_as_uint(ncar), __ATOMIC_RELAXED, __HIP_MEMORY_SCOPE_AGENT);
        }
        { bf16_t* dst = pb + (dir ? C_V : C_X1) + c;
#pragma unroll
          for (int i = 0; i < 16; ++i) { const int si = seg * 16 + i, tl = dir ? 127 - si : si; dst[(size_t)(t0 + tl) * NC] = f2bf(hl[i] + ca[i] * cin); } }
        if (has_next) {
#pragma unroll
            for (int k = 0; k < 3; ++k) { const int idx = tid + 512 * k; if (idx < 1048) *(u32x4*)(RAWR + (idx >> 3) * 64 + (idx & 7) * 8) = pf[k]; } }
        lds_barrier();
    }
#undef RG_PREFETCH
}

__device__ __forceinline__ void unpack6(const U3 v, float (&o)[6]) {
    o[0] = __uint_as_float(v.x << 16); o[1] = __uint_as_float(v.x & 0xffff0000u); o[2] = __uint_as_float(v.y << 16); o[3] = __uint_as_float(v.y & 0xffff0000u);
    o[4] = __uint_as_float(v.z << 16); o[5] = __uint_as_float(v.z & 0xffff0000u);
}
__device__ __forceinline__ void phase_finalize(const Params& p, int l, unsigned char* lds) {
    float* UT = (float*)lds;
    const bf16_t* P = (const bf16_t*)(p.ws + WS_P); bf16_t* Y = (bf16_t*)(p.ws + WS_HY); const bf16_t* U = (const bf16_t*)(p.ws + WS_U);
    const float* cw = p.in[I_HCW] + (size_t)l * 3 * 1152; const float* cb = p.in[I_HCB] + l * 1152; const float* gg = p.in[I_GRPG] + l * DM;
    const int tid = threadIdx.x, lane = tid & 63, wave = tid >> 6;
    float w0[6], w1[6], w2[6], wb[6], ghy[6], grg[6];
#pragma unroll
    for (int q = 0; q < 6; ++q) { const int c = lane * 6 + q; w0[q] = cw[c]; w1[q] = cw[1152 + c]; w2[q] = cw[2304 + c]; wb[q] = cb[c]; ghy[q] = gg[c]; grg[q] = gg[640 + c]; }
    u32x4 pf[6];
#define FIN_PREFETCH(IT) do { const int _b = (IT) / (SL / 64), _t0 = ((IT) % (SL / 64)) * 64; \
        _Pragma("unroll") for (int k = 0; k < 6; ++k) { const int idx = tid + 512 * k, c = idx >> 3, t8 = (idx & 7) * 8; pf[k] = *(const u32x4*)(U + ((size_t)_b * DH + c) * SL + _t0 + t8); } } while (0)
    if ((int)blockIdx.x < NB * (SL / 64)) FIN_PREFETCH((int)blockIdx.x);
    for (int it = blockIdx.x; it < NB * (SL / 64); it += gridDim.x) {
        const int b = it / (SL / 64), t0 = (it % (SL / 64)) * 64;
#pragma unroll
        for (int k = 0; k < 6; ++k) { const int idx = tid + 512 * k, c = idx >> 3, t8 = (idx & 7) * 8;
            const u32x4 v = pf[k];
#pragma unroll
            for (int j = 0; j < 4; ++j) { UT[c * 65 + t8 + 2 * j] = __uint_as_float(v[j] << 16); UT[c * 65 + t8 + 2 * j + 1] = __uint_as_float(v[j] & 0xffff0000u); } }
        lds_barrier();
        if (it + (int)gridDim.x < NB * (SL / 64)) FIN_PREFETCH(it + (int)gridDim.x);
        const bf16_t* pb = P + (size_t)b * SL * NC;
#pragma unroll 4
        for (int i = 0; i < 8; ++i) { const int tl = wave * 8 + i, t = t0 + tl; const size_t row = (size_t)b * SL + t;
            const bf16_t* pq = pb + (size_t)t * NC + lane * 6; const bf16_t* pr = pq + C_X0;
            const int om = (t > 0) ? -NC : 0, op = (t + 1 < SL) ? NC : 0;
            const float fm = (t > 0) ? 1.f : 0.f, fp = (t + 1 < SL) ? 1.f : 0.f;
            const U3 rm = *(const U3*)(pr + om), rc = *(const U3*)pr, rp = *(const U3*)(pr + op), rg = *(const U3*)(pq + C_GATE);
            const U3 rf = *(const U3*)(pq + C_X1), rb = *(const U3*)(pq + C_V), rg2 = *(const U3*)(pq + C_GATE + 640);
            float xm[6], xc[6], xp[6], gt[6], y[6], ss = 0.f;
            unpack6(rm, xm); unpack6(rc, xc); unpack6(rp, xp); unpack6(rg, gt);
#pragma unroll
            for (int q = 0; q < 6; ++q) { const float x0 = w0[q] * (xm[q] * fm) + w1[q] * xc[q] + w2[q] * (xp[q] * fp) + wb[q];
                y[q] = UT[(lane * 6 + q) * 65 + tl] * x0; ss += y[q] * y[q]; }
            float rstd = rsqrtf(wave_sum(ss) * (1.0f / DH) + EPS);
            { U3 o; o.x = pk2(y[0] * rstd * ghy[0] * siluf_(gt[0]), y[1] * rstd * ghy[1] * siluf_(gt[1])); o.y = pk2(y[2] * rstd * ghy[2] * siluf_(gt[2]), y[3] * rstd * ghy[3] * siluf_(gt[3]));
              o.z = pk2(y[4] * rstd * ghy[4] * siluf_(gt[4]), y[5] * rstd * ghy[5] * siluf_(gt[5])); *(U3*)(Y + row * DM + lane * 6) = o; }
            unpack6(rf, xm); unpack6(rb, xc); unpack6(rg2, gt); ss = 0.f;
#pragma unroll
            for (int q = 0; q < 6; ++q) { y[q] = xm[q] + xc[q]; ss += y[q] * y[q]; }
            rstd = rsqrtf(wave_sum(ss) * (1.0f / DR) + EPS);
            { U3 o; o.x = pk2(y[0] * rstd * grg[0] * siluf_(gt[0]), y[1] * rstd * grg[1] * siluf_(gt[1])); o.y = pk2(y[2] * rstd * grg[2] * siluf_(gt[2]), y[3] * rstd * grg[3] * siluf_(gt[3]));
              o.z = pk2(y[4] * rstd * grg[4] * siluf_(gt[4]), y[5] * rstd * grg[5] * siluf_(gt[5])); *(U3*)(Y + row * DM + 640 + lane * 6) = o; }
        }
        lds_barrier();
    }
}

#define XB_TMO      128
#define XB_XCNT(j)  (256  + 64 * (j))
#define XB_XSUB(j)  (1280 + 64 * (j))
#define XB_XGEN(j)  (2304 + 64 * (j))
#define XB_TOP      3328
#define XB_TOPGEN   3392
#define XCD_BAR_WORDS 3456
#define XB_SPIN_CAP (1u << 22)
#define LAS __attribute__((address_space(3)))
__device__ __forceinline__ unsigned xb_ld(unsigned* p)              { return __hip_atomic_load(p, __ATOMIC_RELAXED, __HIP_MEMORY_SCOPE_AGENT); }
__device__ __forceinline__ unsigned xb_add(unsigned* p, unsigned v) { return __hip_atomic_fetch_add(p, v, __ATOMIC_RELAXED, __HIP_MEMORY_SCOPE_AGENT); }
__device__ __forceinline__ unsigned xb_xcc_id() { return (unsigned)__builtin_amdgcn_s_getreg((3 << 11) | 20) & 0xFu; }
#define XB_SPIN(cond, bar) do { unsigned _sp = 0; while (cond) { __builtin_amdgcn_s_sleep(1); \
    if ((++_sp & 255u) == 0u) { if (xb_ld(&(bar)[XB_TMO])) break; if (_sp > XB_SPIN_CAP) { atomicAdd(&(bar)[XB_TMO], 1u); break; } } } } while (0)
struct XcdBarrier { unsigned* bar; unsigned x; volatile LAS unsigned* st; };
__device__ __forceinline__ XcdBarrier xcd_barrier_post(unsigned* bar, volatile LAS unsigned* st) {
    XcdBarrier b; b.bar = bar; b.x = xb_xcc_id(); b.st = st;
    if (threadIdx.x == 0) (void)xb_add(&bar[XB_XCNT(b.x)], 1u);
    return b;
}
__device__ __forceinline__ void xcd_barrier_complete(unsigned* bar, unsigned x, unsigned& nloc, unsigned& nx) {
    const unsigned G = gridDim.x * gridDim.y * gridDim.z;
    unsigned sum, cnt, mine, sp = 0u;
    for (;;) {
        sum = 0u; cnt = 0u; mine = 0u;
#pragma unroll
        for (unsigned j = 0; j < 16; ++j) { const unsigned c = xb_ld(&bar[XB_XCNT(j)]); sum += c; cnt += (c > 0u) ? 1u : 0u; mine = (j == x) ? c : mine; }
        if (sum == G) break;
        __builtin_amdgcn_s_sleep(1);
        if ((++sp & 255u) == 0u) { if (xb_ld(&bar[XB_TMO])) break; if (sp > XB_SPIN_CAP) { atomicAdd(&bar[XB_TMO], 1u); break; } }
    }
    nloc = mine > 0u ? mine : 1u; nx = cnt > 0u ? cnt : 1u;
}
__device__ __forceinline__ void xcd_barrier(const XcdBarrier& b) {
    asm volatile("s_waitcnt vmcnt(0)" ::: "memory");
    __syncthreads();
    if (threadIdx.x == 0) {
        unsigned* bar = b.bar;
        __builtin_amdgcn_s_waitcnt(0);
        unsigned nloc = b.st[0], nx = b.st[1];
        if (nloc == 0u) { xcd_barrier_complete(bar, b.x, nloc, nx); b.st[0] = nloc; b.st[1] = nx; }
        const unsigned old = xb_add(&bar[XB_XSUB(b.x)], 1u);
        const unsigned gen = old / nloc;
        if (old + 1u == (gen + 1u) * nloc) {
            __builtin_amdgcn_fence(__ATOMIC_RELEASE, "agent");
            asm volatile("s_waitcnt vmcnt(0)" ::: "memory");
            const unsigned og = xb_add(&bar[XB_TOP], 1u);
            const unsigned tg = og / nx;
            if (og + 1u == (tg + 1u) * nx) xb_add(&bar[XB_TOPGEN], 1u);
            else XB_SPIN(xb_ld(&bar[XB_TOPGEN]) == tg, bar);
            __builtin_amdgcn_fence(__ATOMIC_ACQUIRE, "agent");
            xb_add(&bar[XB_XGEN(b.x)], 1u);
            asm volatile("s_waitcnt vmcnt(0)" ::: "memory");
        } else {
            XB_SPIN(xb_ld(&bar[XB_XGEN(b.x)]) == gen, bar);
            __builtin_amdgcn_fence(__ATOMIC_ACQUIRE, "agent");
            asm volatile("s_waitcnt vmcnt(0)" ::: "memory");
        }
    }
    __syncthreads();
}

constexpr int NPHASE = 13;
#ifndef MK_DUP
#define MK_DUP 0
#endif
#define DUPN(bit) (((MK_DUP >> (bit)) & 1) ? 2 : 1)
template <int PH>
__device__ __forceinline__ void run_phase(const Params& p, unsigned char* lds, int vc) {
    float* SS = (float*)(p.ws + WS_SS);
    if constexpr (PH == 0) {
        if ((blockIdx.x >> 3) & 1) {
            phase_x0_prep(p.in[I_XP], p.in[I_XS], (bf16_t*)p.out, SS); asm volatile("" ::: "memory");
            phase_prep_weights(p, lds); phase_filters(p, 0, lds);
        } else {
            phase_prep_weights(p, lds); phase_filters(p, 0, lds); asm volatile("" ::: "memory");
            phase_x0_prep(p.in[I_XP], p.in[I_XS], (bf16_t*)p.out, SS);
        }
    } else if constexpr (PH == 12) {
        phase_final_norm((const bf16_t*)(p.ws + WS_P), SS + 2 * T, p.in[I_FING], p.out);
    } else {
        constexpr int l = (PH - 1) / 6, s = (PH - 1) % 6;
        if constexpr (s == 0) {
            pg8::Gemm g; g.A = (const bf16_t*)p.out; g.Bt = (const bf16_t*)(p.ws + WS_WINT) + (size_t)l * NC * DM; g.M = T; g.N = NC; g.K = DM;
            pg8::StaticOrder S; S.init(T, NC, (int)gridDim.x, vc);
            pg8::EpiBf16 E; E.O = (bf16_t*)(p.ws + WS_P); E.ldc = NC; E.ss = SS + l * T; E.invk = 1.0f / DM; E.eps = EPS; E.glu_tiles = 2;
            pg8::gemm_phase<pg8::EpiBf16, pg8::StaticOrder, false>((PG8_LAS unsigned char*)lds, g, S, E, nullptr);
        } else if constexpr (s == 1) {
            phase_kf_fft(p, lds);
            for (int r = 0; r < DUPN(0); ++r) phase_conformer(p, l, lds);
            for (int r = 0; r < DUPN(1); ++r) phase_hyena_prep(p, l, lds);
        } else if constexpr (s == 2) {
            phase_fftconv(p, l, lds);
            for (int r = 0; r < DUPN(3); ++r) phase_rglru_chain(p, l, lds);
        } else if constexpr (s == 3) {
            for (int r = 0; r < DUPN(4); ++r) phase_finalize(p, l, lds);
            if constexpr (l == 0) phase_filters(p, 1, lds);
        } else if constexpr (s == 4) {
            pg8::Gemm g; g.A = (const bf16_t*)(p.ws + WS_HY); g.Bt = (const bf16_t*)(p.ws + WS_WOUTT) + (size_t)l * DM * DM; g.M = T; g.N = DM; g.K = DM;
            pg8::StaticOrder S; S.init(T, DM, (int)gridDim.x, vc);
            pg8::EpiResB E; E.R = (const bf16_t*)p.out; E.O = (l == 0) ? (bf16_t*)p.out : (bf16_t*)(p.ws + WS_P); E.ldc = DM; E.ssq = SS + (l + 1) * T;
            pg8::gemm_phase<pg8::EpiResB, pg8::StaticOrder, false>((PG8_LAS unsigned char*)lds, g, S, E, nullptr);
        }
    }
}
__global__ __launch_bounds__(512, 2) void mega(Params p) {
    extern __shared__ __attribute__((aligned(16))) unsigned char lds[];
    cg::grid_group grid = cg::this_grid();
    volatile LAS unsigned* xst = (volatile LAS unsigned*)(PG8_LAS unsigned char*)(lds + LDS_BYTES);
    if (threadIdx.x == 0) { xst[0] = 0u; xst[1] = 0u; xst[2] = blockIdx.x; xst[3] = 0u; }
    __syncthreads();
    const bool multi = (p.ph_hi - p.ph_lo) > 1;
    XcdBarrier xb; xb.bar = (unsigned*)(p.ws + WS_BAR); xb.x = 0; xb.st = xst;
    unsigned myrank = 0u;
    if (multi) { xb = xcd_barrier_post((unsigned*)(p.ws + WS_BAR), xst);
        if (threadIdx.x == 0) myrank = xb_add(&xb.bar[RK_BASE + 64 * xb.x], 1u); }
#ifndef MK_MASK
#define MK_MASK 0x1fff
#endif
#define RUN_PH(PH) if constexpr ((MK_MASK >> PH) & 1) if (p.ph_lo <= PH && PH < p.ph_hi) { run_phase<PH>(p, lds, (int)xst[2]); asm volatile("" ::: "memory"); if (PH + 1 < p.ph_hi) { if (p.ph_lo > 1000) grid.sync(); else xcd_barrier(xb); } }
    RUN_PH(0)
    if (multi) {
        if (threadIdx.x == 0) { bool ok = (gridDim.x % 8u) == 0u;
            for (unsigned j = 0; j < 16; ++j) { const unsigned cnt = xb_ld(&xb.bar[RK_BASE + 64 * j]); if (cnt != ((j < 8u) ? gridDim.x / 8u : 0u)) ok = false; }
            if (ok && xb.x < 8u && myrank < gridDim.x / 8u) xst[2] = myrank * 8u + xb.x; }
        __syncthreads();
    }
    RUN_PH(1) RUN_PH(2) RUN_PH(3) RUN_PH(4) RUN_PH(5) RUN_PH(7) RUN_PH(8) RUN_PH(9) RUN_PH(10) RUN_PH(11) RUN_PH(12)
#undef RUN_PH
}

#ifndef MK_LAUNCHES
#define MK_LAUNCHES 1
#endif
extern "C" void kernel_launch(void* const* d_in, const int* in_sizes, int n_in, void* d_out, int out_size, void* d_ws, size_t ws_size, hipStream_t stream) {
    static int grid = 0;
    if (grid == 0) {
        if (n_in != 31 || out_size != T * DM || ws_size < WS_END) { fprintf(stderr, "kernel_launch: unexpected shapes (n_in %d out %d ws %zu need %zu)\n", n_in, out_size, ws_size, (size_t)WS_END); grid = -1; return; }
        int dev = 0, cus = 0, per_cu = 0;
        (void)hipGetDevice(&dev); (void)hipDeviceGetAttribute(&cus, hipDeviceAttributeMultiprocessorCount, dev);
        if (hipFuncSetAttribute((const void*)mega, hipFuncAttributeMaxDynamicSharedMemorySize, LDS_BYTES + 16) != hipSuccess) { fprintf(stderr, "kernel_launch: hipFuncSetAttribute failed\n"); grid = -1; return; }
        if (hipOccupancyMaxActiveBlocksPerMultiprocessor(&per_cu, (const void*)mega, 512, LDS_BYTES + 16) != hipSuccess || per_cu < 1) { fprintf(stderr, "kernel_launch: occupancy query gave %d\n", per_cu); per_cu = 1; }
        (void)hipGetLastError();
        grid = cus * per_cu;
    }
    if (grid < 0) return;
    if (hipMemsetAsync((char*)d_ws + WS_BAR, 0, CTL_BYTES, stream) != hipSuccess) { fprintf(stderr, "kernel_launch: memset failed\n"); return; }
    Params p{};
    for (int i = 0; i < 31; ++i) p.in[i] = (const float*)d_in[i];
    p.out = (float*)d_out; p.ws = (unsigned char*)d_ws;
#if MK_LAUNCHES == 1
    p.ph_lo = 0; p.ph_hi = NPHASE;
    void* args[] = {&p};
    hipError_t e = hipLaunchCooperativeKernel((const void*)mega, dim3(grid), dim3(512), args, LDS_BYTES + 16, stream);
    if (e != hipSuccess) fprintf(stderr, "cooperative launch failed: %s (grid %d)\n", hipGetErrorString(e), grid);
#else
    for (int ph = 0; ph < NPHASE; ++ph) { p.ph_lo = ph; p.ph_hi = ph + 1; hipLaunchKernelGGL(mega, dim3(grid), dim3(512), LDS_BYTES + 16, stream, p); }
#endif
}
```

```cpp
#include <hip/hip_runtime.h>
#include <hip/hip_cooperative_groups.h>
#include <cstdio>
#include <cstdint>
namespace cg = cooperative_groups;

namespace pg8 {
#define PG8_LAS __attribute__((address_space(3)))
typedef unsigned short bf16_t;
typedef short bf16x8 __attribute__((ext_vector_type(8)));
typedef float f32x4 __attribute__((ext_vector_type(4)));
typedef unsigned u32x4 __attribute__((ext_vector_type(4)));
constexpr int BM = 256, BK = 64, HALF = 128, HTB = HALF * BK * 2, STAGE_BYTES = 8 * HTB, NXCD = 8, WGM = 8;

__host__ __device__ __forceinline__ int lds_byte(int r, int c) { const int st = (r >> 4) * 2 + (c >> 5), rr = r & 15, cc = c & 31, ob = rr * 64 + cc * 2; return st * 1024 + (ob ^ (((ob >> 9) & 1) << 5)); }
__host__ __device__ __forceinline__ void stage_rc(int b, int& R, int& C) { const int st = b / 1024, sb = b % 1024, swz = sb ^ (((sb >> 9) & 1) << 5); R = (st >> 1) * 16 + swz / 64; C = (st & 1) * 32 + (swz % 64) / 2; }
__host__ __device__ __forceinline__ int perm32(int rho) { const int n = rho >> 4, i = rho & 15; return 8 * (i >> 2) + 4 * n + (i & 3); }

struct Unit { int pm, pn; };
struct Gemm { const bf16_t* A; const bf16_t* Bt; int M, N, K; };

struct StaticOrder {
    int nM, nN, nwg, G, c, wgm;
    __host__ __device__ void init(int M, int N, int G_, int c_, int wgm_ = WGM) { nM = M / BM; nN = N / BM; nwg = nM * nN; G = G_; c = c_; wgm = wgm_; }
    __host__ __device__ bool next(int i, Unit& u) const {
        const long L = (long)i * G + c; if (L >= nwg) return false;
        int wgid = (int)L; { const int q = nwg / NXCD, r = nwg % NXCD, xcd = wgid % NXCD, off = wgid / NXCD; wgid = (xcd < r ? xcd * (q + 1) : r * (q + 1) + (xcd - r) * q) + off; }
        const int nig = wgm * nN, gid = wgid / nig, fm = gid * wgm, gsz = (nM - fm) < wgm ? (nM - fm) : wgm;
        u.pm = fm + ((wgid % nig) % gsz); u.pn = (wgid % nig) / gsz; return true;
    }
    __device__ __forceinline__ void a_ready(const Unit&) const {}
    __device__ __forceinline__ void done(const Unit&) const {}
};

__device__ __forceinline__ unsigned cvt_pk_bf16(float lo, float hi) { unsigned r; asm volatile("v_cvt_pk_bf16_f32 %0, %1, %2" : "=v"(r) : "v"(lo), "v"(hi)); return r; }

struct EpiBf16 {
    static constexpr bool PERM = true, AFTER_DRAIN = false;
    bf16_t* O; int ldc; const float* ss; float invk, eps; int glu_tiles;
    __device__ __forceinline__ void operator()(const f32x4 (&acc)[2][2][4][2], const Unit& u, int wr, int wc, int fr, int fq) const {
        const int row0 = u.pm * BM + wr * 64 + fr; const int col0 = u.pn * BM + wc * 32 + 8 * fq;
        float sv[2][4];
#pragma unroll
        for (int ai = 0; ai < 2; ++ai)
#pragma unroll
            for (int m = 0; m < 4; ++m) sv[ai][m] = ss[row0 + ai * HALF + m * 16];
        asm volatile("s_waitcnt vmcnt(0)" ::: "memory");
        if (u.pn >= glu_tiles) {
#pragma unroll
            for (int ai = 0; ai < 2; ++ai)
#pragma unroll
                for (int m = 0; m < 4; ++m) { const int row = row0 + ai * HALF + m * 16; bf16_t* rowp = O + (size_t)row * ldc + col0;
                    const float rs = __builtin_amdgcn_rsqf(sv[ai][m] * invk + eps);
#pragma unroll
                    for (int bj = 0; bj < 2; ++bj) { const f32x4 v0 = acc[ai][bj][m][0] * rs, v1 = acc[ai][bj][m][1] * rs;
                        u32x4 w; w.x = cvt_pk_bf16(v0[0], v0[1]); w.y = cvt_pk_bf16(v0[2], v0[3]); w.z = cvt_pk_bf16(v1[0], v1[1]); w.w = cvt_pk_bf16(v1[2], v1[3]);
                        __builtin_nontemporal_store(w, (u32x4*)(rowp + bj * HALF)); } }
        } else {
#pragma unroll
            for (int ai = 0; ai < 2; ++ai)
#pragma unroll
                for (int m = 0; m < 4; ++m) { const int row = row0 + ai * HALF + m * 16; bf16_t* rowp = O + (size_t)row * ldc + col0;
                    const float rs = __builtin_amdgcn_rsqf(sv[ai][m] * invk + eps), rg = -1.4426950408889634f * rs;
                    f32x4 v0 = acc[ai][0][m][0] * rs, v1 = acc[ai][0][m][1] * rs; const f32x4 g0 = acc[ai][1][m][0] * rg, g1 = acc[ai][1][m][1] * rg;
#pragma unroll
                    for (int j = 0; j < 4; ++j) { v0[j] *= __builtin_amdgcn_rcpf(1.0f + __builtin_amdgcn_exp2f(g0[j])); v1[j] *= __builtin_amdgcn_rcpf(1.0f + __builtin_amdgcn_exp2f(g1[j])); }
                    u32x4 w; w.x = cvt_pk_bf16(v0[0], v0[1]); w.y = cvt_pk_bf16(v0[2], v0[3]); w.z = cvt_pk_bf16(v1[0], v1[1]); w.w = cvt_pk_bf16(v1[2], v1[3]);
                    __builtin_nontemporal_store(w, (u32x4*)rowp); }
        }
    }
};
struct EpiResB {
    static constexpr bool PERM = true, AFTER_DRAIN = false;
    bf16_t* O; const bf16_t* R; int ldc; float* ssq;
    __device__ __forceinline__ void operator()(const f32x4 (&acc)[2][2][4][2], const Unit& u, int wr, int wc, int fr, int fq) const {
        const int row0 = u.pm * BM + wr * 64 + fr, col0 = u.pn * BM + wc * 32 + 8 * fq;
#pragma unroll
        for (int ai = 0; ai < 2; ++ai) {
            u32x4 rv[4][2];
#pragma unroll
            for (int m = 0; m < 4; ++m)
#pragma unroll
                for (int bj = 0; bj < 2; ++bj) rv[m][bj] = *(const u32x4*)(R + (size_t)(row0 + ai * HALF + m * 16) * ldc + col0 + bj * HALF);
            asm volatile("s_waitcnt vmcnt(0)" ::: "memory");
#pragma unroll
            for (int m = 0; m < 4; ++m) { const int row = row0 + ai * HALF + m * 16; const size_t off = (size_t)row * ldc + col0; float s2 = 0.f;
#pragma unroll
                for (int bj = 0; bj < 2; ++bj) {
                    f32x4 v0 = acc[ai][bj][m][0], v1 = acc[ai][bj][m][1]; const u32x4 r4 = rv[m][bj];
                    v0[0] += __uint_as_float(r4.x << 16); v0[1] += __uint_as_float(r4.x & 0xffff0000u); v0[2] += __uint_as_float(r4.y << 16); v0[3] += __uint_as_float(r4.y & 0xffff0000u);
                    v1[0] += __uint_as_float(r4.z << 16); v1[1] += __uint_as_float(r4.z & 0xffff0000u); v1[2] += __uint_as_float(r4.w << 16); v1[3] += __uint_as_float(r4.w & 0xffff0000u);
                    s2 += v0[0] * v0[0] + v0[1] * v0[1] + v0[2] * v0[2] + v0[3] * v0[3] + v1[0] * v1[0] + v1[1] * v1[1] + v1[2] * v1[2] + v1[3] * v1[3];
                    u32x4 w; w.x = cvt_pk_bf16(v0[0], v0[1]); w.y = cvt_pk_bf16(v0[2], v0[3]); w.z = cvt_pk_bf16(v1[0], v1[1]); w.w = cvt_pk_bf16(v1[2], v1[3]);
                    *(u32x4*)(O + off + bj * HALF) = w; }
                s2 += __shfl_xor(s2, 16); s2 += __shfl_xor(s2, 32);
                if (fq == 0) atomicAdd(ssq + row, s2); }
        }
    }
};

template <class Epi, class Sched, bool STAMP = false>
__device__ __forceinline__ void gemm_phase(PG8_LAS unsigned char* lds, const Gemm g, const Sched& S, const Epi& E, unsigned long long* stamps) {
    const int tid = threadIdx.x, wid = __builtin_amdgcn_readfirstlane(tid >> 6), lane = tid & 63, wr = wid >> 2, wc = wid & 3, fr = lane & 15, fq = lane >> 4;
    const int K = g.K, nt = K / BK;
    int ts_lo = 0, ts_hi = 0, nts = 0; const unsigned long long rt_entry = STAMP ? (unsigned long long)wall_clock64() : 0ull;
#define PG8_STAMP() do { if (STAMP && wid == 0 && nts < 64) { const unsigned long long _c = (unsigned long long)clock64(); \
        ts_lo = (lane == nts) ? (int)(unsigned)_c : ts_lo; ts_hi = (lane == nts) ? (int)(unsigned)(_c >> 32) : ts_hi; ++nts; } } while (0)
    PG8_STAMP();
    unsigned voffA[2], voffB[2];
#pragma unroll
    for (int i = 0; i < 2; ++i) { int R, C; stage_rc(tid * 16 + i * 8192, R, C); const int Rb = Epi::PERM ? ((R & ~31) + perm32(R & 31)) : R;
        voffA[i] = (unsigned)(R * K + C) * 2u; voffB[i] = (unsigned)(Rb * K + C) * 2u; }
    const size_t kstep = (size_t)(BK * 2);
    const size_t hstep = (size_t)HALF * K * 2;
    const size_t tstep = 2 * hstep;
    const unsigned ldsw = (unsigned)wid * 1024u;
    const int aoff = lds_byte(wr * 64 + fr, fq * 8), boff = lds_byte(wc * 32 + fr, fq * 8);
#define PG8_SA(b, h) (((b) * 2 + (h)) * HTB)
#define PG8_SB(b, h) ((4 + (b) * 2 + (h)) * HTB)
#define PG8_STAGE(bufoff, gbase, voff) do { _Pragma("unroll") for (int _i = 0; _i < 2; ++_i) \
        __builtin_amdgcn_global_load_lds((const unsigned*)((const char*)(gbase) + (voff)[_i]), (PG8_LAS unsigned*)(lds + (bufoff) + ldsw + _i * 8192), 16, 0, 0); } while (0)
#define PG8_LDA(dst, b, h) do { _Pragma("unroll") for (int m = 0; m < 4; ++m) _Pragma("unroll") for (int k = 0; k < 2; ++k) dst[m][k] = *(const PG8_LAS bf16x8*)(lds + PG8_SA(b, h) + aoff + m * 2048 + k * 1024); } while (0)
#define PG8_LDB(dst, b, h) do { _Pragma("unroll") for (int n = 0; n < 2; ++n) _Pragma("unroll") for (int k = 0; k < 2; ++k) dst[n][k] = *(const PG8_LAS bf16x8*)(lds + PG8_SB(b, h) + boff + n * 2048 + k * 1024); } while (0)
#define PG8_MMA(ai, bj, At, Bt) do { __builtin_amdgcn_s_setprio(1); _Pragma("unroll") for (int m = 0; m < 4; ++m) _Pragma("unroll") for (int n = 0; n < 2; ++n) _Pragma("unroll") for (int k = 0; k < 2; ++k) \
        acc[ai][bj][m][n] = __builtin_amdgcn_mfma_f32_16x16x32_bf16(Bt[n][k], At[m][k], acc[ai][bj][m][n], 0, 0, 0); __builtin_amdgcn_s_setprio(0); } while (0)
#define PG8_WAIT_V(n) asm volatile("s_waitcnt vmcnt(" #n ")" ::: "memory")
#define PG8_WAIT_L(n) asm volatile("s_waitcnt lgkmcnt(" #n ")" ::: "memory")
#define PG8_BAR __builtin_amdgcn_s_barrier()
#define PG8_SCHED __builtin_amdgcn_sched_barrier(0)
    Unit cur, nxt; int ui = 0;
    if (!S.next(0, cur)) return;
    f32x4 acc[2][2][4][2];
#pragma unroll
    for (int a = 0; a < 2; ++a)
#pragma unroll
        for (int b = 0; b < 2; ++b)
#pragma unroll
            for (int m = 0; m < 4; ++m)
#pragma unroll
                for (int n = 0; n < 2; ++n) acc[a][b][m][n] = (f32x4){0.f, 0.f, 0.f, 0.f};
    bf16x8 At[4][2], B0[2][2], B1[2][2];
    const char* cA = (const char*)g.A + (size_t)cur.pm * tstep; const char* cB = (const char*)g.Bt + (size_t)cur.pn * tstep;
    S.a_ready(cur);
    PG8_STAGE(PG8_SB(0, 0), cB, voffB); PG8_STAGE(PG8_SA(0, 0), cA, voffA); PG8_STAGE(PG8_SB(0, 1), cB + hstep, voffB); PG8_STAGE(PG8_SA(0, 1), cA + hstep, voffA);
    if (wr == 1) PG8_BAR;
    PG8_WAIT_V(4); PG8_BAR;
    PG8_STAGE(PG8_SB(1, 0), cB + kstep, voffB); PG8_STAGE(PG8_SA(1, 0), cA + kstep, voffA); PG8_STAGE(PG8_SB(1, 1), cB + hstep + kstep, voffB);
    PG8_WAIT_V(6); PG8_BAR;
    PG8_STAMP();
    for (;;) {
        const bool has_next = S.next(ui + 1, nxt);
        const char* nA = has_next ? (const char*)g.A + (size_t)nxt.pm * tstep : cA; const char* nB = has_next ? (const char*)g.Bt + (size_t)nxt.pn * tstep : cB;
        for (int t = 0; t < nt; t += 2) {
            const bool last = (t == nt - 2);
            const char* a1 = cA + (size_t)(t + 1) * kstep;
            const char* a2 = last ? nA : cA + (size_t)(t + 2) * kstep; const char* b2 = last ? nB : cB + (size_t)(t + 2) * kstep;
            const char* a3 = a2 + kstep; const char* b3 = b2 + kstep;
            if (last && has_next) S.a_ready(nxt);
            PG8_LDB(B0, 0, 0); PG8_SCHED; PG8_LDA(At, 0, 0); PG8_STAGE(PG8_SA(1, 1), a1 + hstep, voffA);
            PG8_WAIT_L(8); PG8_BAR; PG8_WAIT_L(0); PG8_MMA(0, 0, At, B0); PG8_BAR; PG8_SCHED;
            PG8_LDB(B1, 0, 1); PG8_STAGE(PG8_SB(0, 0), b2, voffB);
            PG8_BAR; PG8_WAIT_L(0); PG8_MMA(0, 1, At, B1); PG8_BAR;
            PG8_LDA(At, 0, 1); PG8_STAGE(PG8_SA(0, 0), a2, voffA);
            PG8_BAR; PG8_WAIT_L(0); PG8_MMA(1, 0, At, B0); PG8_BAR; PG8_SCHED;
            PG8_STAGE(PG8_SB(0, 1), b2 + hstep, voffB);
            PG8_WAIT_V(6); PG8_BAR; PG8_MMA(1, 1, At, B1); PG8_BAR;
            PG8_LDB(B0, 1, 0); PG8_SCHED; PG8_LDA(At, 1, 0); PG8_STAGE(PG8_SA(0, 1), a2 + hstep, voffA);
            PG8_WAIT_L(8); PG8_BAR; PG8_WAIT_L(0); PG8_MMA(0, 0, At, B0); PG8_BAR; PG8_SCHED;
            PG8_LDB(B1, 1, 1); PG8_STAGE(PG8_SB(1, 0), b3, voffB);
            PG8_BAR; PG8_WAIT_L(0); PG8_MMA(0, 1, At, B1); PG8_BAR;
            PG8_LDA(At, 1, 1); PG8_STAGE(PG8_SA(1, 0), a3, voffA);
            PG8_BAR; PG8_WAIT_L(0); PG8_MMA(1, 0, At, B0); PG8_BAR; PG8_SCHED;
            PG8_STAGE(PG8_SB(1, 1), b3 + hstep, voffB);
            PG8_WAIT_V(6); PG8_BAR; PG8_MMA(1, 1, At, B1); PG8_BAR;
        }
        PG8_STAMP();
        if constexpr (!Epi::AFTER_DRAIN) { E(acc, cur, wr, wc, fr, fq); S.done(cur); }
        PG8_STAMP();
        if (!has_next) break;
#pragma unroll
        for (int a = 0; a < 2; ++a)
#pragma unroll
            for (int b = 0; b < 2; ++b)
#pragma unroll
                for (int m = 0; m < 4; ++m)
#pragma unroll
                    for (int n = 0; n < 2; ++n) acc[a][b][m][n] = (f32x4){0.f, 0.f, 0.f, 0.f};
        cur = nxt; cA = nA; cB = nB; ++ui;
    }
    PG8_WAIT_V(0);
    if (wr == 0) PG8_BAR;
    PG8_BAR;
    if constexpr (Epi::AFTER_DRAIN) { E.fused(acc, cur, wr, wc, fr, fq, lds, wid, lane); S.done(cur); }
    PG8_STAMP();
    if (STAMP && wid == 0) { stamps[lane] = lane < nts ? (((unsigned long long)(unsigned)ts_hi << 32) | (unsigned)ts_lo) : 0ull;
        if (lane == 62) stamps[62] = rt_entry; if (lane == 63) stamps[63] = (unsigned long long)wall_clock64(); }
#undef PG8_STAMP
#undef PG8_SA
#undef PG8_SB
#undef PG8_STAGE
#undef PG8_LDA
#undef PG8_LDB
#undef PG8_MMA
#undef PG8_WAIT_V
#undef PG8_WAIT_L
#undef PG8_BAR
#undef PG8_SCHED
}
}

typedef unsigned short bf16_t;
typedef short bf16x8 __attribute__((ext_vector_type(8)));
typedef float f32x4 __attribute__((ext_vector_type(4)));
typedef unsigned u32x4 __attribute__((ext_vector_type(4)));
typedef unsigned u32x2 __attribute__((ext_vector_type(2)));
constexpr int NB = 12, SL = 8192, T = NB * SL, DM = 1024, NC = 3072, NPROMPT = 8 * SL;
constexpr int DH = 384, DC = 256, DR = 384;
constexpr int C_X0 = 512, C_X1 = 896, C_V = 1280, C_RG = 1664, C_GATE = 2048;
__host__ __device__ __forceinline__ int origcol(int n) {
    if (n < 128) return 1152 + n; if (n < 256) return 1408 + (n - 128); if (n < 384) return 1280 + (n - 256); if (n < 512) return 1536 + (n - 384);
    if (n < 896) return n - 512; if (n < 1280) return 384 + (n - 896); if (n < 1664) return 768 + (n - 1280); return n; }
constexpr int NFFT = 16384;
constexpr int LDS_BYTES = (NFFT + NFFT / 16) * 8;
constexpr float EPS = 1e-6f;
constexpr int NCHUNK = 16, CHUNK = 512;
constexpr int XCD_BAR_WORDS_C = 3456;

constexpr size_t WS_P = 0;
constexpr size_t WS_HY = WS_P + (size_t)T * NC * 2;
constexpr size_t WS_U = WS_HY + (size_t)T * DM * 2;
constexpr size_t WS_KF = WS_U + (size_t)NB * DH * SL * 2;
constexpr size_t WS_WINT = WS_KF + (size_t)DH * NFFT * 8;
constexpr size_t WS_WOUTT = WS_WINT + (size_t)2 * NC * DM * 2;
constexpr size_t WS_PWT = WS_WOUTT + (size_t)2 * DM * DM * 2;
constexpr size_t WS_RGWT = WS_PWT + (size_t)2 * DC * DC * 2;
constexpr size_t WS_AGG = WS_RGWT + (size_t)2 * 2 * 2 * 6 * 64 * 64 * 2;
constexpr size_t WS_BAR = WS_AGG + (size_t)NB * NCHUNK * 2 * 2 * DR * 4;
constexpr int RK_BASE = XCD_BAR_WORDS_C;
constexpr size_t CTL_BYTES = (size_t)(XCD_BAR_WORDS_C + 16 * 64) * 4;
constexpr size_t WS_GRAN = WS_BAR + CTL_BYTES;
constexpr size_t GRAN_BYTES = (size_t)2 * 64 * 144 * 64 * 8;
constexpr size_t WS_SS = WS_GRAN + GRAN_BYTES;
constexpr size_t WS_END = WS_SS + (size_t)3 * T * 4;

struct Params {
    const float* in[31];
    float* out;
    unsigned char* ws;
    int ph_lo, ph_hi;
};
enum { I_XP = 0, I_XS, I_NORMG, I_WIN, I_HCW, I_HCB, I_HW1, I_HB1, I_HW2, I_HB2, I_HW3, I_HB3, I_HW4, I_HFREQ, I_HD, I_CDW, I_CDB, I_CLG, I_CLB, I_CPW, I_CPB,
       I_RCW, I_RCB, I_RWA, I_RBA, I_RWX, I_RBX, I_RLAM, I_GRPG, I_WOUT, I_FING };

__device__ __forceinline__ float bf2f(bf16_t b) { return __uint_as_float(((unsigned)b) << 16); }
__device__ __forceinline__ unsigned pk2(float lo, float hi) { unsigned r; asm("v_cvt_pk_bf16_f32 %0, %1, %2" : "=v"(r) : "v"(lo), "v"(hi)); return r; }
__device__ __forceinline__ bf16_t f2bf(float f) { return (bf16_t)(pk2(f, f) & 0xffffu); }
__device__ __forceinline__ float wave_sum(float v) {
#pragma unroll
    for (int o = 32; o >= 1; o >>= 1) v += __shfl_xor(v, o);
    return v;
}
template <int N>
__device__ __forceinline__ void wave_sum_n(float (&v)[N]) {
#pragma unroll
    for (int o = 32; o >= 1; o >>= 1) {
#pragma unroll
        for (int i = 0; i < N; ++i) v[i] += __shfl_xor(v[i], o); }
}
__device__ __forceinline__ void lds_barrier() { asm volatile("s_waitcnt lgkmcnt(0)" ::: "memory"); __builtin_amdgcn_s_barrier(); asm volatile("" ::: "memory"); }
__device__ __forceinline__ int launder_tid() { int t = threadIdx.x; asm volatile("" : "+v"(t)); return t; }
__device__ __forceinline__ float sigmoidf_(float x) { return __builtin_amdgcn_rcpf(1.0f + __builtin_amdgcn_exp2f(-1.4426950408889634f * x)); }
__device__ __forceinline__ float siluf_(float x) { return x * sigmoidf_(x); }
struct __attribute__((packed, aligned(4))) U3 { unsigned x, y, z; };

__device__ __forceinline__ void transpose_tile(const float* src, int src_ld, bf16_t* dst, int dst_ld, int k0, int n0, float* tile  , const float* kscale = nullptr, int n0src = -1) {
    if (n0src < 0) n0src = n0;
    const int tid = threadIdx.x, lo = tid & 63, hi = tid >> 6;
#pragma unroll
    for (int i = 0; i < 8; ++i) { const int kk = i * 8 + hi; tile[kk * 65 + lo] = src[(size_t)(k0 + kk) * src_ld + n0src + lo] * (kscale ? kscale[k0 + kk] : 1.0f); }
    __syncthreads();
#pragma unroll
    for (int i = 0; i < 8; ++i) { const int nn = i * 8 + hi; dst[(size_t)(n0 + nn) * dst_ld + k0 + lo] = f2bf(tile[lo * 65 + nn]); }
    __syncthreads();
}
__device__ __forceinline__ void phase_prep_weights(const Params& p, unsigned char* lds) {
    float* tile = (float*)lds;
    { u32x4* g = (u32x4*)(p.ws + WS_GRAN); const u32x4 z = {0u, 0u, 0u, 0u};
      for (size_t i = (size_t)blockIdx.x * 512 + threadIdx.x; i < GRAN_BYTES / 16; i += (size_t)gridDim.x * 512) g[i] = z; }
    constexpr int N_WIN = 16 * 48, N_WOUT = 16 * 16, N_PW = 16, N_RG = 24;
    constexpr int PER_LAYER = N_WIN + N_WOUT + N_PW + 2 * N_RG;
    for (int it = blockIdx.x; it < 2 * PER_LAYER; it += gridDim.x) {
        const int l = it / PER_LAYER; int r = it % PER_LAYER;
        if (r < N_WIN) { transpose_tile(p.in[I_WIN] + (size_t)l * DM * NC, NC, (bf16_t*)(p.ws + WS_WINT) + (size_t)l * NC * DM, DM, (r / 48) * 64, (r % 48) * 64, tile, p.in[I_NORMG] + l * DM, origcol((r % 48) * 64)); continue; }
        r -= N_WIN;
        if (r < N_WOUT) { transpose_tile(p.in[I_WOUT] + (size_t)l * DM * DM, DM, (bf16_t*)(p.ws + WS_WOUTT) + (size_t)l * DM * DM, DM, (r / 16) * 64, (r % 16) * 64, tile); continue; }
        r -= N_WOUT;
        if (r < N_PW) { transpose_tile(p.in[I_CPW] + (size_t)l * DC * DC, DC, (bf16_t*)(p.ws + WS_PWT) + (size_t)l * DC * DC, DC, (r / 4) * 64, (r % 4) * 64, tile); continue; }
        r -= N_PW;
        const int gate = r / N_RG, dh = r % N_RG, dir = dh / 6, h = dh % 6;
        const float* src = p.in[gate ? I_RWX : I_RWA] + ((size_t)(l * 2 + dir) * 6 + h) * 4096;
        bf16_t* dst = (bf16_t*)(p.ws + WS_RGWT) + ((size_t)((l * 2 + dir) * 2 + gate) * 6 + h) * 4096;
        transpose_tile(src, 64, dst, 64, 0, 0, tile);
    }
}

__device__ __forceinline__ void phase_x0_prep(const float* xa, const float* xb, bf16_t* H, float* ss) {
    const int lane = threadIdx.x & 63, wave = threadIdx.x >> 6;
    for (int i = blockIdx.x * 512 + threadIdx.x; i < 2 * T; i += gridDim.x * 512) ss[T + i] = 0.f;
    const int NW = gridDim.x * 8;
    for (int row0 = blockIdx.x * 8 + wave; row0 < T; row0 += 4 * NW) {
        f32x4 v[4][4];
#pragma unroll
        for (int r = 0; r < 4; ++r) { const int row = row0 + r * NW;
            if (row < T) { const float* xr = (row < NPROMPT) ? xa + (size_t)row * DM : xb + (size_t)(row - NPROMPT) * DM;
#pragma unroll
                for (int j = 0; j < 4; ++j) v[r][j] = __builtin_nontemporal_load((const f32x4*)(xr + lane * 4 + 256 * j)); } }
#pragma unroll
        for (int r = 0; r < 4; ++r) { const int row = row0 + r * NW;
            if (row < T) { float s2 = 0.f;
#pragma unroll
                for (int j = 0; j < 4; ++j) { s2 += v[r][j].x * v[r][j].x + v[r][j].y * v[r][j].y + v[r][j].z * v[r][j].z + v[r][j].w * v[r][j].w;
                    u32x2 w; w.x = pk2(v[r][j].x, v[r][j].y); w.y = pk2(v[r][j].z, v[r][j].w); *(u32x2*)(H + (size_t)row * DM + lane * 4 + 256 * j) = w; }
                s2 = wave_sum(s2); if (lane == 0) ss[row] = s2; } }
    }
}
__device__ __forceinline__ void phase_final_norm(const bf16_t* x2, const float* ss, const float* g, float* out) {
    const int lane = threadIdx.x & 63, wave = threadIdx.x >> 6;
    f32x4 gv[4];
#pragma unroll
    for (int j = 0; j < 4; ++j) gv[j] = *(const f32x4*)(g + lane * 4 + 256 * j);
    const int NW = gridDim.x * 8;
    for (int row0 = blockIdx.x * 8 + wave; row0 < T; row0 += 4 * NW) {
        u32x2 v[4][4]; float rs[4];
#pragma unroll
        for (int r = 0; r < 4; ++r) { const int row = row0 + r * NW; rs[r] = 0.f;
            if (row < T) { rs[r] = rsqrtf(ss[row] * (1.0f / DM) + EPS);
#pragma unroll
                for (int j = 0; j < 4; ++j) v[r][j] = *(const u32x2*)(x2 + (size_t)row * DM + lane * 4 + 256 * j); } }
#pragma unroll
        for (int r = 0; r < 4; ++r) { const int row = row0 + r * NW;
            if (row < T) {
#pragma unroll
                for (int j = 0; j < 4; ++j) { f32x4 x; x.x = __uint_as_float(v[r][j].x << 16); x.y = __uint_as_float(v[r][j].x & 0xffff0000u); x.z = __uint_as_float(v[r][j].y << 16); x.w = __uint_as_float(v[r][j].y & 0xffff0000u);
                    *(f32x4*)(out + (size_t)row * DM + lane * 4 + 256 * j) = x * rs[r] * gv[j]; } } }
    }
}

__device__ __forceinline__ void phase_filters(const Params& p, int l, unsigned char* lds) {
    float* Z = (float*)lds;
    float* H1 = Z + 32 * 33;
    float* H2 = H1 + 32 * 65;
    float* OT = H2 + 32 * 65;
    const float* w1 = p.in[I_HW1] + (size_t)l * 33 * 64; const float* b1 = p.in[I_HB1] + l * 64;
    const float* w2 = p.in[I_HW2] + (size_t)l * 64 * 64; const float* b2 = p.in[I_HB2] + l * 64;
    const float* w3 = p.in[I_HW3] + (size_t)l * 64 * 64; const float* b3 = p.in[I_HB3] + l * 64;
    const float* w4 = p.in[I_HW4] + (size_t)l * 64 * 768; const float* fr = p.in[I_HFREQ] + l * 64;
    float2* KF = (float2*)(p.ws + WS_KF);
    for (int it = blockIdx.x; it < SL / 32; it += gridDim.x) {
        const int t0 = it * 32; const int tid = launder_tid();
        for (int idx = tid; idx < 32 * 33; idx += 512) {
            const int tl = idx / 33, f = idx % 33; const float t = (float)(t0 + tl);
            float z;
            if (f == 0) z = t / (float)(SL - 1);
            else { const int j = (f - 1) & 15; const float fj = 1e-4f + (float)j * ((15.0f - 1e-4f) / 15.0f); const float ang = 2.0f * fj * t * (1.0f / SL);
                   z = (f <= 16) ? cospif(ang) : -sinpif(ang); }
            Z[tl * 33 + f] = z;
        }
        __syncthreads();
        { const int o = tid & 63; const float frq = fr[o], bb = b1[o];
#pragma unroll
          for (int i = 0; i < 4; ++i) { const int tl = (tid >> 6) + 8 * i; float a = bb;
_Pragma("unroll 3") for (int f = 0; f < 33; ++f) a += Z[tl * 33 + f] * w1[f * 64 + o]; H1[tl * 65 + o] = sinf(frq * a); } }
        __syncthreads();
        { const int o = tid & 63; const float frq = fr[o], bb = b2[o];
#pragma unroll
          for (int i = 0; i < 4; ++i) { const int tl = (tid >> 6) + 8 * i; float a = bb;
_Pragma("unroll 4") for (int f = 0; f < 64; ++f) a += H1[tl * 65 + f] * w2[f * 64 + o]; H2[tl * 65 + o] = sinf(frq * a); } }
        __syncthreads();
        { const int o = tid & 63; const float frq = fr[o], bb = b3[o];
#pragma unroll
          for (int i = 0; i < 4; ++i) { const int tl = (tid >> 6) + 8 * i; float a = bb;
_Pragma("unroll 4") for (int f = 0; f < 64; ++f) a += H2[tl * 65 + f] * w3[f * 64 + o]; H1[tl * 65 + o] = sinf(frq * a); } }
        __syncthreads();
#pragma unroll 1
        for (int cr = tid; cr < 2 * 768; cr += 512) {
            const int c = cr % 768, rnd = cr / 768;
            float acc[16];
#pragma unroll
            for (int tl = 0; tl < 16; ++tl) acc[tl] = 0.f;
#pragma unroll 2
            for (int k = 0; k < 64; ++k) { const float w = w4[k * 768 + c];
#pragma unroll
                for (int tl = 0; tl < 16; ++tl) acc[tl] += H1[(rnd * 16 + tl) * 65 + k] * w; }
#pragma unroll
            for (int tl = 0; tl < 16; ++tl) OT[c * 33 + rnd * 16 + tl] = acc[tl];
        }
        __syncthreads();
        for (int idx = tid; idx < 768 * 32; idx += 512) {
            const int c768 = idx >> 5, tl = idx & 31, t = t0 + tl, c = c768 % DH;
            const float minD = -3.0701134573253944f, maxD = -15.350567286626972f;
            const float delta = fabsf(minD + (maxD - minD) * ((float)c / (float)(DH - 1)));
            const float val = OT[c768 * 33 + tl] * __expf(-((float)t / (float)(SL - 1)) * delta) * (1.0f / NFFT);
            if (c768 < DH) KF[(size_t)c * NFFT + t] = make_float2(val, 0.f);
            else if (t > 0) KF[(size_t)c * NFFT + (NFFT - t)] = make_float2(val, 0.f);
            else KF[(size_t)c * NFFT + SL] = make_float2(0.f, 0.f);
        }
        __syncthreads();
    }
}

__device__ __forceinline__ int PH(int i) { return i + (i >> 4); }
__device__ __forceinline__ float2 opq(float2 v) { asm("" : "+v"(v.x), "+v"(v.y)); return v; }
__device__ __forceinline__ float2 cmul(float2 a, float2 b) { return make_float2(a.x * b.x - a.y * b.y, a.x * b.y + a.y * b.x); }
__device__ __forceinline__ float2 tw16(int m, bool inv) {
    const float cs[8] = {1.0f, 0.92387953251128674f, 0.70710678118654752f, 0.38268343236508977f, 0.0f, -0.38268343236508977f, -0.70710678118654752f, -0.92387953251128674f};
    const float sn[8] = {0.0f, 0.38268343236508977f, 0.70710678118654752f, 0.92387953251128674f, 1.0f, 0.92387953251128674f, 0.70710678118654752f, 0.38268343236508977f};
    return make_float2(cs[m], inv ? sn[m] : -sn[m]);
}
template <int LR, bool INV, bool ZEROJ>
__device__ __forceinline__ void bfly(float2 (&x)[1 << LR], float ang0) {
    constexpr int R = 1 << LR;
    float2 w[LR];
    if (!ZEROJ) {
        const float s0 = __builtin_amdgcn_sinf(ang0), c0 = __builtin_amdgcn_cosf(ang0);
        w[0] = make_float2(c0, INV ? s0 : -s0);
#pragma unroll
        for (int t = 1; t < LR; ++t) w[t] = cmul(w[t - 1], w[t - 1]);
    }
#pragma unroll
    for (int tt = 0; tt < LR; ++tt) {
        const int t = INV ? (LR - 1 - tt) : tt;
        const int half = R >> (t + 1);
#pragma unroll
        for (int q = 0; q < R; ++q) {
            if (q & half) continue;
            const int ql = q & (half - 1);
            const int m = (ql << t) * (16 / R);
            float2 tw;
            if (ZEROJ) tw = tw16(m, INV);
            else if (m == 0) tw = w[t];
            else tw = cmul(w[t], tw16(m, INV));
            const bool triv = ZEROJ && (m == 0);
            if (!INV) {
                const float2 a = x[q], b = x[q + half];
                x[q] = make_float2(a.x + b.x, a.y + b.y);
                const float2 d = make_float2(a.x - b.x, a.y - b.y);
                x[q + half] = triv ? d : cmul(d, tw);
            } else {
                const float2 a = x[q]; const float2 b = triv ? x[q + half] : cmul(x[q + half], tw);
                x[q] = make_float2(a.x + b.x, a.y + b.y);
                x[q + half] = make_float2(a.x - b.x, a.y - b.y);
            }
        }
    }
}
template <int LR, bool INV>
__device__ __forceinline__ void fft_pass(float2* X, int Blog) {
    constexpr int R = 1 << LR;
    const int Slog = Blog - LR;
    const int tid0 = launder_tid();
#pragma unroll 1
    for (int id = tid0; id < (NFFT >> LR); id += 512) {
        const int blk = id >> Slog, j = id & ((1 << Slog) - 1);
        const int base = (blk << Blog) + j;
        float2 x[R];
#pragma unroll
        for (int q = 0; q < R; ++q) x[q] = X[PH(base + (q << Slog))];
        bfly<LR, INV, false>(x, (float)j * (1.0f / (float)(1 << Blog)));
#pragma unroll
        for (int q = 0; q < R; ++q) X[PH(base + (q << Slog))] = opq(x[q]);
    }
    lds_barrier();
}
template <bool CONV>
__device__ __forceinline__ void fft_mid(float2* X, const float2* kf, float2* gout, bool do_store) {
    const int tid0 = launder_tid();
#pragma unroll 1
    for (int id = tid0; id < (NFFT >> 4); id += 512) {
        float2 x[16];
#pragma unroll
        for (int q = 0; q < 16; ++q) x[q] = X[17 * id + q];
        bfly<4, false, true>(x, 0.f);
        if (CONV) {
#pragma unroll
            for (int q = 0; q < 16; ++q) { const float2 k1 = kf[q * 1024 + id]; x[q] = cmul(x[q], k1); }
            bfly<4, true, true>(x, 0.f);
#pragma unroll
            for (int q = 0; q < 16; ++q) X[17 * id + q] = opq(x[q]);
        } else if (do_store) {
#pragma unroll
            for (int q = 0; q < 16; ++q) gout[q * 1024 + id] = opq(x[q]);
        }
    }
    lds_barrier();
}
__device__ __forceinline__ void phase_kf_fft(const Params& p, unsigned char* lds, bool do_store = true) {
    float2* X = (float2*)lds; float2* KF = (float2*)(p.ws + WS_KF);
    for (int c = blockIdx.x; c < DH; c += gridDim.x) {
        float2* kc = KF + (size_t)c * NFFT;
        const int tid0 = launder_tid();
#pragma unroll 1
        for (int id = tid0; id < 4096; id += 512) {
            float2 x[4];
#pragma unroll
            for (int q = 0; q < 4; ++q) x[q] = kc[id + q * 4096];
            bfly<2, false, false>(x, (float)id * (1.0f / 16384.0f));
#pragma unroll
            for (int q = 0; q < 4; ++q) X[PH(id + q * 4096)] = opq(x[q]);
        }
        lds_barrier();
        fft_pass<4, false>(X, 12); fft_pass<4, false>(X, 8); fft_mid<false>(X, nullptr, kc, do_store);
    }
}
__device__ __forceinline__ void phase_fftconv(const Params& p, int l, unsigned char* lds, bool do_store = true) {
    float2* X = (float2*)lds; const float2* KF = (const float2*)(p.ws + WS_KF); bf16_t* U = (bf16_t*)(p.ws + WS_U);
    const float* dsk = p.in[I_HD] + l * DH;
    for (int it = blockIdx.x; it < DH * (NB / 2); it += gridDim.x) {
        const int xq = it & 7, xr = it >> 3, c = xq * (DH / 8) + xr / (NB / 2), pr = xr % (NB / 2);
        unsigned* u1 = (unsigned*)(U + ((size_t)(2 * pr) * DH + c) * SL); unsigned* u2 = (unsigned*)(U + ((size_t)(2 * pr + 1) * DH + c) * SL);
        const int tid0 = launder_tid();
#pragma unroll 1
        for (int i = 0; i < 4; ++i) { const int k = tid0 + 512 * i;
            const unsigned a0 = u1[k], a1 = u1[k + 2048], b0 = u2[k], b1 = u2[k + 2048];
#pragma unroll
            for (int e = 0; e < 2; ++e) { const int id = 2 * k + e;
                float2 x[4];
                x[0] = make_float2(e ? __uint_as_float(a0 & 0xffff0000u) : __uint_as_float(a0 << 16), e ? __uint_as_float(b0 & 0xffff0000u) : __uint_as_float(b0 << 16));
                x[1] = make_float2(e ? __uint_as_float(a1 & 0xffff0000u) : __uint_as_float(a1 << 16), e ? __uint_as_float(b1 & 0xffff0000u) : __uint_as_float(b1 << 16));
                x[2] = make_float2(0.f, 0.f); x[3] = make_float2(0.f, 0.f);
                bfly<2, false, false>(x, (float)id * (1.0f / 16384.0f));
#pragma unroll
                for (int q = 0; q < 4; ++q) X[PH(id + q * 4096)] = opq(x[q]); } }
        lds_barrier();
        fft_pass<4, false>(X, 12); fft_pass<4, false>(X, 8);
        fft_mid<true>(X, KF + (size_t)c * NFFT, nullptr, false);
        fft_pass<4, true>(X, 8); fft_pass<4, true>(X, 12);
        const float d = dsk[c];
#pragma unroll 1
        for (int i = 0; i < 4; ++i) { const int k = tid0 + 512 * i;
            const unsigned a0 = u1[k], a1 = u1[k + 2048], b0 = u2[k], b1 = u2[k + 2048];
            float2 y0[2], y1[2];
#pragma unroll
            for (int e = 0; e < 2; ++e) { const int id = 2 * k + e;
                float2 x[4];
#pragma unroll
                for (int q = 0; q < 4; ++q) x[q] = X[PH(id + q * 4096)];
                bfly<2, true, false>(x, (float)id * (1.0f / 16384.0f));
                y0[e] = opq(x[0]); y1[e] = opq(x[1]); }
            if (do_store) {
                u1[k] = pk2(y0[0].x + d * __uint_as_float(a0 << 16), y0[1].x + d * __uint_as_float(a0 & 0xffff0000u));
                u1[k + 2048] = pk2(y1[0].x + d * __uint_as_float(a1 << 16), y1[1].x + d * __uint_as_float(a1 & 0xffff0000u));
                u2[k] = pk2(y0[0].y + d * __uint_as_float(b0 << 16), y0[1].y + d * __uint_as_float(b0 & 0xffff0000u));
                u2[k + 2048] = pk2(y1[0].y + d * __uint_as_float(b1 << 16), y1[1].y + d * __uint_as_float(b1 & 0xffff0000u)); } }
        lds_barrier();
    }
}

__device__ __forceinline__ void phase_hyena_prep(const Params& p, int l, unsigned char* lds) {
    bf16_t* RAW = (bf16_t*)lds;
    float* tile = (float*)(lds + 2 * 130 * 64 * 2);
    const bf16_t* P = (const bf16_t*)(p.ws + WS_P); bf16_t* U = (bf16_t*)(p.ws + WS_U);
    const float* cw = p.in[I_HCW] + (size_t)l * 3 * 1152; const float* cb = p.in[I_HCB] + l * 1152;
    u32x4 pf[5];
#define HP_PREFETCH(IT) do { const int _cg = (IT) % 6, _tt = ((IT) / 6) % 64, _b = (IT) / 384, _t0 = _tt * 128; const bf16_t* _pb = P + (size_t)_b * SL * NC; const int _tid = threadIdx.x; \
        _Pragma("unroll") for (int k = 0; k < 5; ++k) { const int idx = _tid + 512 * k, arr = idx / 1040, rem = idx % 1040, r = rem >> 3, sg = rem & 7, t = _t0 - 1 + r; pf[k] = (u32x4){0u, 0u, 0u, 0u}; \
            if (idx < 2080 && t >= 0 && t < SL) pf[k] = *(const u32x4*)(_pb + (size_t)t * NC + (arr ? C_V : C_X1) + _cg * 64 + sg * 8); } } while (0)
    if ((int)blockIdx.x < NB * 64 * 6) { HP_PREFETCH((int)blockIdx.x);
#pragma unroll
        for (int k = 0; k < 5; ++k) { const int idx = (int)threadIdx.x + 512 * k;
            if (idx < 2080) { const int arr = idx / 1040, rem = idx % 1040, r = rem >> 3, sg = rem & 7; *(u32x4*)(RAW + (arr * 130 + r) * 64 + sg * 8) = pf[k]; } } }
    lds_barrier();
    for (int it = blockIdx.x; it < NB * 64 * 6; it += gridDim.x) {
        const int tid = launder_tid(), cc = tid & 63, tq = tid >> 6;
        const int cgp = it % 6, tt = (it / 6) % 64, b = it / 384;
        const int c = cgp * 64 + cc, t0 = tt * 128;
        const float wx0 = cw[384 + c], wx1 = cw[1152 + 384 + c], wx2 = cw[2304 + 384 + c], bx = cb[384 + c];
        const float wv0 = cw[768 + c], wv1 = cw[1152 + 768 + c], wv2 = cw[2304 + 768 + c], bv = cb[768 + c];
        const bool has_next = it + (int)gridDim.x < NB * 64 * 6;
        if (has_next) HP_PREFETCH(it + (int)gridDim.x);
        { const bf16_t* rx = RAW + (tq * 16) * 64 + cc; const bf16_t* rv = rx + 130 * 64;
          float xm = bf2f(rx[0]), x0 = bf2f(rx[64]), vm = bf2f(rv[0]), v0 = bf2f(rv[64]);
#pragma unroll
          for (int i = 0; i < 16; ++i) {
              const float xp = bf2f(rx[(i + 2) * 64]), vp = bf2f(rv[(i + 2) * 64]);
              const float cx = wx0 * xm + wx1 * x0 + wx2 * xp + bx, cv = wv0 * vm + wv1 * v0 + wv2 * vp + bv;
              tile[cc * 129 + tq * 16 + i] = cx * cv;
              xm = x0; x0 = xp; vm = v0; v0 = vp; } }
        lds_barrier();
#pragma unroll
        for (int i = 0; i < 8; ++i) { const int idx = tid + 512 * i, c2 = idx >> 6, tl = (idx & 63) * 2;
            *(unsigned*)(U + ((size_t)b * DH + cgp * 64 + c2) * SL + t0 + tl) = pk2(tile[c2 * 129 + tl], tile[c2 * 129 + tl + 1]); }
        if (has_next) {
#pragma unroll
            for (int k = 0; k < 5; ++k) { const int idx = tid + 512 * k;
                if (idx < 2080) { const int arr = idx / 1040, rem = idx % 1040, r = rem >> 3, sg = rem & 7; *(u32x4*)(RAW + (arr * 130 + r) * 64 + sg * 8) = pf[k]; } } }
        lds_barrier();
    }
#undef HP_PREFETCH
}

__device__ __forceinline__ void phase_conformer(const Params& p, int l, unsigned char* lds) {
    bf16_t* G = (bf16_t*)lds;
    bf16_t* A = (bf16_t*)lds;
    float* CV = (float*)(lds + 49152);
    const bf16_t* P = (const bf16_t*)(p.ws + WS_P); bf16_t* Y = (bf16_t*)(p.ws + WS_HY);
    const bf16_t* PwT = (const bf16_t*)(p.ws + WS_PWT) + (size_t)l * DC * DC;
    const float* dww = p.in[I_CDW] + (size_t)l * 31 * DC; const float* dwb = p.in[I_CDB] + l * DC;
    const float* lng = p.in[I_CLG] + l * DC; const float* lnb = p.in[I_CLB] + l * DC; const float* pwb = p.in[I_CPB] + l * DC;
    const float* gg = p.in[I_GRPG] + l * DM + DH;
    float w[31];
#pragma unroll
    for (int k = 0; k < 31; ++k) w[k] = dww[k * DC + (threadIdx.x & 255)];
    const float bias = dwb[threadIdx.x & 255];
    u32x4 av[6];
#define CF_TILE(IT) ((((IT) & 7) * (NB * (SL / 64) / 8)) + ((IT) >> 3))
#define CF_PREFETCH(IT) do { const int _tile = CF_TILE(IT), _b = _tile / (SL / 64), _t0 = (_tile % (SL / 64)) * 64; const bf16_t* _pb = P + (size_t)_b * SL * NC; const int _tid = threadIdx.x; \
        _Pragma("unroll") for (int k = 0; k < 6; ++k) { const int idx = _tid + 512 * k, i = idx >> 5, c8 = (idx & 31) * 8, t = _t0 - 15 + i; \
            av[k] = (u32x4){0u, 0u, 0u, 0u}; \
            if (idx < 94 * 32 && t >= 0 && t < SL) av[k] = *(const u32x4*)(_pb + (size_t)t * NC + c8 + ((c8 >= 128) ? 128 : 0)); } } while (0)
    if ((int)blockIdx.x < NB * (SL / 64)) CF_PREFETCH((int)blockIdx.x);
    for (int it = blockIdx.x; it < NB * (SL / 64); it += gridDim.x) {
        const int tid = launder_tid(), lane = tid & 63, wave = tid >> 6, fr = lane & 15, fq = lane >> 4;
        const int tile = CF_TILE(it), b = tile / (SL / 64), t0 = (tile % (SL / 64)) * 64;
        const bf16_t* pb = P + (size_t)b * SL * NC;
#pragma unroll
        for (int k = 0; k < 6; ++k) { const int idx = tid + 512 * k, i = idx >> 5, c8 = (idx & 31) * 8;
            if (idx < 94 * 32) *(u32x4*)(G + i * 256 + c8) = av[k]; }
        lds_barrier();
        if (it + (int)gridDim.x < NB * (SL / 64)) CF_PREFETCH(it + (int)gridDim.x);
        { const int c = tid & 255, hf = tid >> 8;
#pragma unroll 1
          for (int rnd = 0; rnd < 2; ++rnd) {
              const int r0 = hf * 32 + rnd * 16;
              float acc[16];
#pragma unroll
              for (int o = 0; o < 16; ++o) acc[o] = bias;
#pragma unroll
              for (int r = 0; r < 46; ++r) { const float v = bf2f(G[(r0 + r) * 256 + c]);
#pragma unroll
                  for (int o = 0; o < 16; ++o) { if (r - o >= 0 && r - o < 31) acc[o] += w[r - o] * v; } }
#pragma unroll
              for (int o = 0; o < 16; ++o) CV[(r0 + o) * 256 + c] = acc[o];
          } }
        lds_barrier();
        { f32x4 v[8]; float s1[8], s2[8];
#pragma unroll
          for (int i = 0; i < 8; ++i) { v[i] = *(const f32x4*)(CV + (wave * 8 + i) * 256 + lane * 4); s1[i] = (v[i].x + v[i].y) + (v[i].z + v[i].w); }
          wave_sum_n<8>(s1);
#pragma unroll
          for (int i = 0; i < 8; ++i) { v[i] = v[i] - s1[i] * (1.0f / DC); s2[i] = (v[i].x * v[i].x + v[i].y * v[i].y) + (v[i].z * v[i].z + v[i].w * v[i].w); }
          wave_sum_n<8>(s2);
          const f32x4 gv = *(const f32x4*)(lng + lane * 4), bv = *(const f32x4*)(lnb + lane * 4);
#pragma unroll
          for (int i = 0; i < 8; ++i) { const float rstd = rsqrtf(s2[i] * (1.0f / DC) + EPS);
              const f32x4 y = v[i] * rstd * gv + bv;
              u32x2 w; w.x = pk2(siluf_(y.x), siluf_(y.y)); w.y = pk2(siluf_(y.z), siluf_(y.w));
              *(u32x2*)(A + (wave * 8 + i) * 264 + lane * 4) = w; } }
        lds_barrier();
        { f32x4 acc[4][2];
#pragma unroll
          for (int m = 0; m < 4; ++m) { acc[m][0] = (f32x4){0.f, 0.f, 0.f, 0.f}; acc[m][1] = (f32x4){0.f, 0.f, 0.f, 0.f}; }
          const int n0 = wave * 32;
#pragma unroll
          for (int ks = 0; ks < 8; ++ks) {
              bf16x8 bf[2], af[4];
#pragma unroll
              for (int n = 0; n < 2; ++n) bf[n] = *(const bf16x8*)(PwT + (size_t)(n0 + n * 16 + fr) * DC + ks * 32 + fq * 8);
#pragma unroll
              for (int m = 0; m < 4; ++m) af[m] = *(const bf16x8*)(A + (m * 16 + fr) * 264 + ks * 32 + fq * 8);
#pragma unroll
              for (int m = 0; m < 4; ++m)
#pragma unroll
                  for (int n = 0; n < 2; ++n) acc[m][n] = __builtin_amdgcn_mfma_f32_16x16x32_bf16(af[m], bf[n], acc[m][n], 0, 0, 0);
          }
#pragma unroll
          for (int n = 0; n < 2; ++n) { const int col = n0 + n * 16 + fr; const float bb = pwb[col];
#pragma unroll
              for (int m = 0; m < 4; ++m)
#pragma unroll
                  for (int j = 0; j < 4; ++j) CV[(m * 16 + fq * 4 + j) * 256 + col] = acc[m][n][j] + bb; } }
        lds_barrier();
        { f32x4 v[8]; float s2[8]; u32x2 gt[8];
#pragma unroll
          for (int i = 0; i < 8; ++i) { const int tl = wave * 8 + i; const size_t row = (size_t)b * SL + t0 + tl;
              gt[i] = *(const u32x2*)(P + row * NC + C_GATE + DH + lane * 4);
              v[i] = *(const f32x4*)(CV + tl * 256 + lane * 4); s2[i] = (v[i].x * v[i].x + v[i].y * v[i].y) + (v[i].z * v[i].z + v[i].w * v[i].w); }
          wave_sum_n<8>(s2);
          const f32x4 gv = *(const f32x4*)(gg + lane * 4);
#pragma unroll
          for (int i = 0; i < 8; ++i) { const int tl = wave * 8 + i; const size_t row = (size_t)b * SL + t0 + tl;
              const float rstd = rsqrtf(s2[i] * (1.0f / DC) + EPS);
              const float g0 = __uint_as_float(gt[i].x << 16), g1 = __uint_as_float(gt[i].x & 0xffff0000u), g2 = __uint_as_float(gt[i].y << 16), g3 = __uint_as_float(gt[i].y & 0xffff0000u);
              u32x2 w; w.x = pk2(v[i].x * rstd * gv.x * siluf_(g0), v[i].y * rstd * gv.y * siluf_(g1)); w.y = pk2(v[i].z * rstd * gv.z * siluf_(g2), v[i].w * rstd * gv.w * siluf_(g3));
              *(u32x2*)(Y + row * DM + DH + lane * 4) = w; } }
        lds_barrier();
    }
}

template <bool PASSB>
__device__ __forceinline__ void phase_rglru(const Params& p, int l, unsigned char* lds) {
    float* XRF = (float*)lds;
    bf16_t* XRB = (bf16_t*)(lds + 32768);
    float* AS = (float*)(lds + 32768 + 18432);
    float* BS = AS + 128 * 64;
    float* SEGA = BS + 128 * 64;
    float* SEGB = SEGA + 512;
    float* CARRY = SEGB + 512;
    bf16_t* RAWR = (bf16_t*)(CARRY + 64);
    bf16_t* P = (bf16_t*)(p.ws + WS_P); float* AGG = (float*)(p.ws + WS_AGG);
    const float* cw = p.in[I_RCW] + (size_t)l * 4 * DR; const float* cb = p.in[I_RCB] + l * DR;
    const int tid = threadIdx.x, lane = tid & 63, wave = tid >> 6, fr = lane & 15, fq = lane >> 4;
    const int cc = tid & 63, seg = tid >> 6;
    const int mh = wave >> 2, jq = wave & 3;
    for (int it = blockIdx.x; it < NB * 6 * NCHUNK * 2; it += gridDim.x) {
        const int dir = it & 1, ch = (it >> 1) % NCHUNK, h = ((it >> 1) / NCHUNK) % 6, b = (it >> 1) / (NCHUNK * 6);
        bf16_t* pb = P + (size_t)b * SL * NC;
        bf16x8 Ba[2], Bx[2];
        { const bf16_t* wa = (const bf16_t*)(p.ws + WS_RGWT) + ((size_t)((l * 2 + dir) * 2 + 0) * 6 + h) * 4096;
          const bf16_t* wx = (const bf16_t*)(p.ws + WS_RGWT) + ((size_t)((l * 2 + dir) * 2 + 1) * 6 + h) * 4096;
#pragma unroll
          for (int ks = 0; ks < 2; ++ks) { Ba[ks] = *(const bf16x8*)(wa + (jq * 16 + fr) * 64 + ks * 32 + fq * 8); Bx[ks] = *(const bf16x8*)(wx + (jq * 16 + fr) * 64 + ks * 32 + fq * 8); } }
        const int gch = h * 64 + jq * 16 + fr;
        const float bga = p.in[I_RBA][(l * 2 + dir) * DR + gch], bgx = p.in[I_RBX][(l * 2 + dir) * DR + gch];
        const float lam = p.in[I_RLAM][(l * 2 + dir) * DR + gch];
        const float sp8l2 = 8.0f * 1.4426950408889634f * log1pf(__expf(-lam));
        const int c = h * 64 + cc;
        const float w0 = cw[c], w1 = cw[DR + c], w2 = cw[2 * DR + c], w3 = cw[3 * DR + c], cbias = cb[c];
        if (tid < 64) {
            float cin = 0.f;
            if (PASSB) {
                if (dir == 0) { for (int j = 0; j < ch; ++j) { const float* ag = AGG + ((size_t)((b * NCHUNK + j) * 2 + 0) * 2) * DR + c; cin = ag[0] * cin + ag[DR]; } }
                else { for (int j = NCHUNK - 1; j > ch; --j) { const float* ag = AGG + ((size_t)((b * NCHUNK + j) * 2 + 1) * 2) * DR + c; cin = ag[0] * cin + ag[DR]; } }
            }
            CARRY[tid] = cin;
        }
        float totA = 1.f;
        for (int s = 0; s < 4; ++s) {
            const int st = dir ? 3 - s : s, t0 = ch * CHUNK + st * 128;
#pragma unroll
            for (int k = 0; k < 3; ++k) { const int idx = tid + 512 * k;
                if (idx < 1048) { const int r = idx >> 3, sg = idx & 7, t = t0 - 2 + r;
                    u32x4 v = {0u, 0u, 0u, 0u};
                    if (t >= 0 && t < SL) v = *(const u32x4*)(pb + (size_t)t * NC + C_RG + h * 64 + sg * 8);
                    *(u32x4*)(RAWR + r * 64 + sg * 8) = v; } }
            __syncthreads();
            { const bf16_t* rr = RAWR + (seg * 16) * 64 + cc;
              float pm2 = bf2f(rr[0]), pm1 = bf2f(rr[64]), p0 = bf2f(rr[128]);
#pragma unroll
              for (int i = 0; i < 16; ++i) {
                  const float pp = bf2f(rr[(i + 3) * 64]);
                  const float xr = w0 * pm2 + w1 * pm1 + w2 * p0 + w3 * pp + cbias;
                  const int tl = seg * 16 + i, si = dir ? 127 - tl : tl;
                  XRF[si * 64 + cc] = xr; XRB[si * 72 + cc] = f2bf(xr);
                  pm2 = pm1; pm1 = p0; p0 = pp; } }
            __syncthreads();
#pragma unroll
            for (int m = 0; m < 4; ++m) {
                f32x4 ga = {0.f, 0.f, 0.f, 0.f}, gx = {0.f, 0.f, 0.f, 0.f};
#pragma unroll
                for (int ks = 0; ks < 2; ++ks) { const bf16x8 af = *(const bf16x8*)(XRB + (mh * 64 + m * 16 + fr) * 72 + ks * 32 + fq * 8);
                    ga = __builtin_amdgcn_mfma_f32_16x16x32_bf16(af, Ba[ks], ga, 0, 0, 0); gx = __builtin_amdgcn_mfma_f32_16x16x32_bf16(af, Bx[ks], gx, 0, 0, 0); }
#pragma unroll
                for (int j = 0; j < 4; ++j) { const int si = mh * 64 + m * 16 + fq * 4 + j, col = jq * 16 + fr;
                    const float r = sigmoidf_(ga[j] + bga), ig = sigmoidf_(gx[j] + bgx);
                    const float la2 = -sp8l2 * r; const float a = __builtin_amdgcn_exp2f(la2); const float mult = __builtin_amdgcn_sqrtf(fmaxf(1.0f - a * a, 0.f));
                    AS[si * 64 + col] = a; BS[si * 64 + col] = mult * ig * XRF[si * 64 + col]; }
            }
            __syncthreads();
            float hl[16], ca[16];
            { float hh = 0.f, cum = 1.f;
#pragma unroll
              for (int i = 0; i < 16; ++i) { const float a = AS[(seg * 16 + i) * 64 + cc], bb = BS[(seg * 16 + i) * 64 + cc]; hh = a * hh + bb; cum *= a; hl[i] = hh; ca[i] = cum; }
              SEGA[seg * 64 + cc] = cum; SEGB[seg * 64 + cc] = hh; }
            __syncthreads();
            float cin = CARRY[cc];
            for (int q = 0; q < seg; ++q) cin = SEGA[q * 64 + cc] * cin + SEGB[q * 64 + cc];
            if (PASSB) {
                bf16_t* dst = pb + (dir ? C_V : C_X1) + c;
#pragma unroll
                for (int i = 0; i < 16; ++i) { const int si = seg * 16 + i, tl = dir ? 127 - si : si; dst[(size_t)(t0 + tl) * NC] = f2bf(hl[i] + ca[i] * cin); }
            }
            float ncar = 0.f, prodA = 1.f;
            if (seg == 7) { ncar = hl[15] + ca[15] * cin;
#pragma unroll
                for (int q = 0; q < 8; ++q) prodA *= SEGA[q * 64 + cc]; }
            __syncthreads();
            if (seg == 7) { CARRY[cc] = ncar; totA *= prodA; }
        }
        __syncthreads();
        if (!PASSB && seg == 7) { float* ag = AGG + ((size_t)((b * NCHUNK + ch) * 2 + dir) * 2) * DR + c; ag[0] = totA; ag[DR] = CARRY[cc]; }
        __syncthreads();
    }
}

constexpr int NSUB = SL / 128, NSEQ = NB * 6 * 2;
__device__ __forceinline__ void phase_rglru_chain(const Params& p, int l, unsigned char* lds) {
    float* XRF = (float*)lds;
    bf16_t* XRB = (bf16_t*)(lds + 32768);
    float* AS = (float*)(lds + 32768 + 18432);
    float* BS = AS + 128 * 64;
    float* SEGA = BS + 128 * 64;
    float* SEGB = SEGA + 512;
    float* CARRY = SEGB + 512;
    bf16_t* RAWR = (bf16_t*)(CARRY + 64);
    bf16_t* P = (bf16_t*)(p.ws + WS_P);
    unsigned long long* GR = (unsigned long long*)(p.ws + WS_GRAN) + (size_t)l * NSUB * NSEQ * 64;
    const float* cw = p.in[I_RCW] + (size_t)l * 4 * DR; const float* cb = p.in[I_RCB] + l * DR;
    u32x4 pf[3];
#define RG_PREFETCH(IT) do { const int _sub = (IT) / NSEQ, _sq = (IT) % NSEQ, _dir = _sq & 1, _h = (_sq >> 1) % 6, _b = (_sq >> 1) / 6; \
        const int _t0 = (_dir ? NSUB - 1 - _sub : _sub) * 128; const bf16_t* _pb = P + (size_t)_b * SL * NC; const int _tid = threadIdx.x; \
        _Pragma("unroll") for (int k = 0; k < 3; ++k) { const int idx = _tid + 512 * k, r = idx >> 3, sg = idx & 7, t = _t0 - 2 + r; pf[k] = (u32x4){0u, 0u, 0u, 0u}; \
            if (idx < 1048 && t >= 0 && t < SL) pf[k] = *(const u32x4*)(_pb + (size_t)t * NC + C_RG + _h * 64 + sg * 8); } } while (0)
    if ((int)blockIdx.x < NSUB * NSEQ) { RG_PREFETCH((int)blockIdx.x);
#pragma unroll
        for (int k = 0; k < 3; ++k) { const int idx = (int)threadIdx.x + 512 * k; if (idx < 1048) *(u32x4*)(RAWR + (idx >> 3) * 64 + (idx & 7) * 8) = pf[k]; } }
    lds_barrier();
    for (int it = blockIdx.x; it < NSUB * NSEQ; it += gridDim.x) {
        const int tid = launder_tid(), lane = tid & 63, wave = tid >> 6, fr = lane & 15, fq = lane >> 4;
        const int cc = tid & 63, seg = tid >> 6, mh = wave >> 2, jq = wave & 3;
        const int sub = it / NSEQ, sq = it % NSEQ, dir = sq & 1, h = (sq >> 1) % 6, b = (sq >> 1) / 6;
        const int st = dir ? NSUB - 1 - sub : sub, t0 = st * 128;
        bf16_t* pb = P + (size_t)b * SL * NC;
        unsigned long long gv0 = 0ull;
        if (wave == 0 && sub > 0) gv0 = __hip_atomic_load(GR + ((size_t)(sub - 1) * NSEQ + sq) * 64 + lane, __ATOMIC_RELAXED, __HIP_MEMORY_SCOPE_AGENT);
        bf16x8 Ba[2], Bx[2];
        { const bf16_t* wa = (const bf16_t*)(p.ws + WS_RGWT) + ((size_t)((l * 2 + dir) * 2 + 0) * 6 + h) * 4096;
          const bf16_t* wx = (const bf16_t*)(p.ws + WS_RGWT) + ((size_t)((l * 2 + dir) * 2 + 1) * 6 + h) * 4096;
#pragma unroll
          for (int ks = 0; ks < 2; ++ks) { Ba[ks] = *(const bf16x8*)(wa + (jq * 16 + fr) * 64 + ks * 32 + fq * 8); Bx[ks] = *(const bf16x8*)(wx + (jq * 16 + fr) * 64 + ks * 32 + fq * 8); } }
        const int gch = h * 64 + jq * 16 + fr;
        const float bga = p.in[I_RBA][(l * 2 + dir) * DR + gch], bgx = p.in[I_RBX][(l * 2 + dir) * DR + gch];
        const float lam = p.in[I_RLAM][(l * 2 + dir) * DR + gch];
        const float sp8l2 = 8.0f * 1.4426950408889634f * log1pf(__expf(-lam));
        const int c = h * 64 + cc;
        const float w0 = cw[c], w1 = cw[DR + c], w2 = cw[2 * DR + c], w3 = cw[3 * DR + c], cbias = cb[c];
        const bool has_next = it + (int)gridDim.x < NSUB * NSEQ;
        if (has_next) RG_PREFETCH(it + (int)gridDim.x);
        { const bf16_t* rr = RAWR + (seg * 16) * 64 + cc;
          float pm2 = bf2f(rr[0]), pm1 = bf2f(rr[64]), p0 = bf2f(rr[128]);
#pragma unroll
          for (int i = 0; i < 16; ++i) {
              const float pp = bf2f(rr[(i + 3) * 64]);
              const float xr = w0 * pm2 + w1 * pm1 + w2 * p0 + w3 * pp + cbias;
              const int tl = seg * 16 + i, si = dir ? 127 - tl : tl;
              XRF[si * 64 + cc] = xr; XRB[si * 72 + cc] = f2bf(xr);
              pm2 = pm1; pm1 = p0; p0 = pp; } }
        lds_barrier();
#pragma unroll
        for (int m = 0; m < 4; ++m) {
            f32x4 ga = {0.f, 0.f, 0.f, 0.f}, gx = {0.f, 0.f, 0.f, 0.f};
#pragma unroll
            for (int ks = 0; ks < 2; ++ks) { const bf16x8 af = *(const bf16x8*)(XRB + (mh * 64 + m * 16 + fr) * 72 + ks * 32 + fq * 8);
                ga = __builtin_amdgcn_mfma_f32_16x16x32_bf16(af, Ba[ks], ga, 0, 0, 0); gx = __builtin_amdgcn_mfma_f32_16x16x32_bf16(af, Bx[ks], gx, 0, 0, 0); }
#pragma unroll
            for (int j = 0; j < 4; ++j) { const int si = mh * 64 + m * 16 + fq * 4 + j, col = jq * 16 + fr;
                const float r = sigmoidf_(ga[j] + bga), ig = sigmoidf_(gx[j] + bgx);
                const float la2 = -sp8l2 * r; const float a = __builtin_amdgcn_exp2f(la2); const float mult = __builtin_amdgcn_sqrtf(fmaxf(1.0f - a * a, 0.f));
                AS[si * 64 + col] = a; BS[si * 64 + col] = mult * ig * XRF[si * 64 + col]; }
        }
        lds_barrier();
        float hl[16], ca[16];
        { float hh = 0.f, cum = 1.f;
#pragma unroll
          for (int i = 0; i < 16; ++i) { const float a = AS[(seg * 16 + i) * 64 + cc], bb = BS[(seg * 16 + i) * 64 + cc]; hh = a * hh + bb; cum *= a; hl[i] = hh; ca[i] = cum; }
          SEGA[seg * 64 + cc] = cum; SEGB[seg * 64 + cc] = hh; }
        if (wave == 0) {
            float cin = 0.f;
            if (sub > 0) {
                unsigned long long* g = GR + ((size_t)(sub - 1) * NSEQ + sq) * 64 + lane;
                unsigned long long v = gv0; unsigned sp = 0;
                while ((unsigned)(v >> 32) != 1u) { __builtin_amdgcn_s_sleep(1); if (++sp > (1u << 22)) break; v = __hip_atomic_load(g, __ATOMIC_RELAXED, __HIP_MEMORY_SCOPE_AGENT); }
                cin = __uint_as_float((unsigned)v);
            }
            CARRY[lane] = cin;
        }
        lds_barrier();
        float cin = CARRY[cc];
        for (int q = 0; q < seg; ++q) cin = SEGA[q * 64 + cc] * cin + SEGB[q * 64 + cc];
        if (seg == 7) {
            const float ncar = hl[15] + ca[15] * cin;
            __hip_atomic_store(GR + ((size_t)sub * NSEQ + sq) * 64 + cc, ((unsigned long long)1u << 32) | (unsigned long long)__float_as_uint(ncar), __ATOMIC_RELAXED, __HIP_MEMORY_SCOPE_AGENT);
        }
        { bf16_t* dst = pb + (dir ? C_V : C_X1) + c;
#pragma unroll
          for (int i = 0; i < 16; ++i) { const int si = seg * 16 + i, tl = dir ? 127 - si : si; dst[(size_t)(t0 + tl) * NC] = f2bf(hl[i] + ca[i] * cin); } }
        if (has_next) {
#pragma unroll
            for (int k = 0; k < 3; ++k) { const int idx = tid + 512 * k; if (idx < 1048) *(u32x4*)(RAWR + (idx >> 3) * 64 + (idx & 7) * 8) = pf[k]; } }
        lds_barrier();
    }
#undef RG_PREFETCH
}

__device__ __forceinline__ void unpack6(const U3 v, float (&o)[6]) {
    o[0] = __uint_as_float(v.x << 16); o[1] = __uint_as_float(v.x & 0xffff0000u); o[2] = __uint_as_float(v.y << 16); o[3] = __uint_as_float(v.y & 0xffff0000u);
    o[4] = __uint_as_float(v.z << 16); o[5] = __uint_as_float(v.z & 0xffff0000u);
}
__device__ __forceinline__ void phase_finalize(const Params& p, int l, unsigned char* lds) {
    float* UT = (float*)lds;
    const bf16_t* P = (const bf16_t*)(p.ws + WS_P); bf16_t* Y = (bf16_t*)(p.ws + WS_HY); const bf16_t* U = (const bf16_t*)(p.ws + WS_U);
    const float* cw = p.in[I_HCW] + (size_t)l * 3 * 1152; const float* cb = p.in[I_HCB] + l * 1152; const float* gg = p.in[I_GRPG] + l * DM;
    const int tid = threadIdx.x, lane = tid & 63, wave = tid >> 6;
    float w0[6], w1[6], w2[6], wb[6], ghy[6], grg[6];
#pragma unroll
    for (int q = 0; q < 6; ++q) { const int c = lane * 6 + q; w0[q] = cw[c]; w1[q] = cw[1152 + c]; w2[q] = cw[2304 + c]; wb[q] = cb[c]; ghy[q] = gg[c]; grg[q] = gg[640 + c]; }
    u32x4 pf[6];
#define FIN_PREFETCH(IT) do { const int _b = (IT) / (SL / 64), _t0 = ((IT) % (SL / 64)) * 64; \
        _Pragma("unroll") for (int k = 0; k < 6; ++k) { const int idx = tid + 512 * k, c = idx >> 3, t8 = (idx & 7) * 8; pf[k] = *(const u32x4*)(U + ((size_t)_b * DH + c) * SL + _t0 + t8); } } while (0)
    if ((int)blockIdx.x < NB * (SL / 64)) FIN_PREFETCH((int)blockIdx.x);
    for (int it = blockIdx.x; it < NB * (SL / 64); it += gridDim.x) {
        const int b = it / (SL / 64), t0 = (it % (SL / 64)) * 64;
#pragma unroll
        for (int k = 0; k < 6; ++k) { const int idx = tid + 512 * k, c = idx >> 3, t8 = (idx & 7) * 8;
            const u32x4 v = pf[k];
#pragma unroll
            for (int j = 0; j < 4; ++j) { UT[c * 65 + t8 + 2 * j] = __uint_as_float(v[j] << 16); UT[c * 65 + t8 + 2 * j + 1] = __uint_as_float(v[j] & 0xffff0000u); } }
        lds_barrier();
        if (it + (int)gridDim.x < NB * (SL / 64)) FIN_PREFETCH(it + (int)gridDim.x);
        const bf16_t* pb = P + (size_t)b * SL * NC;
#pragma unroll 4
        for (int i = 0; i < 8; ++i) { const int tl = wave * 8 + i, t = t0 + tl; const size_t row = (size_t)b * SL + t;
            const bf16_t* pq = pb + (size_t)t * NC + lane * 6; const bf16_t* pr = pq + C_X0;
            const int om = (t > 0) ? -NC : 0, op = (t + 1 < SL) ? NC : 0;
            const float fm = (t > 0) ? 1.f : 0.f, fp = (t + 1 < SL) ? 1.f : 0.f;
            const U3 rm = *(const U3*)(pr + om), rc = *(const U3*)pr, rp = *(const U3*)(pr + op), rg = *(const U3*)(pq + C_GATE);
            const U3 rf = *(const U3*)(pq + C_X1), rb = *(const U3*)(pq + C_V), rg2 = *(const U3*)(pq + C_GATE + 640);
            float xm[6], xc[6], xp[6], gt[6], y[6], ss = 0.f;
            unpack6(rm, xm); unpack6(rc, xc); unpack6(rp, xp); unpack6(rg, gt);
#pragma unroll
            for (int q = 0; q < 6; ++q) { const float x0 = w0[q] * (xm[q] * fm) + w1[q] * xc[q] + w2[q] * (xp[q] * fp) + wb[q];
                y[q] = UT[(lane * 6 + q) * 65 + tl] * x0; ss += y[q] * y[q]; }
            float rstd = rsqrtf(wave_sum(ss) * (1.0f / DH) + EPS);
            { U3 o; o.x = pk2(y[0] * rstd * ghy[0] * siluf_(gt[0]), y[1] * rstd * ghy[1] * siluf_(gt[1])); o.y = pk2(y[2] * rstd * ghy[2] * siluf_(gt[2]), y[3] * rstd * ghy[3] * siluf_(gt[3]));
              o.z = pk2(y[4] * rstd * ghy[4] * siluf_(gt[4]), y[5] * rstd * ghy[5] * siluf_(gt[5])); *(U3*)(Y + row * DM + lane * 6) = o; }
            unpack6(rf, xm); unpack6(rb, xc); unpack6(rg2, gt); ss = 0.f;
#pragma unroll
            for (int q = 0; q < 6; ++q) { y[q] = xm[q] + xc[q]; ss += y[q] * y[q]; }
            rstd = rsqrtf(wave_sum(ss) * (1.0f / DR) + EPS);
            { U3 o; o.x = pk2(y[0] * rstd * grg[0] * siluf_(gt[0]), y[1] * rstd * grg[1] * siluf_(gt[1])); o.y = pk2(y[2] * rstd * grg[2] * siluf_(gt[2]), y[3] * rstd * grg[3] * siluf_(gt[3]));
              o.z = pk2(y[4] * rstd * grg[4] * siluf_(gt[4]), y[5] * rstd * grg[5] * siluf_(gt[5])); *(U3*)(Y + row * DM + 640 + lane * 6) = o; }
        }
        lds_barrier();
    }
}

#define XB_TMO      128
#define XB_XCNT(j)  (256  + 64 * (j))
#define XB_XSUB(j)  (1280 + 64 * (j))
#define XB_XGEN(j)  (2304 + 64 * (j))
#define XB_TOP      3328
#define XB_TOPGEN   3392
#define XCD_BAR_WORDS 3456
#define XB_SPIN_CAP (1u << 22)
#define LAS __attribute__((address_space(3)))
__device__ __forceinline__ unsigned xb_ld(unsigned* p)              { return __hip_atomic_load(p, __ATOMIC_RELAXED, __HIP_MEMORY_SCOPE_AGENT); }
__device__ __forceinline__ unsigned xb_add(unsigned* p, unsigned v) { return __hip_atomic_fetch_add(p, v, __ATOMIC_RELAXED, __HIP_MEMORY_SCOPE_AGENT); }
__device__ __forceinline__ unsigned xb_xcc_id() { return (unsigned)__builtin_amdgcn_s_getreg((3 << 11) | 20) & 0xFu; }
#define XB_SPIN(cond, bar) do { unsigned _sp = 0; while (cond) { __builtin_amdgcn_s_sleep(1); \
    if ((++_sp & 255u) == 0u) { if (xb_ld(&(bar)[XB_TMO])) break; if (_sp > XB_SPIN_CAP) { atomicAdd(&(bar)[XB_TMO], 1u); break; } } } } while (0)
struct XcdBarrier { unsigned* bar; unsigned x; volatile LAS unsigned* st; };
__device__ __forceinline__ XcdBarrier xcd_barrier_post(unsigned* bar, volatile LAS unsigned* st) {
    XcdBarrier b; b.bar = bar; b.x = xb_xcc_id(); b.st = st;
    if (threadIdx.x == 0) (void)xb_add(&bar[XB_XCNT(b.x)], 1u);
    return b;
}
__device__ __forceinline__ void xcd_barrier_complete(unsigned* bar, unsigned x, unsigned& nloc, unsigned& nx) {
    const unsigned G = gridDim.x * gridDim.y * gridDim.z;
    unsigned sum, cnt, mine, sp = 0u;
    for (;;) {
        sum = 0u; cnt = 0u; mine = 0u;
#pragma unroll
        for (unsigned j = 0; j < 16; ++j) { const unsigned c = xb_ld(&bar[XB_XCNT(j)]); sum += c; cnt += (c > 0u) ? 1u : 0u; mine = (j == x) ? c : mine; }
        if (sum == G) break;
        __builtin_amdgcn_s_sleep(1);
        if ((++sp & 255u) == 0u) { if (xb_ld(&bar[XB_TMO])) break; if (sp > XB_SPIN_CAP) { atomicAdd(&bar[XB_TMO], 1u); break; } }
    }
    nloc = mine > 0u ? mine : 1u; nx = cnt > 0u ? cnt : 1u;
}
__device__ __forceinline__ void xcd_barrier(const XcdBarrier& b) {
    asm volatile("s_waitcnt vmcnt(0)" ::: "memory");
    __syncthreads();
    if (threadIdx.x == 0) {
        unsigned* bar = b.bar;
        __builtin_amdgcn_s_waitcnt(0);
        unsigned nloc = b.st[0], nx = b.st[1];
        if (nloc == 0u) { xcd_barrier_complete(bar, b.x, nloc, nx); b.st[0] = nloc; b.st[1] = nx; }
        const unsigned old = xb_add(&bar[XB_XSUB(b.x)], 1u);
        const unsigned gen = old / nloc;
        if (old + 1u == (gen + 1u) * nloc) {
            __builtin_amdgcn_fence(__ATOMIC_RELEASE, "agent");
            asm volatile("s_waitcnt vmcnt(0)" ::: "memory");
            const unsigned og = xb_add(&bar[XB_TOP], 1u);
            const unsigned tg = og / nx;
            if (og + 1u == (tg + 1u) * nx) xb_add(&bar[XB_TOPGEN], 1u);
            else XB_SPIN(xb_ld(&bar[XB_TOPGEN]) == tg, bar);
            __builtin_amdgcn_fence(__ATOMIC_ACQUIRE, "agent");
            xb_add(&bar[XB_XGEN(b.x)], 1u);
            asm volatile("s_waitcnt vmcnt(0)" ::: "memory");
        } else {
            XB_SPIN(xb_ld(&bar[XB_XGEN(b.x)]) == gen, bar);
            __builtin_amdgcn_fence(__ATOMIC_ACQUIRE, "agent");
            asm volatile("s_waitcnt vmcnt(0)" ::: "memory");
        }
    }
    __syncthreads();
}

constexpr int NPHASE = 13;
#ifndef MK_DUP
#define MK_DUP 0
#endif
#define DUPN(bit) (((MK_DUP >> (bit)) & 1) ? 2 : 1)
template <int PH>
__device__ __forceinline__ void run_phase(const Params& p, unsigned char* lds, int vc) {
    float* SS = (float*)(p.ws + WS_SS);
    if constexpr (PH == 0) {
        if ((blockIdx.x >> 3) & 1) {
            phase_x0_prep(p.in[I_XP], p.in[I_XS], (bf16_t*)p.out, SS); asm volatile("" ::: "memory");
            phase_prep_weights(p, lds); phase_filters(p, 0, lds);
        } else {
            phase_prep_weights(p, lds); phase_filters(p, 0, lds); asm volatile("" ::: "memory");
            phase_x0_prep(p.in[I_XP], p.in[I_XS], (bf16_t*)p.out, SS);
        }
    } else if constexpr (PH == 12) {
        phase_final_norm((const bf16_t*)(p.ws + WS_P), SS + 2 * T, p.in[I_FING], p.out);
    } else {
        constexpr int l = (PH - 1) / 6, s = (PH - 1) % 6;
        if constexpr (s == 0) {
            pg8::Gemm g; g.A = (const bf16_t*)p.out; g.Bt = (const bf16_t*)(p.ws + WS_WINT) + (size_t)l * NC * DM; g.M = T; g.N = NC; g.K = DM;
            pg8::StaticOrder S; S.init(T, NC, (int)gridDim.x, vc);
            pg8::EpiBf16 E; E.O = (bf16_t*)(p.ws + WS_P); E.ldc = NC; E.ss = SS + l * T; E.invk = 1.0f / DM; E.eps = EPS; E.glu_tiles = 2;
            pg8::gemm_phase<pg8::EpiBf16, pg8::StaticOrder, false>((PG8_LAS unsigned char*)lds, g, S, E, nullptr);
        } else if constexpr (s == 1) {
            phase_kf_fft(p, lds);
            for (int r = 0; r < DUPN(0); ++r) phase_conformer(p, l, lds);
            for (int r = 0; r < DUPN(1); ++r) phase_hyena_prep(p, l, lds);
        } else if constexpr (s == 2) {
            phase_fftconv(p, l, lds);
            for (int r = 0; r < DUPN(3); ++r) phase_rglru_chain(p, l, lds);
        } else if constexpr (s == 3) {
            for (int r = 0; r < DUPN(4); ++r) phase_finalize(p, l, lds);
            if constexpr (l == 0) phase_filters(p, 1, lds);
        } else if constexpr (s == 4) {
            pg8::Gemm g; g.A = (const bf16_t*)(p.ws + WS_HY); g.Bt = (const bf16_t*)(p.ws + WS_WOUTT) + (size_t)l * DM * DM; g.M = T; g.N = DM; g.K = DM;
            pg8::StaticOrder S; S.init(T, DM, (int)gridDim.x, vc);
            pg8::EpiResB E; E.R = (const bf16_t*)p.out; E.O = (l == 0) ? (bf16_t*)p.out : (bf16_t*)(p.ws + WS_P); E.ldc = DM; E.ssq = SS + (l + 1) * T;
            pg8::gemm_phase<pg8::EpiResB, pg8::StaticOrder, false>((PG8_LAS unsigned char*)lds, g, S, E, nullptr);
        }
    }
}
__global__ __launch_bounds__(512, 2) void mega(Params p) {
    extern __shared__ __attribute__((aligned(16))) unsigned char lds[];
    cg::grid_group grid = cg::this_grid();
    volatile LAS unsigned* xst = (volatile LAS unsigned*)(PG8_LAS unsigned char*)(lds + LDS_BYTES);
    if (threadIdx.x == 0) { xst[0] = 0u; xst[1] = 0u; xst[2] = blockIdx.x; xst[3] = 0u; }
    __syncthreads();
    const bool multi = (p.ph_hi - p.ph_lo) > 1;
    XcdBarrier xb; xb.bar = (unsigned*)(p.ws + WS_BAR); xb.x = 0; xb.st = xst;
    unsigned myrank = 0u;
    if (multi) { xb = xcd_barrier_post((unsigned*)(p.ws + WS_BAR), xst);
        if (threadIdx.x == 0) myrank = xb_add(&xb.bar[RK_BASE + 64 * xb.x], 1u); }
#ifndef MK_MASK
#define MK_MASK 0x1fff
#endif
#define RUN_PH(PH) if constexpr ((MK_MASK >> PH) & 1) if (p.ph_lo <= PH && PH < p.ph_hi) { run_phase<PH>(p, lds, (int)xst[2]); asm volatile("" ::: "memory"); if (PH + 1 < p.ph_hi) { if (p.ph_lo > 1000) grid.sync(); else xcd_barrier(xb); } }
    RUN_PH(0)
    if (multi) {
        if (threadIdx.x == 0) { bool ok = (gridDim.x % 8u) == 0u;
            for (unsigned j = 0; j < 16; ++j) { const unsigned cnt = xb_ld(&xb.bar[RK_BASE + 64 * j]); if (cnt != ((j < 8u) ? gridDim.x / 8u : 0u)) ok = false; }
            if (ok && xb.x < 8u && myrank < gridDim.x / 8u) xst[2] = myrank * 8u + xb.x; }
        __syncthreads();
    }
    RUN_PH(1) RUN_PH(2) RUN_PH(3) RUN_PH(4) RUN_PH(5) RUN_PH(7) RUN_PH(8) RUN_PH(9) RUN_PH(10) RUN_PH(11) RUN_PH(12)
#undef RUN_PH
}

#ifndef MK_LAUNCHES
#define MK_LAUNCHES 1
#endif
extern "C" void kernel_launch(void* const* d_in, const int* in_sizes, int n_in, void* d_out, int out_size, void* d_ws, size_t ws_size, hipStream_t stream) {
    static int grid = 0;
    if (grid == 0) {
        if (n_in != 31 || out_size != T * DM || ws_size < WS_END) { fprintf(stderr, "kernel_launch: unexpected shapes (n_in %d out %d ws %zu need %zu)\n", n_in, out_size, ws_size, (size_t)WS_END); grid = -1; return; }
        int dev = 0, cus = 0, per_cu = 0;
        (void)hipGetDevice(&dev); (void)hipDeviceGetAttribute(&cus, hipDeviceAttributeMultiprocessorCount, dev);
        if (hipFuncSetAttribute((const void*)mega, hipFuncAttributeMaxDynamicSharedMemorySize, LDS_BYTES + 16) != hipSuccess) { fprintf(stderr, "kernel_launch: hipFuncSetAttribute failed\n"); grid = -1; return; }
        if (hipOccupancyMaxActiveBlocksPerMultiprocessor(&per_cu, (const void*)mega, 512, LDS_BYTES + 16) != hipSuccess || per_cu < 1) { fprintf(stderr, "kernel_launch: occupancy query gave %d\n", per_cu); per_cu = 1; }
        (void)hipGetLastError();
        grid = cus * per_cu;
    }
    if (grid < 0) return;
    if (hipMemsetAsync((char*)d_ws + WS_BAR, 0, CTL_BYTES, stream) != hipSuccess) { fprintf(stderr, "kernel_launch: memset failed\n"); return; }
    Params p{};
    for (int i = 0; i < 31; ++i) p.in[i] = (const float*)d_in[i];
    p.out = (float*)d_out; p.ws = (unsigned char*)d_ws;
#if MK_LAUNCHES == 1
    p.ph_lo = 0; p.ph_hi = NPHASE;
    void* args[] = {&p};
    hipError_t e = hipLaunchCooperativeKernel((const void*)mega, dim3(grid), dim3(512), args, LDS_BYTES + 16, stream);
    if (e != hipSuccess) fprintf(stderr, "cooperative launch failed: %s (grid %d)\n", hipGetErrorString(e), grid);
#else
    for (int ph = 0; ph < NPHASE; ++ph) { p.ph_lo = ph; p.ph_hi = ph + 1; hipLaunchKernelGGL(mega, dim3(grid), dim3(512), LDS_BYTES + 16, stream, p); }
#endif
}
```
